# Optimizing an MI355X kernel written in HIP

```python
import math
import jax, jax.numpy as jnp
from jax import lax
import numpy as np

D_MODEL = 2048
BATCH = 2
SEQ = 4096
DEPTH = 1

CHUNK = 64
LN_EPS = 1e-5
D_LRU = 1024
N_LRU_BLOCKS = 8
LRU_BLOCK = D_LRU // N_LRU_BLOCKS
CONV_W = 4
LRU_C = 8.0
N_HEADS = 8
HEAD_DIM = 128
D_ATT = N_HEADS * HEAD_DIM
N_IDX_HEADS = 16
IDX_DIM = 64
TOPK_MAX = 256
Q_BLOCK = 128
ROPE_THETA = 500000.0
ROT_ATT = HEAD_DIM // 4
ROT_IDX = IDX_DIM // 4
D_MIX = D_LRU + D_ATT
IN_SPLITS = (D_LRU, D_LRU, D_ATT, D_ATT, D_ATT, N_IDX_HEADS * IDX_DIM, IDX_DIM, N_IDX_HEADS)
D_IN = sum(IN_SPLITS)
PEER_HEADS = 8
N_KEYS = 128
N_EXPERTS = N_KEYS * N_KEYS
PEER_KEY_DIM = 256
PEER_TOPK = 16
TOK_BLOCK = 128
DEEPNORM_ALPHA = (2.0 * DEPTH) ** 0.25
DEEPNORM_BETA = (8.0 * DEPTH) ** -0.25

kernel_name = "hybrid_rglru_dsa_peer_deepnorm_adaln"


def layer_norm(x):
    xf = x.astype(jnp.float32)
    mu = jnp.mean(xf, -1, keepdims=True)
    var = jnp.mean(jnp.square(xf - mu), -1, keepdims=True)
    return ((xf - mu) * lax.rsqrt(var + LN_EPS)).astype(x.dtype)


def partial_rope(x, pos, rot_dim):
    half = rot_dim // 2
    inv_freq = ROPE_THETA ** (-jnp.arange(half, dtype=jnp.float32) / half)
    ang = pos.astype(jnp.float32)[:, :, None] * inv_freq
    cos = jnp.cos(ang)[:, :, None, :].astype(x.dtype)
    sin = jnp.sin(ang)[:, :, None, :].astype(x.dtype)
    x1, x2, xp = x[..., :half], x[..., half:rot_dim], x[..., rot_dim:]
    return jnp.concatenate([x1 * cos - x2 * sin, x2 * cos + x1 * sin, xp], -1)


def rglru_group(xb, gb, conv_w, conv_b, w_rg_a, b_rg_a, w_rg_x, b_rg_x, lam):
    B, S, _ = xb.shape
    xpad = jnp.pad(xb, ((0, 0), (CONV_W - 1, 0), (0, 0)))
    xc = sum(xpad[:, j:j + S] * conv_w[j] for j in range(CONV_W)) + conv_b
    xblk = xc.reshape(B, S, N_LRU_BLOCKS, LRU_BLOCK)
    r = jax.nn.sigmoid(jnp.einsum('bsnd,nde->bsne', xblk, w_rg_a).reshape(B, S, D_LRU) + b_rg_a)
    i = jax.nn.sigmoid(jnp.einsum('bsnd,nde->bsne', xblk, w_rg_x).reshape(B, S, D_LRU) + b_rg_x)
    log_a = -LRU_C * r.astype(jnp.float32) * jax.nn.softplus(-lam.astype(jnp.float32))
    a = jnp.exp(log_a)
    b = jnp.sqrt(-jnp.expm1(2.0 * log_a)) * (i * xc).astype(jnp.float32)

    def combine(e1, e2):
        a1, b1 = e1
        a2, b2 = e2
        return a1 * a2, a2 * b1 + b2

    _, h = lax.associative_scan(combine, (a, b), axis=1)
    return h.astype(xb.dtype) * jax.nn.gelu(gb)


def dsa_group(q, k, v, q_idx, k_idx, w_idx, k_idx_g, pos):
    B, S, _ = q.shape
    topk = min(TOPK_MAX, S // 4)
    q = partial_rope(q.reshape(B, S, N_HEADS, HEAD_DIM), pos, ROT_ATT)
    k = partial_rope(k.reshape(B, S, N_HEADS, HEAD_DIM), pos, ROT_ATT)
    v = v.reshape(B, S, N_HEADS, HEAD_DIM)
    q_idx = partial_rope(q_idx.reshape(B, S, N_IDX_HEADS, IDX_DIM), pos, ROT_IDX)
    k_idx = partial_rope((layer_norm(k_idx) * k_idx_g)[:, :, None, :], pos, ROT_IDX)[:, :, 0]
    w_idx = w_idx * (N_IDX_HEADS ** -0.5)
    key_chunk = jnp.arange(S) // CHUNK
    idx_scale = IDX_DIM ** -0.5
    att_scale = HEAD_DIM ** -0.5

    def block(bi):
        start = bi * Q_BLOCK
        qib = lax.dynamic_slice_in_dim(q_idx, start, Q_BLOCK, axis=1)
        wib = lax.dynamic_slice_in_dim(w_idx, start, Q_BLOCK, axis=1)
        logits = jnp.einsum('bthd,bsd->bths', qib, k_idx).astype(jnp.float32)
        score = jnp.einsum('bth,bths->bts', wib.astype(jnp.float32), jax.nn.relu(logits) * idx_scale)
        q_chunk = (start + jnp.arange(Q_BLOCK)) // CHUNK
        adm = key_chunk[None, :] <= q_chunk[:, None]
        score = jnp.where(adm[None], score, -jnp.inf)
        _, sel = lax.top_k(score, topk)
        valid = key_chunk[sel] <= q_chunk[None, :, None]
        k_sel = jax.vmap(lambda kk, ii: kk[ii])(k, sel)
        v_sel = jax.vmap(lambda vv, ii: vv[ii])(v, sel)
        qb = lax.dynamic_slice_in_dim(q, start, Q_BLOCK, axis=1)
        s = jnp.einsum('bthd,btkhd->bhtk', qb, k_sel).astype(jnp.float32) * att_scale
        s = jnp.where(valid[:, None], s, -jnp.inf)
        p = jax.nn.softmax(s, axis=-1).astype(v.dtype)
        return jnp.einsum('bhtk,btkhd->bthd', p, v_sel)

    out = lax.map(block, jnp.arange(S // Q_BLOCK))
    return out.transpose(1, 0, 2, 3, 4).reshape(B, S, D_ATT)


def peer(u, w_pq, sub_keys, u_tab, v_tab):
    B, S, D = u.shape
    q = (u @ w_pq).reshape(B, S, PEER_HEADS, 2, PEER_KEY_DIM // 2)
    s = jnp.einsum('bshpd,hpnd->bshpn', q, sub_keys).astype(jnp.float32)
    s1, i1 = lax.top_k(s[..., 0, :], PEER_TOPK)
    s2, i2 = lax.top_k(s[..., 1, :], PEER_TOPK)
    cand_s = (s1[..., :, None] + s2[..., None, :]).reshape(B, S, PEER_HEADS, PEER_TOPK * PEER_TOPK)
    cand_i = (i1[..., :, None] * N_KEYS + i2[..., None, :]).reshape(B, S, PEER_HEADS, PEER_TOPK * PEER_TOPK)
    top_s, pick = lax.top_k(cand_s, PEER_TOPK)
    eidx = jnp.take_along_axis(cand_i, pick, axis=-1)
    g = jax.nn.softmax(top_s, axis=-1)
    nb = (B * S) // TOK_BLOCK
    uf = u.reshape(nb, TOK_BLOCK, D)
    ef = eidx.reshape(nb, TOK_BLOCK, PEER_HEADS, PEER_TOPK)
    gf = g.reshape(nb, TOK_BLOCK, PEER_HEADS, PEER_TOPK)

    def apply(args):
        xb, eb, gb = args
        act = jax.nn.gelu(jnp.einsum('thkd,td->thk', u_tab[eb], xb).astype(jnp.float32))
        hk = (gb * act).astype(xb.dtype)
        return jnp.einsum('thk,thkd->td', hk, v_tab[eb])

    return lax.map(apply, (uf, ef, gf)).reshape(B, S, D)


def setup_inputs(seed: int = 0) -> dict:
    key = jax.random.key(seed)
    ks = jax.random.split(key, 24)
    f32 = jnp.float32
    L = DEPTH

    def nrm(k, shape, scale):
        return jax.random.normal(k, shape, f32) * scale

    x = nrm(ks[0], (BATCH, SEQ, D_MODEL), 1.0)
    c = nrm(ks[1], (BATCH, D_MODEL), 1.0)
    offs = jax.random.randint(ks[2], (BATCH, 1), 0, 1024, dtype=jnp.int32)
    positions = (offs + jnp.arange(SEQ, dtype=jnp.int32)[None, :]).astype(jnp.int32)
    w_ada = nrm(ks[3], (L, D_MODEL, 6 * D_MODEL), 0.2 * D_MODEL ** -0.5)
    b_ada = nrm(ks[4], (L, 6 * D_MODEL), 0.02)
    w_in = nrm(ks[5], (L, D_MODEL, D_IN), D_MODEL ** -0.5)
    conv_w = nrm(ks[6], (L, CONV_W, D_LRU), CONV_W ** -0.5)
    conv_b = nrm(ks[7], (L, D_LRU), 0.02)
    w_rg_a = nrm(ks[8], (L, N_LRU_BLOCKS, LRU_BLOCK, LRU_BLOCK), LRU_BLOCK ** -0.5)
    b_rg_a = nrm(ks[9], (L, D_LRU), 0.02)
    w_rg_x = nrm(ks[10], (L, N_LRU_BLOCKS, LRU_BLOCK, LRU_BLOCK), LRU_BLOCK ** -0.5)
    b_rg_x = nrm(ks[11], (L, D_LRU), 0.02)
    a_c = jax.random.uniform(ks[12], (L, D_LRU), f32, 0.9, 0.999)
    sg = a_c ** (1.0 / LRU_C)
    lru_lambda = jnp.log(sg) - jnp.log1p(-sg)
    k_idx_g = 1.0 + nrm(ks[13], (L, IDX_DIM), 0.02)
    w_out = nrm(ks[14], (L, D_MIX, D_MODEL), DEEPNORM_BETA * D_MIX ** -0.5)
    ln1_g = 1.0 + nrm(ks[15], (L, D_MODEL), 0.02)
    ln1_b = nrm(ks[16], (L, D_MODEL), 0.02)
    w_pq = nrm(ks[17], (L, D_MODEL, PEER_HEADS * PEER_KEY_DIM), D_MODEL ** -0.5)
    peer_sub_keys = nrm(ks[18], (L, PEER_HEADS, 2, N_KEYS, PEER_KEY_DIM // 2), (PEER_KEY_DIM // 2) ** -0.5)
    peer_u = nrm(ks[19], (L, N_EXPERTS, D_MODEL), D_MODEL ** -0.5)
    peer_v = nrm(ks[20], (L, N_EXPERTS, D_MODEL), DEEPNORM_BETA * PEER_HEADS ** -0.5)
    ln2_g = 1.0 + nrm(ks[21], (L, D_MODEL), 0.02)
    ln2_b = nrm(ks[22], (L, D_MODEL), 0.02)
    return {"x": x, "c": c, "positions": positions, "w_ada": w_ada, "b_ada": b_ada,
            "w_in": w_in, "conv_w": conv_w, "conv_b": conv_b, "w_rg_a": w_rg_a,
            "b_rg_a": b_rg_a, "w_rg_x": w_rg_x, "b_rg_x": b_rg_x, "lru_lambda": lru_lambda,
            "k_idx_g": k_idx_g, "w_out": w_out, "ln1_g": ln1_g, "ln1_b": ln1_b,
            "w_pq": w_pq, "peer_sub_keys": peer_sub_keys, "peer_u": peer_u, "peer_v": peer_v,
            "ln2_g": ln2_g, "ln2_b": ln2_b}


def reference(x, c, positions, w_ada, b_ada, w_in, conv_w, conv_b, w_rg_a, b_rg_a, w_rg_x,
              b_rg_x, lru_lambda, k_idx_g, w_out, ln1_g, ln1_b, w_pq, peer_sub_keys, peer_u,
              peer_v, ln2_g, ln2_b):
    split_at = np.cumsum(IN_SPLITS)[:-1].tolist()
    for l in range(DEPTH):
        mod = jax.nn.silu(c) @ w_ada[l] + b_ada[l]
        sh1, sc1, gt1, sh2, sc2, gt2 = [m[:, None, :] for m in jnp.split(mod, 6, axis=-1)]
        u1 = layer_norm(x) * (1.0 + sc1) + sh1
        xl, gl, q, k, v, qi, ki, wi = jnp.split(u1 @ w_in[l], split_at, axis=-1)
        y_lru = rglru_group(xl, gl, conv_w[l], conv_b[l], w_rg_a[l], b_rg_a[l], w_rg_x[l],
                            b_rg_x[l], lru_lambda[l])
        y_att = dsa_group(q, k, v, qi, ki, wi, k_idx_g[l], positions)
        mix = jnp.concatenate([y_lru, y_att], axis=-1) @ w_out[l]
        x = layer_norm(DEEPNORM_ALPHA * x + (1.0 + gt1) * mix) * ln1_g[l] + ln1_b[l]
        u2 = layer_norm(x) * (1.0 + sc2) + sh2
        y_ffn = peer(u2, w_pq[l], peer_sub_keys[l], peer_u[l], peer_v[l])
        x = layer_norm(DEEPNORM_ALPHA * x + (1.0 + gt2) * y_ffn) * ln2_g[l] + ln2_b[l]
    return x
```

```cpp
#include <hip/hip_runtime.h>
#include <hip/hip_bf16.h>
#include <cstdio>
#include <cstdint>
#include <cmath>

constexpr int NB = 2, SEQ = 4096, NTOK = NB * SEQ, DM = 2048;
constexpr int D_LRU = 1024, D_ATT = 1024, NHEAD = 8, HDIM = 128, NIH = 16, IDIM = 64;
constexpr int DIN = 6224, NMAIN = 6144;
constexpr int C_XL = 0, C_GL = 1024, C_Q = 2048, C_K = 3072, C_V = 4096, C_QI = 5120, C_KI = 6144, C_WI = 6208;
constexpr int NEXP = 16384, PKD = 256, PTOPK = 16, PHEADS = 8, NKEYS = 128;
constexpr float LN_EPS = 1e-5f;
constexpr float DN_ALPHA = 1.189207115002721f;

constexpr size_t MiB = 1u << 20;
constexpr size_t WS_CTL = 0, CTL_ZERO_BYTES = 1 * MiB;
constexpr size_t WS_MODP = 1 * MiB;
constexpr size_t WS_MODF = 4 * MiB;
constexpr size_t WS_WRG  = 5 * MiB;
constexpr size_t WS_SUBK = 6 * MiB;
constexpr size_t WS_KIDX = 7 * MiB;
constexpr size_t WS_WIDX = 8 * MiB;
constexpr size_t WS_AGG  = 9 * MiB;
constexpr size_t WS_MASK = 10 * MiB;
constexpr size_t WS_WIN  = 14 * MiB;
constexpr size_t WS_WOUT = 40 * MiB;
constexpr size_t WS_WPQ  = 48 * MiB;
constexpr size_t WS_PU   = 56 * MiB;
constexpr size_t WS_PV   = 120 * MiB;
constexpr size_t WS_U1   = 184 * MiB;
constexpr size_t WS_PROJ = 216 * MiB;
constexpr size_t WS_AG   = 312 * MiB;
constexpr size_t WS_BG   = 344 * MiB;
constexpr size_t WS_END  = 376 * MiB;
constexpr size_t WS_YMIX = WS_U1, WS_X1 = WS_PROJ, WS_U2 = WS_PROJ + 64 * MiB, WS_QP = WS_AG;

#define GAS __attribute__((address_space(1)))
#define LAS __attribute__((address_space(3)))
typedef unsigned short bf16;
typedef unsigned v4u __attribute__((ext_vector_type(4)));
typedef unsigned v2u __attribute__((ext_vector_type(2)));
typedef float f32x4 __attribute__((ext_vector_type(4)));
typedef float f32x2 __attribute__((ext_vector_type(2)));
typedef float f32x16 __attribute__((ext_vector_type(16)));
typedef short bf16x8 __attribute__((ext_vector_type(8)));
typedef short s16x4 __attribute__((ext_vector_type(4)));
#define RLX_AGENT __ATOMIC_RELAXED, __HIP_MEMORY_SCOPE_AGENT
#define LDS_WAIT() asm volatile("s_waitcnt lgkmcnt(0)" ::: "memory")
#define VM_WAIT() asm volatile("s_waitcnt vmcnt(0)" ::: "memory")
__device__ __forceinline__ unsigned f2bf(float f) { unsigned u = __builtin_bit_cast(unsigned, f); return (u + 0x7fffu + ((u >> 16) & 1u)) >> 16; }
__device__ __forceinline__ unsigned pk2(float lo, float hi) { return f2bf(lo) | (f2bf(hi) << 16); }
__device__ __forceinline__ float bflo(unsigned w) { return __builtin_bit_cast(float, w << 16); }
__device__ __forceinline__ float bfhi(unsigned w) { return __builtin_bit_cast(float, w & 0xffff0000u); }
__device__ __forceinline__ float bf2f(bf16 h) { return __builtin_bit_cast(float, (unsigned)h << 16); }
__device__ __forceinline__ float wave_sum(float v) {
#pragma unroll
    for (int o = 1; o < 64; o <<= 1) v += __shfl_xor(v, o);
    return v;
}
__device__ __forceinline__ float sigmoidf_(float x) { return 1.0f / (1.0f + __expf(-x)); }
__device__ __forceinline__ float gelu_tanh(float x) {
    const float u = 1.5957691216057308f * (x + 0.044715f * x * x * x);
    return x / (1.0f + __expf(-u));
}
namespace pg8 {
#define PG8_LAS __attribute__((address_space(3)))
typedef unsigned short bf16_t;
typedef short bf16x8 __attribute__((ext_vector_type(8)));
typedef float f32x4 __attribute__((ext_vector_type(4)));
typedef unsigned u32x4 __attribute__((ext_vector_type(4)));
constexpr int BM = 256, BK = 64, HALF = 128, HTB = HALF * BK * 2  , STAGE_BYTES = 8 * HTB, NXCD = 8, WGM = 8;

__host__ __device__ __forceinline__ int lds_byte(int r, int c) { const int st = (r >> 4) * 2 + (c >> 5), rr = r & 15, cc = c & 31, ob = rr * 64 + cc * 2; return st * 1024 + (ob ^ (((ob >> 9) & 1) << 5)); }
__host__ __device__ __forceinline__ void stage_rc(int b, int& R, int& C) { const int st = b / 1024, sb = b % 1024, swz = sb ^ (((sb >> 9) & 1) << 5); R = (st >> 1) * 16 + swz / 64; C = (st & 1) * 32 + (swz % 64) / 2; }
__host__ __device__ __forceinline__ int perm32(int rho) { const int n = rho >> 4, i = rho & 15; return 8 * (i >> 2) + 4 * n + (i & 3); }

struct Unit { int pm, pn; };
struct Gemm { const bf16_t* A; const bf16_t* Bt; int M, N, K; };

struct StaticOrder {
    int nM, nN, nwg, G, c;
    __host__ __device__ void init(int M, int N, int G_, int c_) { nM = M / BM; nN = N / BM; nwg = nM * nN; G = G_; c = c_; }
    __host__ __device__ bool next(int i, Unit& u) const {
        const long L = (long)i * G + c; if (L >= nwg) return false;
        int wgid = (int)L; { const int q = nwg / NXCD, r = nwg % NXCD, xcd = wgid % NXCD, off = wgid / NXCD; wgid = (xcd < r ? xcd * (q + 1) : r * (q + 1) + (xcd - r) * q) + off; }
        const int nig = WGM * nN, gid = wgid / nig, fm = gid * WGM, gsz = (nM - fm) < WGM ? (nM - fm) : WGM;
        u.pm = fm + ((wgid % nig) % gsz); u.pn = (wgid % nig) / gsz; return true;
    }
    __device__ __forceinline__ void a_ready(const Unit&) const {}
    __device__ __forceinline__ void done(const Unit&) const {}
};

__device__ __forceinline__ unsigned cvt_pk_bf16(float lo, float hi) { unsigned r; asm volatile("v_cvt_pk_bf16_f32 %0, %1, %2" : "=v"(r) : "v"(lo), "v"(hi)); return r; }
typedef float f32x2 __attribute__((ext_vector_type(2)));
__device__ __forceinline__ f32x2 gelu_pk(f32x2 v) {
    const f32x2 av = __builtin_elementwise_abs(v), d = av * 0.2316418882f + 1.0f;
    f32x2 t; t.x = __builtin_amdgcn_rcpf(d.x); t.y = __builtin_amdgcn_rcpf(d.y);
    f32x2 q = t * 0.5307027145f + (-0.7265760135f); q = q * t + 0.7107068705f; q = q * t + (-0.142248368f); q = q * t + 0.127414796f; q = q * t;
    const f32x2 s = (v * v) * (-0.72134752044f);
    f32x2 e; e.x = __builtin_amdgcn_exp2f(s.x); e.y = __builtin_amdgcn_exp2f(s.y);
    const f32x2 m = v * (q * e), r = v - m;
    f32x2 o; o.x = v.x < 0.f ? m.x : r.x; o.y = v.y < 0.f ? m.y : r.y; return o;
}

template <int ACT  > struct EpiBf16 {
    static constexpr bool PERM = true, AFTER_DRAIN = false; static_assert(ACT == 0 || ACT == 1, "EpiBf16: ACT is 0 (none) or 1 (gelu_pk)");
    bf16_t* O; int ldc; const float* bias; int split_cols; size_t split_stride; float scale0;
    __device__ __forceinline__ void operator()(const f32x4 (&acc)[2][2][4][2], const Unit& u, int wr, int wc, int fr, int fq) const {
        const int row0 = u.pm * BM + wr * 64 + fr; int colt = u.pn * BM; bf16_t* base = O;
        float sc = 1.f; if (split_cols) { const int t = colt / split_cols; base += (size_t)t * split_stride; colt -= t * split_cols; if (t == 0) sc = scale0; }
        const int col0 = colt + wc * 32 + 8 * fq, bcol0 = u.pn * BM + wc * 32 + 8 * fq;
        f32x4 bv[2][2];
#pragma unroll
        for (int bj = 0; bj < 2; ++bj)
#pragma unroll
            for (int n = 0; n < 2; ++n) bv[bj][n] = bias ? *(const f32x4*)(bias + bcol0 + bj * HALF + 4 * n) : (f32x4){0.f, 0.f, 0.f, 0.f};
#pragma unroll
        for (int ai = 0; ai < 2; ++ai)
#pragma unroll
            for (int m = 0; m < 4; ++m) { bf16_t* rowp = base + (size_t)(row0 + ai * HALF + m * 16) * ldc + col0;
#pragma unroll
                for (int bj = 0; bj < 2; ++bj) { f32x4 v0 = acc[ai][bj][m][0] + bv[bj][0], v1 = acc[ai][bj][m][1] + bv[bj][1];
                    if (ACT == 1) { f32x2 a = gelu_pk((f32x2){v0[0], v0[1]}), b = gelu_pk((f32x2){v0[2], v0[3]}), c = gelu_pk((f32x2){v1[0], v1[1]}), d = gelu_pk((f32x2){v1[2], v1[3]});
                        v0 = (f32x4){a.x, a.y, b.x, b.y}; v1 = (f32x4){c.x, c.y, d.x, d.y}; }
                    v0 = v0 * sc; v1 = v1 * sc; u32x4 w; w.x = cvt_pk_bf16(v0[0], v0[1]); w.y = cvt_pk_bf16(v0[2], v0[3]); w.z = cvt_pk_bf16(v1[0], v1[1]); w.w = cvt_pk_bf16(v1[2], v1[3]);
                    *(u32x4*)(rowp + bj * HALF) = w; } }
    }
};

struct EpiResF32 {
    static constexpr bool PERM = false, AFTER_DRAIN = false;
    const float* X; float* Z; const float* gate; int ldc, rows_per_batch, gstride; float alpha;
    __device__ __forceinline__ void operator()(const f32x4 (&acc)[2][2][4][2], const Unit& u, int wr, int wc, int fr, int fq) const {
        const int row0 = u.pm * BM + wr * 64 + fr, col0 = u.pn * BM + wc * 32 + 4 * fq;
        const float* gb = gate + (size_t)((u.pm * BM) / rows_per_batch) * gstride;
        f32x4 gv[2][2];
#pragma unroll
        for (int bj = 0; bj < 2; ++bj)
#pragma unroll
            for (int n = 0; n < 2; ++n) gv[bj][n] = *(const f32x4*)(gb + col0 + bj * HALF + n * 16) + 1.0f;
#pragma unroll
        for (int ai = 0; ai < 2; ++ai)
#pragma unroll
            for (int m = 0; m < 4; ++m) { const size_t off = (size_t)(row0 + ai * HALF + m * 16) * ldc + col0;
#pragma unroll
                for (int bj = 0; bj < 2; ++bj)
#pragma unroll
                    for (int n = 0; n < 2; ++n) { const f32x4 xv = *(const f32x4*)(X + off + bj * HALF + n * 16);
                        *(f32x4*)(Z + off + bj * HALF + n * 16) = xv * alpha + gv[bj][n] * acc[ai][bj][m][n]; } }
    }
};

template <class Epi, class Sched, bool ALIGN_EPI = false, bool SP2 = false>
__device__ __forceinline__ void gemm_phase(PG8_LAS unsigned char* lds, const Gemm g, const Sched& S, const Epi& E) {
    const int tid = threadIdx.x, wid = __builtin_amdgcn_readfirstlane(tid >> 6), lane = tid & 63, wr = wid >> 2, wc = wid & 3, fr = lane & 15, fq = lane >> 4;
    const int K = g.K, nt = K / BK;
    unsigned voffA[2], voffB[2];
#pragma unroll
    for (int i = 0; i < 2; ++i) { int R, C; stage_rc(tid * 16 + i * 8192, R, C); const int Rb = Epi::PERM ? ((R & ~31) + perm32(R & 31)) : R;
        voffA[i] = (unsigned)(R * K + C) * 2u; voffB[i] = (unsigned)(Rb * K + C) * 2u; }
    const size_t kstep = (size_t)(BK * 2);
    const size_t hstep = (size_t)HALF * K * 2;
    const size_t tstep = 2 * hstep;
    const unsigned ldsw = (unsigned)wid * 1024u;
    const int aoff = lds_byte(wr * 64 + fr, fq * 8), boff = lds_byte(wc * 32 + fr, fq * 8);
#define PG8_SA(b, h) (((b) * 2 + (h)) * HTB)
#define PG8_SB(b, h) ((4 + (b) * 2 + (h)) * HTB)
#define PG8_STAGE(bufoff, gbase, voff) do { _Pragma("unroll") for (int _i = 0; _i < 2; ++_i) \
        __builtin_amdgcn_global_load_lds((const unsigned*)((const char*)(gbase) + (voff)[_i]), (PG8_LAS unsigned*)(lds + (bufoff) + ldsw + _i * 8192), 16, 0, 0); } while (0)
#define PG8_LDA(dst, b, h) do { _Pragma("unroll") for (int m = 0; m < 4; ++m) _Pragma("unroll") for (int k = 0; k < 2; ++k) dst[m][k] = *(const PG8_LAS bf16x8*)(lds + PG8_SA(b, h) + aoff + m * 2048 + k * 1024); } while (0)
#define PG8_LDB(dst, b, h) do { _Pragma("unroll") for (int n = 0; n < 2; ++n) _Pragma("unroll") for (int k = 0; k < 2; ++k) dst[n][k] = *(const PG8_LAS bf16x8*)(lds + PG8_SB(b, h) + boff + n * 2048 + k * 1024); } while (0)
#define PG8_MMA(ai, bj, At, Bt) do { __builtin_amdgcn_s_setprio(1); _Pragma("unroll") for (int m = 0; m < 4; ++m) _Pragma("unroll") for (int n = 0; n < 2; ++n) _Pragma("unroll") for (int k = 0; k < 2; ++k) \
        acc[ai][bj][m][n] = __builtin_amdgcn_mfma_f32_16x16x32_bf16(Bt[n][k], At[m][k], acc[ai][bj][m][n], 0, 0, 0); __builtin_amdgcn_s_setprio(0); } while (0)
#define PG8_WAIT_V(n) asm volatile("s_waitcnt vmcnt(" #n ")" ::: "memory")
#define PG8_WAIT_L(n) asm volatile("s_waitcnt lgkmcnt(" #n ")" ::: "memory")
#define PG8_BAR __builtin_amdgcn_s_barrier()
#define PG8_SCHED __builtin_amdgcn_sched_barrier(0)
    Unit cur, nxt; int ui = 0;
    if (!S.next(0, cur)) return;
    f32x4 acc[2][2][4][2];
#pragma unroll
    for (int a = 0; a < 2; ++a)
#pragma unroll
        for (int b = 0; b < 2; ++b)
#pragma unroll
            for (int m = 0; m < 4; ++m)
#pragma unroll
                for (int n = 0; n < 2; ++n) acc[a][b][m][n] = (f32x4){0.f, 0.f, 0.f, 0.f};
    bf16x8 At[4][2], B0[2][2], B1[2][2];
    const char* cA = (const char*)g.A + (size_t)cur.pm * tstep; const char* cB = (const char*)g.Bt + (size_t)cur.pn * tstep;
    S.a_ready(cur);
    if constexpr (SP2) {
        PG8_STAGE(PG8_SB(0, 0), cB, voffB); PG8_STAGE(PG8_SB(0, 1), cB + hstep, voffB); PG8_STAGE(PG8_SA(0, 0), cA, voffA); PG8_STAGE(PG8_SA(0, 1), cA + hstep, voffA);
        if (wr == 1) PG8_BAR;
        PG8_WAIT_V(2); PG8_BAR;
        PG8_STAGE(PG8_SB(1, 0), cB + kstep, voffB); PG8_STAGE(PG8_SA(1, 0), cA + kstep, voffA); PG8_STAGE(PG8_SB(1, 1), cB + hstep + kstep, voffB);
        PG8_WAIT_V(6); PG8_BAR;
    } else {
        PG8_STAGE(PG8_SB(0, 0), cB, voffB); PG8_STAGE(PG8_SA(0, 0), cA, voffA); PG8_STAGE(PG8_SB(0, 1), cB + hstep, voffB); PG8_STAGE(PG8_SA(0, 1), cA + hstep, voffA);
        if (wr == 1) PG8_BAR;
        PG8_WAIT_V(4); PG8_BAR;
        PG8_STAGE(PG8_SB(1, 0), cB + kstep, voffB); PG8_STAGE(PG8_SA(1, 0), cA + kstep, voffA); PG8_STAGE(PG8_SB(1, 1), cB + hstep + kstep, voffB);
        PG8_WAIT_V(6); PG8_BAR;
    }
    for (;;) {
        const bool has_next = S.next(ui + 1, nxt);
        const char* nA = has_next ? (const char*)g.A + (size_t)nxt.pm * tstep : cA; const char* nB = has_next ? (const char*)g.Bt + (size_t)nxt.pn * tstep : cB;
        for (int t = 0; t < nt; t += 2) {
            const bool last = (t == nt - 2);
            const char* a1 = cA + (size_t)(t + 1) * kstep;
            const char* a2 = last ? nA : cA + (size_t)(t + 2) * kstep; const char* b2 = last ? nB : cB + (size_t)(t + 2) * kstep;
            const char* a3 = a2 + kstep; const char* b3 = b2 + kstep;
            if (last && has_next) S.a_ready(nxt);
            if constexpr (SP2) {
            PG8_LDB(B0, 0, 0); PG8_LDB(B1, 0, 1); PG8_SCHED; PG8_LDA(At, 0, 0); PG8_STAGE(PG8_SA(1, 1), a1 + hstep, voffA);
            PG8_WAIT_V(8); PG8_WAIT_L(0); PG8_BAR; PG8_MMA(0, 0, At, B0); PG8_MMA(0, 1, At, B1); PG8_BAR; PG8_SCHED;
            PG8_LDA(At, 0, 1); PG8_STAGE(PG8_SB(0, 0), b2, voffB); PG8_STAGE(PG8_SB(0, 1), b2 + hstep, voffB); PG8_STAGE(PG8_SA(0, 0), a2, voffA);
            PG8_WAIT_V(8); PG8_WAIT_L(0); PG8_BAR; PG8_MMA(1, 0, At, B0); PG8_MMA(1, 1, At, B1); PG8_BAR; PG8_SCHED;
            PG8_LDB(B0, 1, 0); PG8_LDB(B1, 1, 1); PG8_SCHED; PG8_LDA(At, 1, 0); PG8_STAGE(PG8_SA(0, 1), a2 + hstep, voffA);
            PG8_WAIT_V(8); PG8_WAIT_L(0); PG8_BAR; PG8_MMA(0, 0, At, B0); PG8_MMA(0, 1, At, B1); PG8_BAR; PG8_SCHED;
            PG8_LDA(At, 1, 1); PG8_STAGE(PG8_SB(1, 0), b3, voffB); PG8_STAGE(PG8_SB(1, 1), b3 + hstep, voffB); PG8_STAGE(PG8_SA(1, 0), a3, voffA);
            PG8_WAIT_V(8); PG8_WAIT_L(0); PG8_BAR; PG8_MMA(1, 0, At, B0); PG8_MMA(1, 1, At, B1); PG8_BAR; PG8_SCHED;
            } else {
            PG8_LDB(B0, 0, 0); PG8_SCHED; PG8_LDA(At, 0, 0); PG8_STAGE(PG8_SA(1, 1), a1 + hstep, voffA);
            PG8_WAIT_L(8); PG8_BAR; PG8_WAIT_L(0); PG8_MMA(0, 0, At, B0); PG8_BAR; PG8_SCHED;
            PG8_LDB(B1, 0, 1); PG8_STAGE(PG8_SB(0, 0), b2, voffB);
            PG8_BAR; PG8_WAIT_L(0); PG8_MMA(0, 1, At, B1); PG8_BAR;
            PG8_LDA(At, 0, 1); PG8_STAGE(PG8_SA(0, 0), a2, voffA);
            PG8_BAR; PG8_WAIT_L(0); PG8_MMA(1, 0, At, B0); PG8_BAR; PG8_SCHED;
            PG8_STAGE(PG8_SB(0, 1), b2 + hstep, voffB);
            PG8_WAIT_V(6); PG8_BAR; PG8_MMA(1, 1, At, B1); PG8_BAR;
            PG8_LDB(B0, 1, 0); PG8_SCHED; PG8_LDA(At, 1, 0); PG8_STAGE(PG8_SA(0, 1), a2 + hstep, voffA);
            PG8_WAIT_L(8); PG8_BAR; PG8_WAIT_L(0); PG8_MMA(0, 0, At, B0); PG8_BAR; PG8_SCHED;
            PG8_LDB(B1, 1, 1); PG8_STAGE(PG8_SB(1, 0), b3, voffB);
            PG8_BAR; PG8_WAIT_L(0); PG8_MMA(0, 1, At, B1); PG8_BAR;
            PG8_LDA(At, 1, 1); PG8_STAGE(PG8_SA(1, 0), a3, voffA);
            PG8_BAR; PG8_WAIT_L(0); PG8_MMA(1, 0, At, B0); PG8_BAR; PG8_SCHED;
            PG8_STAGE(PG8_SB(1, 1), b3 + hstep, voffB);
            PG8_WAIT_V(6); PG8_BAR; PG8_MMA(1, 1, At, B1); PG8_BAR;
            }
        }
        if constexpr (ALIGN_EPI) { if (wr == 0) PG8_BAR; }
        if constexpr (!Epi::AFTER_DRAIN) { E(acc, cur, wr, wc, fr, fq); S.done(cur); }
        if (!has_next) break;
#pragma unroll
        for (int a = 0; a < 2; ++a)
#pragma unroll
            for (int b = 0; b < 2; ++b)
#pragma unroll
                for (int m = 0; m < 4; ++m)
#pragma unroll
                    for (int n = 0; n < 2; ++n) acc[a][b][m][n] = (f32x4){0.f, 0.f, 0.f, 0.f};
        cur = nxt; cA = nA; cB = nB; ++ui;
        if constexpr (ALIGN_EPI) { if (wr == 1) PG8_BAR; }
    }
    PG8_WAIT_V(0);
    if constexpr (!ALIGN_EPI) { if (wr == 0) PG8_BAR; }
    PG8_BAR;
    if constexpr (Epi::AFTER_DRAIN) { E.fused(acc, cur, wr, wc, fr, fq, lds, wid, lane); S.done(cur); }
#undef PG8_SA
#undef PG8_SB
#undef PG8_STAGE
#undef PG8_LDA
#undef PG8_LDB
#undef PG8_MMA
#undef PG8_WAIT_V
#undef PG8_WAIT_L
#undef PG8_BAR
#undef PG8_SCHED
}
}
namespace att {
using bf16 = __hip_bfloat16;
typedef short bf16x8 __attribute__((ext_vector_type(8)));
typedef short s16x4 __attribute__((ext_vector_type(4)));
typedef float f32x16 __attribute__((ext_vector_type(16)));
typedef float f32x4 __attribute__((ext_vector_type(4)));
typedef unsigned u32x4 __attribute__((ext_vector_type(4)));
template <class A, class Bt> struct same_t { static constexpr bool v = false; };
template <class A> struct same_t<A, A> { static constexpr bool v = true; };
constexpr int D = 128, PIN = 6144, POUT = 2048;
constexpr float THR = 8.f;
constexpr bool WSKIP = false;
constexpr float SCALE = 0.08838834764831845f;
constexpr int NW = 8, QBLK = 32, KVBLK = 64, QB = NW * QBLK;
constexpr int SHM_V = KVBLK * D * 2, SHM_K = KVBLK * D * 2;
constexpr int LDS_BYTES = 2 * SHM_V + 2 * SHM_K + NW * 64 * 4;
#define KSWZ(row, colB) ((row) * 256 + ((colB) ^ (((row) & 7) << 4)))
#define SBAR() __builtin_amdgcn_sched_barrier(0)
__device__ __forceinline__ int v_st(int k, int c) { const int kk = (k & ~0xC) | ((k & 4) << 1) | ((k & 8) >> 1); return ((kk >> 3) * 4 + (c >> 5)) * 512 + ((kk & 7) * 32 + (c & 31)) * 2; }
__device__ __forceinline__ int v_rd_base(int lane) { return ((lane & 3) << 3) | (((lane >> 2) & 3) << 6) | (((lane >> 4) & 1) << 5) | (((lane >> 5) & 1) << 8); }
constexpr int v_rd_off(int d0, int ks, int half) { return d0 * 512 + ks * 4096 + half * 2048; }
__device__ __forceinline__ int crow(int r, int hi) { return (r & 3) + 8 * (r >> 2) + 4 * hi; }
__device__ __forceinline__ unsigned cvtpk(float lo, float hi) {
    unsigned r; asm volatile("v_cvt_pk_bf16_f32 %0, %1, %2" : "=v"(r) : "v"(lo), "v"(hi)); return r;
}
__device__ __forceinline__ bf16x8 pack8(f32x4 a, f32x4 b) {
    u32x4 w = {cvtpk(a[0], a[1]), cvtpk(a[2], a[3]), cvtpk(b[0], b[1]), cvtpk(b[2], b[3])};
    return *reinterpret_cast<bf16x8*>(&w);
}
template <class T> __device__ __forceinline__ bf16x8 load8(const T* p) {
    if constexpr (same_t<T, float>::v) { return pack8(*(const f32x4*)p, *(const f32x4*)(p + 4)); }
    else { return *reinterpret_cast<const bf16x8*>(p); }
}
__device__ __forceinline__ void mask_tile(f32x16& p0, f32x16& p1, int dq, unsigned W) {
    const float NEG = -__builtin_inff();
#pragma unroll
    for (int r = 0; r < 16; ++r) {
        const int c = (r & 3) + 8 * (r >> 2);
        if ((unsigned)(dq - c) >= W) p0[r] = NEG;
        if ((unsigned)(dq - c - 32) >= W) p1[r] = NEG;
    }
}
__device__ __forceinline__ void bitmask_tile(f32x16& p0, f32x16& p1, unsigned mw) {
    const float NEG = -__builtin_inff();
#pragma unroll
    for (int r = 0; r < 16; ++r) {
        if (!((mw >> r) & 1u)) p0[r] = NEG;
        if (!((mw >> (16 + r)) & 1u)) p1[r] = NEG;
    }
}
__device__ __forceinline__ void partialSM(f32x16& p0, f32x16& p1, float& m_reg, float& mn, float& alpha) {
    float pmax = p0[0]; for (int r = 1; r < 16; ++r) pmax = fmaxf(pmax, p0[r]); for (int r = 0; r < 16; ++r) pmax = fmaxf(pmax, p1[r]);
    { auto rr = __builtin_amdgcn_permlane32_swap(__float_as_uint(pmax), __float_as_uint(pmax), false, false);
      pmax = fmaxf(__uint_as_float(rr[0]), __uint_as_float(rr[1])); }
    constexpr float C2 = 1.4426950408889634f * SCALE;
    if (__builtin_expect(__all((pmax - m_reg) * SCALE <= THR), 1)) { mn = m_reg; alpha = 1.f; }
    else { mn = fmaxf(m_reg, pmax); alpha = __builtin_amdgcn_exp2f((m_reg - mn) * C2); m_reg = mn; }
    const float mnL = -mn * C2;
    for (int r = 0; r < 16; ++r) p0[r] = fmaf(p0[r], C2, mnL); for (int r = 0; r < 16; ++r) p1[r] = fmaf(p1[r], C2, mnL);
    for (int r = 0; r < 16; ++r) p0[r] = __builtin_amdgcn_exp2f(p0[r]);
}
__device__ __forceinline__ void finishSM(f32x16& p0, f32x16& p1, float alpha, float& l_reg, bf16x8& pa0, bf16x8& pa1, bf16x8& pa2, bf16x8& pa3) {
    for (int r = 0; r < 16; ++r) p1[r] = __builtin_amdgcn_exp2f(p1[r]);
    float ps = 0; for (int r = 0; r < 16; ++r) ps += p0[r]; for (int r = 0; r < 16; ++r) ps += p1[r];
    { auto rr = __builtin_amdgcn_permlane32_swap(__float_as_uint(ps), __float_as_uint(ps), false, false);
      ps = __uint_as_float(rr[0]) + __uint_as_float(rr[1]); }
    l_reg = l_reg * alpha + ps;
#define PK4(P, B_, OUT) do { unsigned a0 = cvtpk(P[B_+0], P[B_+1]), a1 = cvtpk(P[B_+2], P[B_+3]);                          \
        unsigned b0 = cvtpk(P[B_+4], P[B_+5]), b1 = cvtpk(P[B_+6], P[B_+7]);                                             \
        auto r0 = __builtin_amdgcn_permlane32_swap(a0, b0, false, false); auto r1 = __builtin_amdgcn_permlane32_swap(a1, b1, false, false); \
        u32x4 w = {r0[0], r1[0], r0[1], r1[1]}; OUT = *reinterpret_cast<bf16x8*>(&w); } while (0)
    PK4(p0, 0, pa0); PK4(p0, 8, pa1); PK4(p1, 0, pa2); PK4(p1, 8, pa3);
#undef PK4
}
template <int KB, bool SK>
__device__ __forceinline__ void qkt(f32x16& p0, f32x16& p1, const char* K_lds, int r32, int hi, const bf16x8* qr, bool act) {
    if (SK && !act) { const float NEG = -__builtin_inff();
#pragma unroll
        for (int r = 0; r < 16; ++r) { p0[r] = NEG; p1[r] = NEG; } return; }
    p0 = f32x16{}; p1 = f32x16{};
    const char* kb[4];
#pragma unroll
    for (int dd = 0; dd < 4; ++dd) kb[dd] = K_lds + KB * SHM_K + KSWZ(r32, (dd * 16 + hi * 8) * 2);
#pragma unroll
    for (int d0 = 0; d0 < 8; ++d0) { const char* a = kb[d0 & 3] + (d0 >> 2) * 128;
        bf16x8 b0 = *reinterpret_cast<const bf16x8*>(a);
        bf16x8 b1 = *reinterpret_cast<const bf16x8*>(a + 32 * 256);
        p0 = __builtin_amdgcn_mfma_f32_32x32x16_bf16(b0, qr[d0], p0, 0, 0, 0);
        p1 = __builtin_amdgcn_mfma_f32_32x32x16_bf16(b1, qr[d0], p1, 0, 0, 0); }
}
template <int VB, bool SK>
__device__ __forceinline__ void pv_tile(f32x16* o, int vb0, bf16x8 pa0, bf16x8 pa1, bf16x8 pa2, bf16x8 pa3, bool act) {
    if (SK && !act) return;
#define TRRD(dst, off) asm volatile("ds_read_b64_tr_b16 %0, %1 offset:%2" : "=&v"(dst) : "v"(vb0), "i"(off) : "memory")
#define PV_D0(d0) do { s16x4 l0, l1, l2, l3, h0, h1, h2, h3; constexpr int b_ = VB * SHM_V + v_rd_off(d0, 0, 0);     \
        TRRD(l0, b_); TRRD(h0, b_ + 2048); TRRD(l1, b_ + 4096); TRRD(h1, b_ + 6144); TRRD(l2, b_ + 8192); TRRD(h2, b_ + 10240); TRRD(l3, b_ + 12288); TRRD(h3, b_ + 14336); \
        asm volatile("s_waitcnt lgkmcnt(0)" ::: "memory"); SBAR();                 \
        o[d0] = __builtin_amdgcn_mfma_f32_32x32x16_bf16(pa0, (bf16x8){l0[0], l0[1], l0[2], l0[3], h0[0], h0[1], h0[2], h0[3]}, o[d0], 0, 0, 0);   \
        o[d0] = __builtin_amdgcn_mfma_f32_32x32x16_bf16(pa1, (bf16x8){l1[0], l1[1], l1[2], l1[3], h1[0], h1[1], h1[2], h1[3]}, o[d0], 0, 0, 0);   \
        o[d0] = __builtin_amdgcn_mfma_f32_32x32x16_bf16(pa2, (bf16x8){l2[0], l2[1], l2[2], l2[3], h2[0], h2[1], h2[2], h2[3]}, o[d0], 0, 0, 0);   \
        o[d0] = __builtin_amdgcn_mfma_f32_32x32x16_bf16(pa3, (bf16x8){l3[0], l3[1], l3[2], l3[3], h3[0], h3[1], h3[2], h3[3]}, o[d0], 0, 0, 0); } while (0)
    PV_D0(0); PV_D0(1); PV_D0(2); PV_D0(3);
#undef PV_D0
#undef TRRD
}

template <class TIn, class TOut> struct BlockRef { const TIn* Q; const TIn* K; const TIn* V; TOut* O; const unsigned long long* M; int P0; };
template <class TIn> struct Seam {
    bf16x8 qr[8];
    bf16x8 st_v0, st_v1, st_k0, st_k1; f32x4 sf0, sf1, sf2, sf3;
    f32x4 tq[16];
};
__device__ __forceinline__ int swa_jlo(int P0, int W) { const int lowk = P0 - W + 1; return lowk > 0 ? lowk / KVBLK : 0; }
#define ROW(p, k0, rr) ((p) + (size_t)((k0) + (rr)) * PIN + sc)
#define VMW() asm volatile("s_waitcnt vmcnt(0)" ::: "memory")
#define VMWN(n) asm volatile("s_waitcnt vmcnt(%0)" :: "i"(n) : "memory")
#define SLOAD_H(Kp, Vp, k0) do { S.st_v0 = load8<TIn>(ROW(Vp, k0, sr)); S.st_v1 = load8<TIn>(ROW(Vp, k0, 32 + sr));              \
                         S.st_k0 = load8<TIn>(ROW(Kp, k0, sr)); S.st_k1 = load8<TIn>(ROW(Kp, k0, 32 + sr)); } while (0)
#define SWRITE_HK(bf) do { *(bf16x8*)(K_lds + (bf) * SHM_K + kws) = S.st_k0; *(bf16x8*)(K_lds + (bf) * SHM_K + kws + 32 * 256) = S.st_k1; } while (0)
#define SWRITE_HV(bf) do { *(bf16x8*)(V_lds + (bf) * SHM_V + vst0) = S.st_v0; *(bf16x8*)(V_lds + (bf) * SHM_V + vst1) = S.st_v1; } while (0)
#define SWRITE_H(bf) do { SWRITE_HV(bf); SWRITE_HK(bf); } while (0)
#define SLOAD_F(p, k0) do { S.sf0 = *(const f32x4*)ROW(p, k0, sr); S.sf1 = *(const f32x4*)(ROW(p, k0, sr) + 4);                \
                            S.sf2 = *(const f32x4*)ROW(p, k0, 32 + sr); S.sf3 = *(const f32x4*)(ROW(p, k0, 32 + sr) + 4); } while (0)
#define SWRITE_KF(bf) do { *(bf16x8*)(K_lds + (bf) * SHM_K + kws) = pack8(S.sf0, S.sf1); *(bf16x8*)(K_lds + (bf) * SHM_K + kws + 32 * 256) = pack8(S.sf2, S.sf3); } while (0)
#define SWRITE_VF(bf) do { *(bf16x8*)(V_lds + (bf) * SHM_V + vst0) = pack8(S.sf0, S.sf1); *(bf16x8*)(V_lds + (bf) * SHM_V + vst1) = pack8(S.sf2, S.sf3); } while (0)
template <class TIn, class TOut>
__device__ __forceinline__ void causal_swa_prime(const BlockRef<TIn, TOut>& cur, int W, char* lds, Seam<TIn>& S) {
    constexpr bool F32 = same_t<TIn, float>::v;
    const int tid = threadIdx.x, wid = __builtin_amdgcn_readfirstlane(tid >> 6), lane = tid & 63, r32 = lane & 31, hi = lane >> 5;
    const int sr = tid >> 4, sc = (tid & 15) * 8, kws = KSWZ(sr, sc * 2); char* K_lds = lds + 2 * SHM_V;
    const int kb0 = swa_jlo(cur.P0, W) * KVBLK;
    for (int d0 = 0; d0 < 8; ++d0) S.qr[d0] = load8<TIn>(cur.Q + (size_t)(wid * QBLK + r32) * PIN + d0 * 16 + hi * 8);
    if constexpr (F32) { SLOAD_F((const float*)cur.K, kb0); VMW(); SWRITE_KF(0); SBAR(); SLOAD_F((const float*)cur.V, kb0); }
    else { SLOAD_H(cur.K, cur.V, kb0); VMW(); SWRITE_HK(0); }
    __syncthreads();
}
template <class TIn, class TOut>
__device__ __forceinline__ void causal_swa_block(const BlockRef<TIn, TOut>& cur, const BlockRef<TIn, TOut>& nxt, int skv, int W, char* lds, Seam<TIn>& S) {
    constexpr bool F32 = same_t<TIn, float>::v;
    const int tid = threadIdx.x, wid = __builtin_amdgcn_readfirstlane(tid >> 6), lane = tid & 63, r32 = lane & 31, hi = lane >> 5;
    const int j_lo = swa_jlo(cur.P0, W);
    int j_hi = (cur.P0 + QB - 1) / KVBLK + 1; if (j_hi > skv / KVBLK) j_hi = skv / KVBLK;
    const int NT = j_hi - j_lo;
    const int kbn = swa_jlo(nxt.P0, W) * KVBLK;
    const unsigned* M32 = (const unsigned*)cur.M; const unsigned moff = (unsigned)((wid * QBLK + r32) * 128 + hi);
    const int qlo = cur.P0 + wid * QBLK;
    char* V_lds = lds; char* K_lds = lds + 2 * SHM_V;
    float* ws = (float*)(lds + 2 * SHM_V + 2 * SHM_K) + wid * 64; float* li_l = ws, * al_l = ws + 32;
    float m_reg = -1e30f, l_reg = 0; f32x16 o[4] = {};
    const int sr = tid >> 4, sc = (tid & 15) * 8, vst0 = v_st(sr, sc), vst1 = v_st(32 + sr, sc), kws = KSWZ(sr, sc * 2);
    const int vb0 = (int)(uintptr_t)V_lds + v_rd_base(lane);
    const TIn* Kh = cur.K; const TIn* Vh = cur.V;
#define RESC(a) do { if (__any((a) < 1.f)) { if (hi == 0) al_l[r32] = (a); asm volatile("s_waitcnt lgkmcnt(0)" ::: "memory");              \
                     for (int d_ = 0; d_ < 4; ++d_) for (int r = 0; r < 16; ++r) o[d_][r] *= al_l[crow(r, hi)]; } } while (0)
#define KBASE(t) ((j_lo + (t)) * KVBLK)
#define ACT(t) (KBASE(t) <= qlo + QBLK - 1 && KBASE(t) + KVBLK - 1 >= qlo - W + 1)
#define MASKT(P0_, P1_, t) do { bitmask_tile(P0_, P1_, mwn); } while (0)
    constexpr int NQL = F32 ? 16 : 8;
    constexpr bool SK = WSKIP && !F32;
#define SEAM_K0() do { VMWN(NQL); if constexpr (F32) { SWRITE_KF(0); SBAR(); SLOAD_F((const float*)nxt.V, kbn); } else { SWRITE_HK(0); } SBAR(); } while (0)
    f32x16 pA0, pA1, pB0, pB1; float mnA, mnB, alA, alB; bf16x8 pa0, pa1, pa2, pa3;
    if constexpr (F32) { VMW(); SWRITE_VF(0); SBAR(); } else { SWRITE_HV(0); SBAR(); }
    if (NT > 1) { if constexpr (F32) SLOAD_F((const float*)Kh, KBASE(1)); else SLOAD_H(Kh, Vh, KBASE(1)); }
    unsigned mwn = M32[moff + 2 * j_lo]; SBAR(); qkt<0, SK>(pA0, pA1, K_lds, r32, hi, S.qr, ACT(0));
    if constexpr (F32) { if (NT > 1) { VMW(); SWRITE_KF(1); SBAR(); SLOAD_F((const float*)Vh, KBASE(1)); } }
    MASKT(pA0, pA1, 0); partialSM(pA0, pA1, m_reg, mnA, alA);
    if (NT > 1) { VMW(); if constexpr (F32) { SWRITE_VF(1); SBAR(); if (NT > 2) SLOAD_F((const float*)Kh, KBASE(2)); } else SWRITE_H(1); }
    __syncthreads();
#define HALF_STEP(PX0, PX1, mnX, alX, PY0, PY1, alY, t, KB, VB, SB) do {                                                      \
        mwn = M32[moff + 2 * (j_lo + (t))]; SBAR(); qkt<KB, SK>(PX0, PX1, K_lds, r32, hi, S.qr, ACT(t));             \
        finishSM(PY0, PY1, alY, l_reg, pa0, pa1, pa2, pa3); SBAR();                                                           \
        if ((t) + 1 < NT) { if constexpr (F32) { VMW(); SWRITE_KF(SB); SBAR(); SLOAD_F((const float*)Vh, KBASE((t) + 1)); }  \
                            else { SLOAD_H(Kh, Vh, KBASE((t) + 1)); } SBAR(); }                                               \
        pv_tile<VB, SK>(o, vb0, pa0, pa1, pa2, pa3, ACT((t) - 1)); MASKT(PX0, PX1, (t)); partialSM(PX0, PX1, m_reg, mnX, alX);                                        \
        __syncthreads();                                                                                                      \
        if ((t) + 1 < NT) { VMW(); if constexpr (F32) { SWRITE_VF(SB); SBAR(); if ((t) + 2 < NT) SLOAD_F((const float*)Kh, KBASE((t) + 2)); } \
                            else { SWRITE_H(SB); } }                                                                          \
        RESC(alX); __syncthreads(); } while (0)
    for (int t = 1; t + 1 < NT; t += 2) {
        HALF_STEP(pB0, pB1, mnB, alB, pA0, pA1, alA, t, 1, 0, 0);
        HALF_STEP(pA0, pA1, mnA, alA, pB0, pB1, alB, t + 1, 0, 1, 1);
    }
    const bool even = (NT & 1) == 0;
    if (even) { mwn = M32[moff + 2 * (j_lo + NT - 1)]; SBAR(); qkt<1, SK>(pB0, pB1, K_lds, r32, hi, S.qr, ACT(NT - 1)); SBAR(); }
#define QROW(e) (nxt.Q + (size_t)(wid * QBLK + r32) * PIN + ((e) >> 1) * 16 + hi * 8 + ((e) & 1) * 4)
    if constexpr (F32) { SLOAD_F((const float*)nxt.K, kbn); SBAR();
#pragma unroll
        for (int e = 0; e < 8; ++e) S.tq[e] = *(const f32x4*)QROW(e); }
    else { SLOAD_H(nxt.K, nxt.V, kbn); SBAR();
#pragma unroll
        for (int d0 = 0; d0 < 8; ++d0) S.qr[d0] = load8<TIn>(nxt.Q + (size_t)(wid * QBLK + r32) * PIN + d0 * 16 + hi * 8); }
    SBAR();
    finishSM(pA0, pA1, alA, l_reg, pa0, pa1, pa2, pa3); SBAR();
    if constexpr (F32) {
#pragma unroll
        for (int e = 8; e < 16; ++e) S.tq[e] = *(const f32x4*)QROW(e); SBAR(); }
#undef QROW
    pv_tile<0, SK>(o, vb0, pa0, pa1, pa2, pa3, ACT(even ? NT - 2 : NT - 1));
    if (even) { MASKT(pB0, pB1, NT - 1); partialSM(pB0, pB1, m_reg, mnB, alB); __syncthreads(); RESC(alB);
        finishSM(pB0, pB1, alB, l_reg, pa0, pa1, pa2, pa3); SBAR(); pv_tile<1, SK>(o, vb0, pa0, pa1, pa2, pa3, ACT(NT - 1)); }
    SBAR(); SEAM_K0();
    if (hi == 0) li_l[r32] = l_reg; asm volatile("s_waitcnt lgkmcnt(0)" ::: "memory");
    float rli[16];
#pragma unroll
    for (int r = 0; r < 16; ++r) rli[r] = __builtin_amdgcn_rcpf(li_l[crow(r, hi)]);
    TOut* Ow = cur.O + (size_t)(wid * QBLK) * POUT;
#pragma unroll
    for (int r = 0; r < 16; ++r) { const int orow = crow(r, hi);
#pragma unroll
        for (int d0 = 0; d0 < 4; ++d0) { const float v = o[d0][r] * rli[r];
            if constexpr (same_t<TOut, float>::v) { Ow[(size_t)orow * POUT + d0 * 32 + r32] = v; }
            else { const float vn = __shfl_xor(v, 1);
                   if ((r32 & 1) == 0) *(unsigned*)(Ow + (size_t)orow * POUT + d0 * 32 + r32) = cvtpk(v, vn); } } }
    if constexpr (F32) {
#pragma unroll
        for (int d0 = 0; d0 < 8; ++d0) S.qr[d0] = pack8(S.tq[2 * d0], S.tq[2 * d0 + 1]); }
    __syncthreads();
#undef RESC
#undef KBASE
#undef ACT
#undef MASKT
#undef SEAM_K0
#undef HALF_STEP
}
#undef ROW
#undef VMW
#undef VMWN
#undef SLOAD_H
#undef SWRITE_HK
#undef SWRITE_HV
#undef SWRITE_H
#undef SLOAD_F
#undef SWRITE_KF
#undef SWRITE_VF

}
typedef GAS unsigned gu32;
#define XB_TMO      128
#define XB_XCNT(j)  (256  + 64 * (j))
#define XB_XSUB(j)  (1280 + 64 * (j))
#define XB_XGEN(j)  (2304 + 64 * (j))
#define XB_TOP      3328
#define XB_TOPGEN   3392
#define XCD_BAR_WORDS 3456
#define XB_SPIN_CAP (1u << 18)

__device__ __forceinline__ unsigned xb_ld(unsigned* p)              { return __hip_atomic_load(p, __ATOMIC_RELAXED, __HIP_MEMORY_SCOPE_AGENT); }
__device__ __forceinline__ unsigned xb_add(unsigned* p, unsigned v) { return __hip_atomic_fetch_add(p, v, __ATOMIC_RELAXED, __HIP_MEMORY_SCOPE_AGENT); }
__device__ __forceinline__ unsigned xb_xcc_id() { return (unsigned)__builtin_amdgcn_s_getreg((3 << 11) | 20) & 0xFu; }
#define XB_SPIN(cond, bar) do { unsigned _sp = 0; while (cond) { __builtin_amdgcn_s_sleep(1); \
    if ((++_sp & 255u) == 0u) { if (xb_ld(&(bar)[XB_TMO])) break; if (_sp > XB_SPIN_CAP) { atomicAdd(&(bar)[XB_TMO], 1u); break; } } } } while (0)

struct XcdBarrier {
    unsigned* bar; unsigned x;
    volatile LAS unsigned* st;
};

__device__ __forceinline__ XcdBarrier xcd_barrier_post(unsigned* bar, volatile LAS unsigned* st) {
    XcdBarrier b; b.bar = bar; b.x = xb_xcc_id(); b.st = st;
    if (threadIdx.x == 0) (void)xb_add(&bar[XB_XCNT(b.x)], 1u);
    return b;
}
__device__ __forceinline__ void xcd_barrier_complete(unsigned* bar, unsigned x, unsigned& nloc, unsigned& nx) {
    const unsigned G = gridDim.x * gridDim.y * gridDim.z;
    unsigned sum, cnt, mine, sp = 0u;
    for (;;) {
        sum = 0u; cnt = 0u; mine = 0u;
#pragma unroll
        for (unsigned j = 0; j < 16; ++j) { const unsigned c = xb_ld(&bar[XB_XCNT(j)]); sum += c; cnt += (c > 0u) ? 1u : 0u; mine = (j == x) ? c : mine; }
        if (sum == G) break;
        __builtin_amdgcn_s_sleep(1);
        if ((++sp & 255u) == 0u) { if (xb_ld(&bar[XB_TMO])) break; if (sp > XB_SPIN_CAP) { atomicAdd(&bar[XB_TMO], 1u); break; } }
    }
    nloc = mine > 0u ? mine : 1u; nx = cnt > 0u ? cnt : 1u;
}

__device__ __forceinline__ void xcd_barrier(const XcdBarrier& b) {
    asm volatile("s_waitcnt vmcnt(0)" ::: "memory");
    __syncthreads();
    if (threadIdx.x == 0) {
        unsigned* bar = b.bar;
        __builtin_amdgcn_s_waitcnt(0);
        unsigned nloc = b.st[0], nx = b.st[1];
        if (nloc == 0u) { xcd_barrier_complete(bar, b.x, nloc, nx); b.st[0] = nloc; b.st[1] = nx; }
        const unsigned old = xb_add(&bar[XB_XSUB(b.x)], 1u);
        const unsigned gen = old / nloc;
        if (old + 1u == (gen + 1u) * nloc) {
            __builtin_amdgcn_fence(__ATOMIC_RELEASE, "agent");
            asm volatile("s_waitcnt vmcnt(0)" ::: "memory");
            const unsigned og = xb_add(&bar[XB_TOP], 1u);
            const unsigned tg = og / nx;
            if (og + 1u == (tg + 1u) * nx) xb_add(&bar[XB_TOPGEN], 1u);
            else XB_SPIN(xb_ld(&bar[XB_TOPGEN]) == tg, bar);
            __builtin_amdgcn_fence(__ATOMIC_ACQUIRE, "agent");
            xb_add(&bar[XB_XGEN(b.x)], 1u);
            asm volatile("s_waitcnt vmcnt(0)" ::: "memory");
        } else {
            XB_SPIN(xb_ld(&bar[XB_XGEN(b.x)]) == gen, bar);
            __builtin_amdgcn_fence(__ATOMIC_ACQUIRE, "agent");
            asm volatile("s_waitcnt vmcnt(0)" ::: "memory");
        }
    }
    __syncthreads();
}

constexpr int LDS_BYTES = 147456;
constexpr int MISC_OFF = LDS_BYTES - 256;
constexpr int NWAVES = 8;

struct Args { const void* in[23]; float* out; unsigned char* ws; int ph_lo, ph_hi; };
enum { I_X = 0, I_C, I_POS, I_WADA, I_BADA, I_WIN, I_CONVW, I_CONVB, I_WRGA, I_BRGA, I_WRGX, I_BRGX, I_LAM, I_KIDXG, I_WOUT, I_LN1G, I_LN1B, I_WPQ, I_SUBK, I_PU, I_PV, I_LN2G, I_LN2B };

struct Ctx { LAS unsigned char* lds; unsigned char* ws; int tid, lane, wave, bid, G, gw, ngw; };

__device__ __forceinline__ f32x4 mfma16(bf16x8 a, bf16x8 b, f32x4 c) { return __builtin_amdgcn_mfma_f32_16x16x32_bf16(a, b, c, 0, 0, 0); }
__device__ __forceinline__ f32x16 mfma32(bf16x8 a, bf16x8 b, f32x16 c) { return __builtin_amdgcn_mfma_f32_32x32x16_bf16(a, b, c, 0, 0, 0); }

__device__ __forceinline__ void transpose_item(const float* W, int K, int N, bf16* WT, LAS float* scr, int item, int lane) {
    const int nblk = (N + 31) / 32, kb = item / nblk, nb = item % nblk, k0 = 64 * kb, n0 = 32 * nb;
    const int nc = n0 + (lane & 31); const bool okc = nc < N;
#pragma unroll 8
    for (int i = 0; i < 32; ++i) { const int kk = 2 * i + (lane >> 5); scr[kk * 33 + (lane & 31)] = okc ? W[(size_t)(k0 + kk) * N + nc] : 0.f; }
    LDS_WAIT(); asm volatile("" ::: "memory");
    const int c = lane & 7;
#pragma unroll
    for (int j = 0; j < 4; ++j) { const int n = (lane >> 3) + 8 * j; const LAS float* s = scr + (8 * c) * 33 + n;
        v4u o; o.x = pk2(s[0 * 33], s[1 * 33]); o.y = pk2(s[2 * 33], s[3 * 33]); o.z = pk2(s[4 * 33], s[5 * 33]); o.w = pk2(s[6 * 33], s[7 * 33]);
        if (n0 + n < N) *(v4u*)(WT + (size_t)(n0 + n) * K + k0 + 8 * c) = o; }
    LDS_WAIT(); asm volatile("" ::: "memory");
}
__device__ __forceinline__ void convert_stream(const float* src, bf16* dst, size_t n, int gw, int ngw, int lane) {
    const size_t niter = n / 512;
#pragma unroll 4
    for (size_t i = gw; i < niter; i += ngw) { const size_t e = i * 512 + (size_t)lane * 8;
        const f32x4 a = *(const f32x4*)(src + e), b = *(const f32x4*)(src + e + 4);
        v4u o; o.x = pk2(a.x, a.y); o.y = pk2(a.z, a.w); o.z = pk2(b.x, b.y); o.w = pk2(b.z, b.w);
        *(v4u*)(dst + e) = o; }
}
__device__ __forceinline__ void p0_prologue(const Ctx& c, const Args& a) {
    const int tid = c.tid, lane = c.lane, gw = c.gw, ngw = c.ngw;
    LAS float* sl = (LAS float*)(c.lds + 8 * 8448);
    { const float* cc = (const float*)a.in[I_C];
      for (int i = tid; i < 2 * DM; i += 512) { const float v = cc[i]; sl[i] = v / (1.0f + __expf(-v)); } }
    __syncthreads();
    { const float* W = (const float*)a.in[I_WADA]; float* MODP = (float*)(c.ws + WS_MODP);
      for (int it = gw; it < 48 * 32; it += ngw) { const int cg = it % 48, ks = it / 48, col = cg * 256 + lane * 4, k0 = ks * 64;
          f32x4 a0 = {0.f, 0.f, 0.f, 0.f}, a1 = {0.f, 0.f, 0.f, 0.f};
#pragma unroll 8
          for (int kk = 0; kk < 64; ++kk) { const f32x4 w = *(const f32x4*)(W + (size_t)(k0 + kk) * (6 * DM) + col); const float s0 = sl[k0 + kk], s1 = sl[DM + k0 + kk]; a0 += w * s0; a1 += w * s1; }
          *(f32x4*)(MODP + ((size_t)ks * 2 + 0) * (6 * DM) + col) = a0; *(f32x4*)(MODP + ((size_t)ks * 2 + 1) * (6 * DM) + col) = a1; } }
    LAS float* scr = (LAS float*)(c.lds + c.wave * 8448);
    { constexpr int I_IN = (DM / 64) * ((DIN + 31) / 32), I_SQ = (DM / 64) * (DM / 32), I_G = 8 * 2 * 4;
      for (int it = gw; it < I_IN + 2 * I_SQ + 2 * I_G; it += ngw) { int r = it;
          if (r < I_IN) { transpose_item((const float*)a.in[I_WIN], DM, DIN, (bf16*)(c.ws + WS_WIN), scr, r, lane); continue; } r -= I_IN;
          if (r < I_SQ) { transpose_item((const float*)a.in[I_WOUT], DM, DM, (bf16*)(c.ws + WS_WOUT), scr, r, lane); continue; } r -= I_SQ;
          if (r < I_SQ) { transpose_item((const float*)a.in[I_WPQ], DM, DM, (bf16*)(c.ws + WS_WPQ), scr, r, lane); continue; } r -= I_SQ;
          if (r < I_G) { const int n = r / 8; transpose_item((const float*)a.in[I_WRGA] + n * 16384, 128, 128, (bf16*)(c.ws + WS_WRG) + n * 16384, scr, r % 8, lane); continue; } r -= I_G;
          { const int n = r / 8; transpose_item((const float*)a.in[I_WRGX] + n * 16384, 128, 128, (bf16*)(c.ws + WS_WRG) + (8 + n) * 16384, scr, r % 8, lane); } } }
    convert_stream((const float*)a.in[I_SUBK], (bf16*)(c.ws + WS_SUBK), (size_t)8 * 2 * 128 * 128, gw, ngw, lane);
    convert_stream((const float*)a.in[I_PU], (bf16*)(c.ws + WS_PU), (size_t)NEXP * DM, gw, ngw, lane);
    convert_stream((const float*)a.in[I_PV], (bf16*)(c.ws + WS_PV), (size_t)NEXP * DM, gw, ngw, lane);
    __syncthreads();
}

__device__ __forceinline__ void p1_u1(const Ctx& c, const Args& a) {
    const int tid = c.tid, lane = c.lane;
    const float* MODP = (const float*)(c.ws + WS_MODP); const float* bada = (const float*)a.in[I_BADA]; float* MODF = (float*)(c.ws + WS_MODF);
    { const int g = c.bid * 512 + tid;
      for (int e = g; e < 2 * 6 * DM; e += c.G * 512) { const int b = e / (6 * DM), j = e % (6 * DM); float s = bada[j];
          for (int ks = 0; ks < 32; ++ks) s += MODP[((size_t)ks * 2 + b) * (6 * DM) + j];
          MODF[e] = s; } }
    LAS float* ms = (LAS float*)c.lds;
    for (int i = tid; i < 2 * 2 * DM; i += 512) { const int b = i / (2 * DM), j = i % (2 * DM); float s = bada[j];
        for (int ks = 0; ks < 32; ++ks) s += MODP[((size_t)ks * 2 + b) * (6 * DM) + j];
        ms[i] = s; }
    __syncthreads();
    const float* x = (const float*)a.in[I_X]; bf16* U1 = (bf16*)(c.ws + WS_U1);
    for (int row = c.gw; row < NTOK; row += c.ngw) { const int b = row / SEQ;
        const f32x4* xr = (const f32x4*)(x + (size_t)row * DM) + lane;
        f32x4 v[8]; float s = 0.f;
#pragma unroll
        for (int j = 0; j < 8; ++j) { v[j] = xr[64 * j]; s += (v[j].x + v[j].y) + (v[j].z + v[j].w); }
        const float mean = wave_sum(s) * (1.f / DM); float s2 = 0.f;
#pragma unroll
        for (int j = 0; j < 8; ++j) { v[j] = v[j] - mean; s2 += (v[j].x * v[j].x + v[j].y * v[j].y) + (v[j].z * v[j].z + v[j].w * v[j].w); }
        const float rstd = 1.f / sqrtf(wave_sum(s2) * (1.f / DM) + LN_EPS);
#pragma unroll
        for (int j = 0; j < 8; ++j) { const int col = 4 * lane + 256 * j;
            const f32x4 sh = *(const LAS f32x4*)(ms + b * 4096 + col), sc = *(const LAS f32x4*)(ms + b * 4096 + DM + col);
            const f32x4 y = v[j] * rstd * (sc + 1.0f) + sh;
            v2u o; o.x = pk2(y.x, y.y); o.y = pk2(y.z, y.w);
            *(v2u*)(U1 + (size_t)row * DM + col) = o; }
    }
    __syncthreads();
}

__device__ __forceinline__ void p3_post(const Ctx& c, const Args& a) {
    const int tid = c.tid, lane = c.lane, wave = c.wave, fr = lane & 15, fq = lane >> 4;
    bf16* PROJ = (bf16*)(c.ws + WS_PROJ); const bf16* U1 = (const bf16*)(c.ws + WS_U1); const bf16* WinT = (const bf16*)(c.ws + WS_WIN);
    const int* pos = (const int*)a.in[I_POS];
    for (int it = c.bid; it < NTOK / 32; it += c.G) {
        const int t0 = it * 32, b = t0 / SEQ;
        LAS float* red = (LAS float*)c.lds;
        LAS float* kw = red + 8 * 32 * 80;
        LAS float* cst = kw + 32 * 80;
        { f32x4 acc[2][5];
#pragma unroll
          for (int m = 0; m < 2; ++m)
#pragma unroll
              for (int n = 0; n < 5; ++n) acc[m][n] = (f32x4){0.f, 0.f, 0.f, 0.f};
          for (int ks = 0; ks < 8; ++ks) { const int kb = wave * 256 + ks * 32 + 8 * fq;
              const bf16x8 a0 = *(const bf16x8*)(U1 + (size_t)(t0 + fr) * DM + kb), a1 = *(const bf16x8*)(U1 + (size_t)(t0 + 16 + fr) * DM + kb);
#pragma unroll
              for (int n = 0; n < 5; ++n) { const bf16x8 bb = *(const bf16x8*)(WinT + (size_t)(NMAIN + 16 * n + fr) * DM + kb);
                  acc[0][n] = mfma16(a0, bb, acc[0][n]); acc[1][n] = mfma16(a1, bb, acc[1][n]); } }
#pragma unroll
          for (int m = 0; m < 2; ++m)
#pragma unroll
              for (int n = 0; n < 5; ++n)
#pragma unroll
                  for (int r = 0; r < 4; ++r) red[(wave * 32 + 16 * m + 4 * fq + r) * 80 + 16 * n + fr] = acc[m][n][r]; }
        for (int i = tid; i < 32 * 24; i += 512) { const int tk = i / 24, j = i % 24;
            const float ex = j < 16 ? -(float)j / 16.0f : -(float)(j - 16) / 8.0f;
            const float inv = exp2f(ex * 18.931568569324174f);
            const float ang = (float)pos[t0 + tk] * inv;
            double rev = (double)ang * 0.15915494309189535; rev -= floor(rev);
            if (rev > 0.5) rev -= 1.0;
            const float rr = (float)(rev * 6.283185307179586);
            float sn, cs; sincosf(rr, &sn, &cs);
            cst[2 * i] = cs; cst[2 * i + 1] = sn; }
        __syncthreads();
        for (int i = tid; i < 32 * 80; i += 512) { float s = 0.f;
#pragma unroll
            for (int w = 0; w < 8; ++w) s += red[w * 2560 + i];
            kw[i] = s; }
        __syncthreads();
        if (tid < 32) { const int tk = tid; const LAS float* row = kw + tk * 80; const float* kg = (const float*)a.in[I_KIDXG];
            float s = 0.f;
            for (int d = 0; d < 64; ++d) s += row[d];
            const float mean = s * (1.f / 64.f); float s2 = 0.f;
            for (int d = 0; d < 64; ++d) { const float dv = row[d] - mean; s2 += dv * dv; }
            const float rstd = 1.f / sqrtf(s2 * (1.f / 64.f) + LN_EPS);
            bf16* ko = (bf16*)(c.ws + WS_KIDX) + (size_t)(t0 + tk) * 64;
            for (int d = 0; d < 8; ++d) { const float x1 = (row[d] - mean) * rstd * kg[d], x2 = (row[d + 8] - mean) * rstd * kg[d + 8];
                const float cs = cst[2 * (tk * 24 + 16 + d)], sn = cst[2 * (tk * 24 + 16 + d) + 1];
                ko[d] = (bf16)f2bf(x1 * cs - x2 * sn); ko[d + 8] = (bf16)f2bf(x2 * cs + x1 * sn); }
            for (int d = 16; d < 64; ++d) ko[d] = (bf16)f2bf((row[d] - mean) * rstd * kg[d]);
            float* wo = (float*)(c.ws + WS_WIDX) + (size_t)(t0 + tk) * 16;
            for (int h = 0; h < 16; ++h) wo[h] = row[64 + h] * (0.25f * 0.125f); }
        for (int i = tid; i < 32 * 8 * 16; i += 512) { const int tk = i >> 7, h = (i >> 4) & 7, d = i & 15;
            const float cs = cst[2 * (tk * 24 + d)], sn = cst[2 * (tk * 24 + d) + 1];
            bf16* p = PROJ + (size_t)(t0 + tk) * NMAIN + C_Q + h * 128 + d;
            { const float x1 = bf2f(p[0]), x2 = bf2f(p[16]); p[0] = (bf16)f2bf(x1 * cs - x2 * sn); p[16] = (bf16)f2bf(x2 * cs + x1 * sn); }
            p += (C_K - C_Q);
            { const float x1 = bf2f(p[0]), x2 = bf2f(p[16]); p[0] = (bf16)f2bf(x1 * cs - x2 * sn); p[16] = (bf16)f2bf(x2 * cs + x1 * sn); } }
        for (int i = tid; i < 32 * 16 * 8; i += 512) { const int tk = i >> 7, h = (i >> 3) & 15, d = i & 7;
            const float cs = cst[2 * (tk * 24 + 16 + d)], sn = cst[2 * (tk * 24 + 16 + d) + 1];
            bf16* p = PROJ + (size_t)(t0 + tk) * NMAIN + C_QI + h * 64 + d;
            const float x1 = bf2f(p[0]), x2 = bf2f(p[8]); p[0] = (bf16)f2bf(x1 * cs - x2 * sn); p[8] = (bf16)f2bf(x2 * cs + x1 * sn); }
        __syncthreads();
        { const int n = wave; LAS float* xcs = (LAS float*)c.lds + wave * (32 * 132);
          const float* convw = (const float*)a.in[I_CONVW]; const float* convb = (const float*)a.in[I_CONVB]; const bf16* WRG = (const bf16*)(c.ws + WS_WRG);
          const float* brga = (const float*)a.in[I_BRGA]; const float* brgx = (const float*)a.in[I_BRGX]; const float* lam = (const float*)a.in[I_LAM];
          float* AG = (float*)(c.ws + WS_AG); float* BG = (float*)(c.ws + WS_BG);
#pragma unroll 1
          for (int m = 0; m < 2; ++m) { const int tk = 16 * m + fr, tok = t0 + tk;
              f32x4 accA[8], accX[8];
#pragma unroll
              for (int nt = 0; nt < 8; ++nt) { accA[nt] = (f32x4){0.f, 0.f, 0.f, 0.f}; accX[nt] = (f32x4){0.f, 0.f, 0.f, 0.f}; }
#pragma unroll 1
              for (int ks = 0; ks < 4; ++ks) { int fq8 = 8 * fq; asm volatile("" : "+v"(fq8));
                  const int chl = ks * 32 + fq8, ch = n * 128 + chl;
                  f32x4 x0 = *(const f32x4*)(convb + ch), x1 = *(const f32x4*)(convb + ch + 4);
#pragma unroll
                  for (int j = 0; j < 4; ++j) { const int tt = tok - 3 + j;
                      if (tt >= b * SEQ) { const v4u raw = *(const v4u*)(PROJ + (size_t)tt * NMAIN + C_XL + ch);
                          const f32x4 w0 = *(const f32x4*)(convw + j * D_LRU + ch), w1 = *(const f32x4*)(convw + j * D_LRU + ch + 4);
                          x0.x += w0.x * bflo(raw.x); x0.y += w0.y * bfhi(raw.x); x0.z += w0.z * bflo(raw.y); x0.w += w0.w * bfhi(raw.y);
                          x1.x += w1.x * bflo(raw.z); x1.y += w1.y * bfhi(raw.z); x1.z += w1.z * bflo(raw.w); x1.w += w1.w * bfhi(raw.w); } }
                  *(LAS f32x4*)(xcs + tk * 132 + chl) = x0; *(LAS f32x4*)(xcs + tk * 132 + chl + 4) = x1;
                  v4u o; o.x = pk2(x0.x, x0.y); o.y = pk2(x0.z, x0.w); o.z = pk2(x1.x, x1.y); o.w = pk2(x1.z, x1.w);
                  const bf16x8 af = __builtin_bit_cast(bf16x8, o);
#pragma unroll
                  for (int nt = 0; nt < 8; ++nt) { const size_t wo = ((size_t)n * 128 + 16 * nt + fr) * 128 + ks * 32 + fq8;
                      const bf16x8 ba = *(const bf16x8*)(WRG + wo), bx = *(const bf16x8*)(WRG + (size_t)8 * 16384 + wo);
                      accA[nt] = mfma16(af, ba, accA[nt]); accX[nt] = mfma16(af, bx, accX[nt]); } }
              LDS_WAIT(); asm volatile("" ::: "memory");
#pragma unroll
              for (int nt = 0; nt < 8; ++nt) { const int chl = 16 * nt + fr, ch = n * 128 + chl;
                  const float ba_ = brga[ch], bx_ = brgx[ch], sp = log1pf(__expf(-lam[ch]));
#pragma unroll
                  for (int r = 0; r < 4; ++r) { const int tk2 = 16 * m + 4 * fq + r;
                      const float ra = sigmoidf_(accA[nt][r] + ba_), ix = sigmoidf_(accX[nt][r] + bx_);
                      const float la = -8.0f * ra * sp, av = __expf(la), bc = sqrtf(-expm1f(2.0f * la)), xv = xcs[tk2 * 132 + chl];
                      AG[(size_t)(t0 + tk2) * D_LRU + ch] = av; BG[(size_t)(t0 + tk2) * D_LRU + ch] = bc * ix * xv; } } } }
        __syncthreads();
    }
}

__device__ __forceinline__ void p4_lru_scan(const Ctx& c) {
    float* AG = (float*)(c.ws + WS_AG); float* BG = (float*)(c.ws + WS_BG); float* AGG = (float*)(c.ws + WS_AGG);
    for (int li = c.gw; li < 2048; li += c.ngw) { const int b = li >> 10, ck = (li >> 4) & 63, ch = (li & 15) * 64 + c.lane; const size_t base = ((size_t)b * SEQ + ck * 64) * D_LRU + ch;
        float h = 0.f, P = 1.f;
        for (int t8 = 0; t8 < 64; t8 += 8) { float av[8], bv[8];
#pragma unroll
            for (int t = 0; t < 8; ++t) { av[t] = AG[base + (size_t)(t8 + t) * D_LRU]; bv[t] = BG[base + (size_t)(t8 + t) * D_LRU]; }
#pragma unroll
            for (int t = 0; t < 8; ++t) { h = av[t] * h + bv[t]; P *= av[t]; av[t] = P; bv[t] = h; }
#pragma unroll
            for (int t = 0; t < 8; ++t) { AG[base + (size_t)(t8 + t) * D_LRU] = av[t]; BG[base + (size_t)(t8 + t) * D_LRU] = bv[t]; } }
        AGG[((size_t)(0 * 2 + b) * 64 + ck) * D_LRU + ch] = P; AGG[((size_t)(1 * 2 + b) * 64 + ck) * D_LRU + ch] = h; }
}

constexpr int IDX_ROWB = 144;
constexpr int IDX_TILE = 256, IDX_BUFB = IDX_TILE * IDX_ROWB;
__device__ __forceinline__ void p4_indexer_item(const Ctx& c, int b, int q0) {
    const int tid = c.tid, lane = c.lane, wave = c.wave, r32 = lane & 31, hh = lane >> 5;
    const bf16* PROJ = (const bf16*)(c.ws + WS_PROJ); const bf16* KIDX = (const bf16*)(c.ws + WS_KIDX); const float* WIDX = (const float*)(c.ws + WS_WIDX);
    const int n = 64 * (q0 / 64 + 1), ntile = (n + IDX_TILE - 1) / IDX_TILE, nj = n / 32;
    const int tokA = b * SEQ + q0 + 2 * wave, myq = tokA + ((r32 >> 2) & 1), myh = (r32 & 3) + 4 * (r32 >> 3);
    bf16x8 af[4];
#pragma unroll
    for (int s = 0; s < 4; ++s) af[s] = *(const bf16x8*)(PROJ + (size_t)myq * NMAIN + C_QI + myh * 64 + 16 * s + 8 * hh);
    float wv[16];
#pragma unroll
    for (int r = 0; r < 16; ++r) wv[r] = WIDX[(size_t)(tokA + hh) * 16 + r];
    const int skey = tid >> 1, shalf = tid & 1;
    const bf16* kbase = KIDX + (size_t)b * SEQ * 64;
    v4u st[4];
    auto stage_load = [&](int tile) { int key = tile * IDX_TILE + skey; key = key < SEQ ? key : SEQ - 1;
#pragma unroll
        for (int q = 0; q < 4; ++q) st[q] = *(const v4u*)(kbase + (size_t)key * 64 + shalf * 32 + 8 * q); };
    auto stage_write = [&](int buf) {
#pragma unroll
        for (int q = 0; q < 4; ++q) *(LAS v4u*)(c.lds + buf * IDX_BUFB + skey * IDX_ROWB + shalf * 64 + 16 * q) = st[q]; };
    unsigned key_[128];
    stage_load(0); stage_write(0); __syncthreads();
#pragma unroll
    for (int tile = 0; tile < 16; ++tile) {
        if (tile < ntile) {
            if (tile + 1 < ntile) stage_load(tile + 1);
            const LAS unsigned char* kb = c.lds + (tile & 1) * IDX_BUFB + r32 * IDX_ROWB + hh * 16;
#pragma unroll
            for (int jj = 0; jj < 8; ++jj) { const int j = tile * 8 + jj;
                if (j < nj) {
                    f32x16 acc = {};
#pragma unroll
                    for (int s = 0; s < 4; ++s) { const bf16x8 bb = *(const LAS bf16x8*)(kb + jj * 32 * IDX_ROWB + s * 32); acc = mfma32(af[s], bb, acc); }
                    float sc = 0.f;
#pragma unroll
                    for (int r = 0; r < 16; ++r) sc += wv[r] * fmaxf(acc[r], 0.f);
                    const unsigned u = __builtin_bit_cast(unsigned, sc);
                    key_[j] = (u & 0x80000000u) ? ~u : (u | 0x80000000u);
                } else key_[j] = 0u; }
            if (tile + 1 < ntile) stage_write((tile + 1) & 1);
            __syncthreads();
        } else {
#pragma unroll
            for (int jj = 0; jj < 8; ++jj) key_[tile * 8 + jj] = 0u;
        }
    }
    unsigned prefix = 0u;
    for (int bit = 31; bit >= 0; --bit) { const unsigned cand = prefix | (1u << bit); int cnt = 0;
#pragma unroll
        for (int g = 0; g < 8; ++g) if (g * 16 < nj) {
#pragma unroll
            for (int jj = 0; jj < 16; ++jj) cnt += (key_[g * 16 + jj] >= cand) ? 1 : 0; }
#pragma unroll
        for (int o = 1; o < 32; o <<= 1) cnt += __shfl_xor(cnt, o);
        if (cnt >= 256) prefix = cand; }
    unsigned wA0 = 0u, wA1 = 0u, wB0 = 0u, wB1 = 0u;
#define CMP16(x_) (((x_) & 0xFu) | (((x_) >> 4) & 0xF0u) | (((x_) >> 8) & 0xF00u) | (((x_) >> 12) & 0xF000u))
    const unsigned thr = prefix > 1u ? prefix : 1u;
#pragma unroll
    for (int g = 0; g < 8; ++g) if (g * 16 < nj) {
#pragma unroll
    for (int jj = 0; jj < 16; ++jj) { const int j = g * 16 + jj; const unsigned long long m = __ballot(key_[j] >= thr);
        const unsigned ma = (unsigned)m, mb = (unsigned)(m >> 32);
        const unsigned a0 = CMP16(ma) << (16 * (j & 1)), a1 = CMP16(ma >> 4) << (16 * (j & 1)), b0 = CMP16(mb) << (16 * (j & 1)), b1 = CMP16(mb >> 4) << (16 * (j & 1));
        const int idx = 2 * (j >> 1);
        if (idx < 64) { if (lane == idx) { wA0 |= a0; wB0 |= b0; } if (lane == idx + 1) { wA0 |= a1; wB0 |= b1; } }
        else { if (lane == idx - 64) { wA1 |= a0; wB1 |= b0; } if (lane == idx - 63) { wA1 |= a1; wB1 |= b1; } } } }
#undef CMP16
    unsigned* MASK = (unsigned*)(c.ws + WS_MASK);
    MASK[(size_t)tokA * 128 + lane] = wA0; MASK[(size_t)tokA * 128 + 64 + lane] = wA1;
    MASK[(size_t)(tokA + 1) * 128 + lane] = wB0; MASK[(size_t)(tokA + 1) * 128 + 64 + lane] = wB1;
    __syncthreads();
}
__device__ __forceinline__ void p4_indexer(const Ctx& c) {
    for (int w = c.bid; w < 256; w += c.G) { const int b = w & 1, p = w >> 1;
        p4_indexer_item(c, b, 16 * p); p4_indexer_item(c, b, 16 * (255 - p)); }
}

__device__ __forceinline__ void p5_lru_apply(const Ctx& c) {
    const float* AG = (const float*)(c.ws + WS_AG); const float* BG = (const float*)(c.ws + WS_BG); const float* AGG = (const float*)(c.ws + WS_AGG);
    const bf16* PROJ = (const bf16*)(c.ws + WS_PROJ); bf16* YMIX = (bf16*)(c.ws + WS_YMIX);
    for (int li = c.gw; li < 2048; li += c.ngw) { const int b = li >> 10, ck = (li >> 4) & 63, ch = (li & 15) * 64 + c.lane; const size_t tok0 = (size_t)b * SEQ + ck * 64;
        float hc = 0.f;
        for (int cc = 0; cc < ck; ++cc) hc = AGG[((size_t)(0 * 2 + b) * 64 + cc) * D_LRU + ch] * hc + AGG[((size_t)(1 * 2 + b) * 64 + cc) * D_LRU + ch];
#pragma unroll 8
        for (int t = 0; t < 64; ++t) { const size_t tok = tok0 + t; const float h = BG[tok * D_LRU + ch] + AG[tok * D_LRU + ch] * hc;
            const float gl = bf2f(PROJ[tok * NMAIN + C_GL + ch]);
            YMIX[tok * DM + ch] = (bf16)f2bf(h * gelu_tanh(gl)); } }
}
__device__ __forceinline__ void p5_attention(const Ctx& c) {
    typedef att::bf16 abf;
    const abf* PROJ = (const abf*)(c.ws + WS_PROJ); abf* YMIX = (abf*)(c.ws + WS_YMIX); const unsigned long long* MASK = (const unsigned long long*)(c.ws + WS_MASK);
    for (int w = c.bid; w < 256; w += c.G) {
        const int xcd = w & 7, slot = w >> 3, bh = xcd * 2 + (slot >> 4), x = 15 - (slot & 15), b = bh >> 3, h = bh & 7;
        att::BlockRef<abf, abf> cur;
        const size_t tokb = (size_t)b * SEQ, tok0 = tokb + (size_t)x * 256;
        cur.Q = PROJ + tok0 * NMAIN + C_Q + h * 128; cur.K = PROJ + tokb * NMAIN + C_K + h * 128; cur.V = PROJ + tokb * NMAIN + C_V + h * 128;
        cur.O = YMIX + tok0 * DM + D_LRU + h * 128; cur.M = MASK + tok0 * 64; cur.P0 = x * 256;
        att::Seam<abf> S;
        att::causal_swa_prime<abf, abf>(cur, 1 << 30, (char*)c.lds, S);
        att::causal_swa_block<abf, abf>(cur, cur, SEQ, 1 << 30, (char*)c.lds, S);
        VM_WAIT(); __syncthreads();
    }
}

__device__ __forceinline__ void p7_rows(const Ctx& c, const Args& a) {
    const int lane = c.lane;
    float* X1 = (float*)(c.ws + WS_X1); bf16* U2 = (bf16*)(c.ws + WS_U2); const float* MODF = (const float*)(c.ws + WS_MODF);
    const float* g1 = (const float*)a.in[I_LN1G]; const float* b1 = (const float*)a.in[I_LN1B];
    for (int row = c.gw; row < NTOK; row += c.ngw) { const int b = row / SEQ;
        f32x4* xr = (f32x4*)(X1 + (size_t)row * DM) + lane;
        f32x4 v[8]; float s = 0.f;
#pragma unroll
        for (int j = 0; j < 8; ++j) { v[j] = xr[64 * j]; s += (v[j].x + v[j].y) + (v[j].z + v[j].w); }
        float mean = wave_sum(s) * (1.f / DM), s2 = 0.f;
#pragma unroll
        for (int j = 0; j < 8; ++j) { v[j] = v[j] - mean; s2 += (v[j].x * v[j].x + v[j].y * v[j].y) + (v[j].z * v[j].z + v[j].w * v[j].w); }
        float rstd = 1.f / sqrtf(wave_sum(s2) * (1.f / DM) + LN_EPS);
        s = 0.f;
#pragma unroll
        for (int j = 0; j < 8; ++j) { const int col = 4 * lane + 256 * j;
            v[j] = v[j] * rstd * *(const f32x4*)(g1 + col) + *(const f32x4*)(b1 + col);
            xr[64 * j] = v[j]; s += (v[j].x + v[j].y) + (v[j].z + v[j].w); }
        mean = wave_sum(s) * (1.f / DM); s2 = 0.f;
#pragma unroll
        for (int j = 0; j < 8; ++j) { v[j] = v[j] - mean; s2 += (v[j].x * v[j].x + v[j].y * v[j].y) + (v[j].z * v[j].z + v[j].w * v[j].w); }
        rstd = 1.f / sqrtf(wave_sum(s2) * (1.f / DM) + LN_EPS);
#pragma unroll
        for (int j = 0; j < 8; ++j) { const int col = 4 * lane + 256 * j;
            const f32x4 sh = *(const f32x4*)(MODF + (size_t)b * (6 * DM) + 3 * DM + col), sc = *(const f32x4*)(MODF + (size_t)b * (6 * DM) + 4 * DM + col);
            const f32x4 y = v[j] * rstd * (sc + 1.0f) + sh;
            v2u o; o.x = pk2(y.x, y.y); o.y = pk2(y.z, y.w);
            *(v2u*)(U2 + (size_t)row * DM + col) = o; }
    }
}

__device__ __forceinline__ unsigned f2key(float f) { const unsigned u = __builtin_bit_cast(unsigned, f); return u ^ ((unsigned)((int)u >> 31) | 0x80000000u); }
__device__ __forceinline__ float key2f(unsigned k) { const unsigned u = (k & 0x80000000u) ? (k ^ 0x80000000u) : ~k; return __builtin_bit_cast(float, u); }
#define INSK(k_, T) do { _Pragma("unroll") for (int q_ = 0; q_ < 16; ++q_) { const unsigned t_ = T[q_]; const unsigned mx_ = t_ > k_ ? t_ : k_; const unsigned mn_ = t_ > k_ ? k_ : t_; T[q_] = mx_; k_ = mn_; } } while (0)
__device__ __forceinline__ float wave_sum_u(float v) {
    v += __builtin_bit_cast(float, __builtin_amdgcn_mov_dpp(__builtin_bit_cast(int, v), 0xB1, 0xf, 0xf, true));
    v += __builtin_bit_cast(float, __builtin_amdgcn_mov_dpp(__builtin_bit_cast(int, v), 0x4E, 0xf, 0xf, true));
    v += __builtin_bit_cast(float, __builtin_amdgcn_mov_dpp(__builtin_bit_cast(int, v), 0x141, 0xf, 0xf, true));
    v += __builtin_bit_cast(float, __builtin_amdgcn_mov_dpp(__builtin_bit_cast(int, v), 0x140, 0xf, 0xf, true));
    const int iv = __builtin_bit_cast(int, v);
    return (__builtin_bit_cast(float, __builtin_amdgcn_readlane(iv, 0)) + __builtin_bit_cast(float, __builtin_amdgcn_readlane(iv, 16)))
         + (__builtin_bit_cast(float, __builtin_amdgcn_readlane(iv, 32)) + __builtin_bit_cast(float, __builtin_amdgcn_readlane(iv, 48)));
}
__device__ __forceinline__ float dot2bf(unsigned a, unsigned b, float c) {
    c = fmaf(bflo(a), bflo(b), c); return fmaf(bfhi(a), bfhi(b), c);
}
__device__ __forceinline__ void p9_peer(const Ctx& c, const Args& a) {
    const int lane = c.lane, wave = c.wave, fr = lane & 15, fq = lane >> 4;
    const bf16* QP = (const bf16*)(c.ws + WS_QP); const bf16* SUBK = (const bf16*)(c.ws + WS_SUBK); const bf16* U2 = (const bf16*)(c.ws + WS_U2);
    const bf16* PU = (const bf16*)(c.ws + WS_PU); const bf16* PV = (const bf16*)(c.ws + WS_PV); const float* X1 = (const float*)(c.ws + WS_X1);
    const float* MODF = (const float*)(c.ws + WS_MODF); const float* g2 = (const float*)a.in[I_LN2G]; const float* b2 = (const float*)a.in[I_LN2B];
    int* EIDX = (int*)(c.ws + WS_U1); float* PGW = (float*)(c.ws + WS_U1 + 4 * MiB);
    for (int it = c.bid; it < NTOK / 32; it += c.G) {
        const int t0 = it * 32;
#ifndef P9_NOROUTE
        { LAS float* sb = (LAS float*)c.lds + wave * (32 * 129); const int h = wave;
#pragma unroll 1
          for (int m = 0; m < 2; ++m) {
              int fq8 = 8 * fq; asm volatile("" : "+v"(fq8));
              { f32x4 acc[2][8];
#pragma unroll
                for (int p = 0; p < 2; ++p)
#pragma unroll
                    for (int nt = 0; nt < 8; ++nt) acc[p][nt] = (f32x4){0.f, 0.f, 0.f, 0.f};
#pragma unroll
                for (int p = 0; p < 2; ++p)
#pragma unroll
                    for (int ks = 0; ks < 4; ++ks) { const bf16x8 av = *(const bf16x8*)(QP + (size_t)(t0 + 16 * m + fr) * DM + h * 256 + p * 128 + ks * 32 + fq8);
#pragma unroll
                        for (int nt = 0; nt < 8; ++nt) { const bf16x8 bv = *(const bf16x8*)(SUBK + ((size_t)(h * 2 + p) * 128 + 16 * nt + fr) * 128 + ks * 32 + fq8);
                            acc[p][nt] = mfma16(av, bv, acc[p][nt]); } }
#pragma unroll
                for (int p = 0; p < 2; ++p)
#pragma unroll
                    for (int nt = 0; nt < 8; ++nt)
#pragma unroll
                        for (int r = 0; r < 4; ++r) sb[(p * 16 + 4 * fq + r) * 129 + 16 * nt + fr] = acc[p][nt][r]; }
              LDS_WAIT(); asm volatile("" ::: "memory");
              unsigned T[16];
#pragma unroll
              for (int q = 0; q < 16; ++q) T[q] = 0u;
              { const int half = lane >> 5; const LAS float* row = sb + (lane & 31) * 129 + half * 64;
#pragma unroll 4
                for (int k = 0; k < 64; ++k) { unsigned key = (f2key(row[k]) & 0xFFFFFF80u) | (unsigned)(127 - (half * 64 + k)); INSK(key, T); } }
              { unsigned P[16];
#pragma unroll
                for (int q = 0; q < 16; ++q) P[q] = (unsigned)__shfl_xor((int)T[q], 32);
#pragma unroll
                for (int q = 0; q < 16; ++q) { unsigned key = P[q]; INSK(key, T); } }
              unsigned T2[16];
#pragma unroll
              for (int q = 0; q < 16; ++q) T2[q] = (unsigned)__shfl((int)T[q], (lane & 15) + 16);
              LDS_WAIT(); asm volatile("" ::: "memory");
              LAS int* ib = (LAS int*)sb;
              if (lane < 16) {
#pragma unroll
                  for (int q = 0; q < 16; ++q) { ib[lane * 33 + q] = 127 - (int)(T[q] & 0x7Fu); ib[lane * 33 + 16 + q] = 127 - (int)(T2[q] & 0x7Fu); } }
              float f1[16], f2[16];
#pragma unroll
              for (int q = 0; q < 16; ++q) { f1[q] = key2f(T[q] & 0xFFFFFF80u); f2[q] = key2f(T2[q] & 0xFFFFFF80u); }
              unsigned C[16];
#pragma unroll
              for (int q = 0; q < 16; ++q) C[q] = 0u;
#pragma unroll
              for (int a_ = 0; a_ < 16; ++a_)
#pragma unroll
                  for (int b_ = 0; b_ < 16; ++b_) if ((a_ + 1) * (b_ + 1) <= 16) { unsigned key = (f2key(f1[a_] + f2[b_]) & 0xFFFFFF00u) | (unsigned)(255 - (a_ * 16 + b_)); INSK(key, C); }
              LDS_WAIT(); asm volatile("" ::: "memory");
              if (lane < 16) {
                  const float mx = key2f(C[0] & 0xFFFFFF00u); float ev[16], sum = 0.f;
#pragma unroll
                  for (int q = 0; q < 16; ++q) { ev[q] = __expf(key2f(C[q] & 0xFFFFFF00u) - mx); sum += ev[q]; }
                  const float rs = 1.0f / sum;
#pragma unroll
                  for (int q = 0; q < 16; ++q) { const int code = 255 - (int)(C[q] & 0xFFu);
                      const int eid = ib[lane * 33 + (code >> 4)] * 128 + ib[lane * 33 + 16 + (code & 15)];
                      EIDX[(size_t)(t0 + 16 * m + lane) * 128 + h * 16 + q] = eid; PGW[(size_t)(t0 + 16 * m + lane) * 128 + h * 16 + q] = ev[q] * rs; } }
              LDS_WAIT(); asm volatile("" ::: "memory");
          } }
#endif
        VM_WAIT(); __syncthreads();
#ifndef P9_NOGATHER
#pragma unroll 1
        for (int i4 = 0; i4 < 4; ++i4) { const int tok = t0 + wave * 4 + i4, b = tok / SEQ;
            int l8 = 8 * lane; asm volatile("" : "+v"(l8));
            v4u uu[4];
#pragma unroll
            for (int j = 0; j < 4; ++j) uu[j] = *(const v4u*)(U2 + (size_t)tok * DM + 512 * j + l8);
            f32x4 acc[4][2];
#pragma unroll
            for (int j = 0; j < 4; ++j) { acc[j][0] = (f32x4){0.f, 0.f, 0.f, 0.f}; acc[j][1] = (f32x4){0.f, 0.f, 0.f, 0.f}; }
#pragma unroll 1
            for (int hf = 0; hf < 2; ++hf) {
                const int myi = EIDX[(size_t)tok * 128 + hf * 64 + lane]; const float myg = PGW[(size_t)tok * 128 + hf * 64 + lane];
#pragma unroll 1
                for (int e2 = 0; e2 < 64; e2 += 2) {
                    const int ex0 = __builtin_amdgcn_readlane(myi, e2), ex1 = __builtin_amdgcn_readlane(myi, e2 + 1);
                    const float g0 = __builtin_bit_cast(float, __builtin_amdgcn_readlane(__builtin_bit_cast(int, myg), e2)), g1 = __builtin_bit_cast(float, __builtin_amdgcn_readlane(__builtin_bit_cast(int, myg), e2 + 1));
                    v4u ra[4], rb[4];
#pragma unroll
                    for (int j = 0; j < 4; ++j) { ra[j] = *(const v4u*)(PU + (size_t)ex0 * DM + 512 * j + l8); rb[j] = *(const v4u*)(PU + (size_t)ex1 * DM + 512 * j + l8); }
                    __builtin_amdgcn_sched_barrier(0);
                    float d0 = 0.f, d1 = 0.f;
#pragma unroll
                    for (int j = 0; j < 4; ++j) { d0 = dot2bf(ra[j].x, uu[j].x, d0); d0 = dot2bf(ra[j].y, uu[j].y, d0); d0 = dot2bf(ra[j].z, uu[j].z, d0); d0 = dot2bf(ra[j].w, uu[j].w, d0);
                                                  d1 = dot2bf(rb[j].x, uu[j].x, d1); d1 = dot2bf(rb[j].y, uu[j].y, d1); d1 = dot2bf(rb[j].z, uu[j].z, d1); d1 = dot2bf(rb[j].w, uu[j].w, d1); }
                    __builtin_amdgcn_sched_barrier(0);
#pragma unroll
                    for (int j = 0; j < 4; ++j) { ra[j] = *(const v4u*)(PV + (size_t)ex0 * DM + 512 * j + l8); rb[j] = *(const v4u*)(PV + (size_t)ex1 * DM + 512 * j + l8); }
                    __builtin_amdgcn_sched_barrier(0);
                    const float h0 = g0 * gelu_tanh(wave_sum_u(d0)), h1 = g1 * gelu_tanh(wave_sum_u(d1));
                    __builtin_amdgcn_sched_barrier(0);
#pragma unroll
                    for (int j = 0; j < 4; ++j) { { const v4u r = ra[j];
                            acc[j][0].x += h0 * bflo(r.x); acc[j][0].y += h0 * bfhi(r.x); acc[j][0].z += h0 * bflo(r.y); acc[j][0].w += h0 * bfhi(r.y);
                            acc[j][1].x += h0 * bflo(r.z); acc[j][1].y += h0 * bfhi(r.z); acc[j][1].z += h0 * bflo(r.w); acc[j][1].w += h0 * bfhi(r.w); }
                        { const v4u r = rb[j];
                            acc[j][0].x += h1 * bflo(r.x); acc[j][0].y += h1 * bfhi(r.x); acc[j][0].z += h1 * bflo(r.y); acc[j][0].w += h1 * bfhi(r.y);
                            acc[j][1].x += h1 * bflo(r.z); acc[j][1].y += h1 * bfhi(r.z); acc[j][1].z += h1 * bflo(r.w); acc[j][1].w += h1 * bfhi(r.w); } }
                    __builtin_amdgcn_sched_barrier(0);
                } }
            float s = 0.f;
#pragma unroll
            for (int j = 0; j < 4; ++j)
#pragma unroll
                for (int w = 0; w < 2; ++w) { const int col = 512 * j + l8 + 4 * w;
                    const f32x4 xv = *(const f32x4*)(X1 + (size_t)tok * DM + col), gt = *(const f32x4*)(MODF + (size_t)b * (6 * DM) + 5 * DM + col);
                    acc[j][w] = xv * DN_ALPHA + (gt + 1.0f) * acc[j][w];
                    s += (acc[j][w].x + acc[j][w].y) + (acc[j][w].z + acc[j][w].w); }
            const float mean = wave_sum_u(s) * (1.f / DM); float s2 = 0.f;
#pragma unroll
            for (int j = 0; j < 4; ++j)
#pragma unroll
                for (int w = 0; w < 2; ++w) { acc[j][w] = acc[j][w] - mean; s2 += (acc[j][w].x * acc[j][w].x + acc[j][w].y * acc[j][w].y) + (acc[j][w].z * acc[j][w].z + acc[j][w].w * acc[j][w].w); }
            const float rstd = 1.f / sqrtf(wave_sum_u(s2) * (1.f / DM) + LN_EPS);
#pragma unroll
            for (int j = 0; j < 4; ++j)
#pragma unroll
                for (int w = 0; w < 2; ++w) { const int col = 512 * j + l8 + 4 * w;
                    *(f32x4*)(a.out + (size_t)tok * DM + col) = acc[j][w] * rstd * *(const f32x4*)(g2 + col) + *(const f32x4*)(b2 + col); }
        }
#endif
        __syncthreads();
    }
}

#ifndef MK_SINGLE
#define MK_SINGLE 1
#endif
constexpr int NPHASE = 10;
constexpr int CW_BAR = 4096;

__global__ void __launch_bounds__(NWAVES * 64, 2) fwd_kernel(Args args) {
    extern __shared__ __attribute__((aligned(16))) unsigned char lds_raw[];
    Ctx c;
    c.lds = (LAS unsigned char*)lds_raw; c.ws = args.ws;
    c.tid = threadIdx.x; c.lane = c.tid & 63; c.wave = __builtin_amdgcn_readfirstlane(c.tid >> 6);
    c.bid = blockIdx.x; c.G = gridDim.x; c.gw = c.bid * NWAVES + c.wave; c.ngw = c.G * NWAVES;
    volatile LAS unsigned* MISC = (volatile LAS unsigned*)(c.lds + MISC_OFF);
    if (c.tid < 64) MISC[c.tid] = 0u;
    __syncthreads();
    const int lo = args.ph_lo, hi = args.ph_hi;
    XcdBarrier bar; bar.bar = (unsigned*)(c.ws + WS_CTL) + CW_BAR; bar.x = 0; bar.st = nullptr;
    if (hi - lo > 1) bar = xcd_barrier_post((unsigned*)(c.ws + WS_CTL) + CW_BAR, MISC + 8);
#ifdef ONLY
#define IN(k) ((k) == ONLY)
#else
#define IN(k) (lo <= (k) && (k) < hi)
#endif
#define SEAM(k) do { if (IN(k) && IN((k) + 1)) xcd_barrier(bar); } while (0)

    if (IN(0)) { p0_prologue(c, args); } SEAM(0);
    if (IN(1)) { p1_u1(c, args); } SEAM(1);
    if (IN(2)) {
        pg8::Gemm g{(const pg8::bf16_t*)(c.ws + WS_U1), (const pg8::bf16_t*)(c.ws + WS_WIN), NTOK, NMAIN, DM}; pg8::StaticOrder S; S.init(NTOK, NMAIN, c.G, c.bid);
        pg8::EpiBf16<0> E{(pg8::bf16_t*)(c.ws + WS_PROJ), NMAIN, nullptr, 0, 0, 1.f};
        pg8::gemm_phase<pg8::EpiBf16<0>, pg8::StaticOrder, true, true>(c.lds, g, S, E);
    } SEAM(2);
    if (IN(3)) { p3_post(c, args); } SEAM(3);
    if (IN(4)) { p4_lru_scan(c); p4_indexer(c); } SEAM(4);
    if (IN(5)) { p5_lru_apply(c); p5_attention(c); } SEAM(5);
    if (IN(6)) {
        pg8::Gemm g{(const pg8::bf16_t*)(c.ws + WS_YMIX), (const pg8::bf16_t*)(c.ws + WS_WOUT), NTOK, DM, DM}; pg8::StaticOrder S; S.init(NTOK, DM, c.G, c.bid);
        pg8::EpiResF32 E{(const float*)args.in[I_X], (float*)(c.ws + WS_X1), (const float*)(c.ws + WS_MODF) + 2 * DM, DM, SEQ, 6 * DM, DN_ALPHA};
        pg8::gemm_phase<pg8::EpiResF32, pg8::StaticOrder, true, true>(c.lds, g, S, E);
    } SEAM(6);
    if (IN(7)) { p7_rows(c, args); } SEAM(7);
    if (IN(8)) {
        pg8::Gemm g{(const pg8::bf16_t*)(c.ws + WS_U2), (const pg8::bf16_t*)(c.ws + WS_WPQ), NTOK, DM, DM}; pg8::StaticOrder S; S.init(NTOK, DM, c.G, c.bid);
        pg8::EpiBf16<0> E{(pg8::bf16_t*)(c.ws + WS_QP), DM, nullptr, 0, 0, 1.f};
        pg8::gemm_phase<pg8::EpiBf16<0>, pg8::StaticOrder, true, true>(c.lds, g, S, E);
    } SEAM(8);
    if (IN(9)) { p9_peer(c, args); }
#undef IN
#undef SEAM
}

extern "C" void kernel_launch(void* const* d_in, const int* in_sizes, int n_in, void* d_out, int out_size, void* d_ws, size_t ws_size, hipStream_t stream) {
    static int grid = 0;
    if (grid == 0) {
        if (n_in != 23 || in_sizes[0] != NTOK * DM || out_size != NTOK * DM || ws_size < WS_END) {
            fprintf(stderr, "kernel_launch: unexpected shapes (n_in %d, in0 %d, out %d, ws %zu); nothing launched\n", n_in, n_in > 0 ? in_sizes[0] : -1, out_size, ws_size); grid = -1; return; }
        int dev = 0, cus = 0, per_cu = 0;
        if (hipGetDevice(&dev) != hipSuccess || hipDeviceGetAttribute(&cus, hipDeviceAttributeMultiprocessorCount, dev) != hipSuccess) { grid = -1; return; }
        if (hipFuncSetAttribute((const void*)fwd_kernel, hipFuncAttributeMaxDynamicSharedMemorySize, LDS_BYTES) != hipSuccess) { fprintf(stderr, "kernel_launch: hipFuncSetAttribute failed\n"); grid = -1; return; }
        if (hipOccupancyMaxActiveBlocksPerMultiprocessor(&per_cu, (const void*)fwd_kernel, NWAVES * 64, LDS_BYTES) != hipSuccess || per_cu < 1) { fprintf(stderr, "kernel_launch: occupancy query says %d\n", per_cu); }
        (void)hipGetLastError();
        grid = cus;
    }
    if (grid < 0) return;
    (void)hipMemsetAsync((char*)d_ws + WS_CTL, 0, CTL_ZERO_BYTES, stream);
    Args a{};
    for (int i = 0; i < 23; ++i) a.in[i] = d_in[i];
    a.out = (float*)d_out; a.ws = (unsigned char*)d_ws;
#if MK_SINGLE
    a.ph_lo = 0; a.ph_hi = NPHASE;
    hipLaunchKernelGGL(fwd_kernel, dim3(grid), dim3(NWAVES * 64), LDS_BYTES, stream, a);
#else
    for (int p = 0; p < NPHASE; ++p) { a.ph_lo = p; a.ph_hi = p + 1; hipLaunchKernelGGL(fwd_kernel, dim3(grid), dim3(NWAVES * 64), LDS_BYTES, stream, a); }
#endif
}
```

```cpp
#include <hip/hip_runtime.h>
#include <hip/hip_bf16.h>
#include <cstdio>
#include <cstdint>
#include <cmath>
#ifndef REP_PHASE
#define REP_PHASE -1
#endif
#define NREP(k) ((k) == REP_PHASE ? 2 : 1)

constexpr int NB = 2, SEQ = 4096, NTOK = NB * SEQ, DM = 2048;
constexpr int D_LRU = 1024, D_ATT = 1024, NHEAD = 8, HDIM = 128, NIH = 16, IDIM = 64;
constexpr int DIN = 6224, NMAIN = 6144;
constexpr int C_XL = 0, C_GL = 1024, C_Q = 2048, C_K = 3072, C_V = 4096, C_QI = 5120, C_KI = 6144, C_WI = 6208;
constexpr int NEXP = 16384, PKD = 256, PTOPK = 16, PHEADS = 8, NKEYS = 128;
constexpr float LN_EPS = 1e-5f;
constexpr float DN_ALPHA = 1.189207115002721f;

constexpr size_t MiB = 1u << 20;
constexpr size_t WS_CTL = 0, CTL_ZERO_BYTES = 1 * MiB;
constexpr size_t WS_MODP = 1 * MiB;
constexpr size_t WS_MODF = 4 * MiB;
constexpr size_t WS_PUS = 4 * MiB + 256 * 1024, WS_PVS = 4 * MiB + 512 * 1024;
constexpr size_t WS_WRG  = 5 * MiB;
constexpr size_t WS_SUBK = 6 * MiB;
constexpr size_t WS_KIDX = 7 * MiB;
constexpr size_t WS_WIDX = 8 * MiB;
constexpr size_t WS_AGG  = 9 * MiB;
constexpr size_t WS_MASK = 10 * MiB;
constexpr size_t WS_WIN  = 14 * MiB;
constexpr size_t WS_WOUT = 40 * MiB;
constexpr size_t WS_WPQ  = 48 * MiB;
constexpr size_t WS_PU   = 56 * MiB;
constexpr size_t WS_PV   = 120 * MiB;
constexpr size_t WS_U1   = 184 * MiB;
constexpr size_t WS_PROJ = 216 * MiB;
constexpr size_t WS_AG   = 312 * MiB;
constexpr size_t WS_BG   = 344 * MiB;
constexpr size_t WS_END  = 376 * MiB;
constexpr size_t WS_YMIX = WS_U1, WS_X1 = WS_PROJ, WS_U2 = WS_PROJ + 64 * MiB, WS_QP = WS_AG;

#define GAS __attribute__((address_space(1)))
#define LAS __attribute__((address_space(3)))
typedef unsigned short bf16;
typedef unsigned v4u __attribute__((ext_vector_type(4)));
typedef unsigned v2u __attribute__((ext_vector_type(2)));
typedef float f32x4 __attribute__((ext_vector_type(4)));
typedef float f32x2 __attribute__((ext_vector_type(2)));
typedef float f32x16 __attribute__((ext_vector_type(16)));
typedef short bf16x8 __attribute__((ext_vector_type(8)));
typedef short s16x4 __attribute__((ext_vector_type(4)));
#define RLX_AGENT __ATOMIC_RELAXED, __HIP_MEMORY_SCOPE_AGENT
#define LDS_WAIT() asm volatile("s_waitcnt lgkmcnt(0)" ::: "memory")
#define VM_WAIT() asm volatile("s_waitcnt vmcnt(0)" ::: "memory")
__device__ __forceinline__ unsigned f2bf(float f) { unsigned u = __builtin_bit_cast(unsigned, f); return (u + 0x7fffu + ((u >> 16) & 1u)) >> 16; }
__device__ __forceinline__ unsigned pk2(float lo, float hi) { return f2bf(lo) | (f2bf(hi) << 16); }
__device__ __forceinline__ float bflo(unsigned w) { return __builtin_bit_cast(float, w << 16); }
__device__ __forceinline__ float bfhi(unsigned w) { return __builtin_bit_cast(float, w & 0xffff0000u); }
__device__ __forceinline__ float bf2f(bf16 h) { return __builtin_bit_cast(float, (unsigned)h << 16); }
__device__ __forceinline__ float wave_sum(float v) {
#pragma unroll
    for (int o = 1; o < 64; o <<= 1) v += __shfl_xor(v, o);
    return v;
}
__device__ __forceinline__ float sigmoidf_(float x) { return 1.0f / (1.0f + __expf(-x)); }
__device__ __forceinline__ float gelu_tanh(float x) {
    const float u = 1.5957691216057308f * (x + 0.044715f * x * x * x);
    return x / (1.0f + __expf(-u));
}
namespace pg8 {
#define PG8_LAS __attribute__((address_space(3)))
typedef unsigned short bf16_t;
typedef short bf16x8 __attribute__((ext_vector_type(8)));
typedef float f32x4 __attribute__((ext_vector_type(4)));
typedef unsigned u32x4 __attribute__((ext_vector_type(4)));
constexpr int BM = 256, BK = 64, HALF = 128, HTB = HALF * BK * 2  , STAGE_BYTES = 8 * HTB, NXCD = 8, WGM = 8;

__host__ __device__ __forceinline__ int lds_byte(int r, int c) { const int st = (r >> 4) * 2 + (c >> 5), rr = r & 15, cc = c & 31, ob = rr * 64 + cc * 2; return st * 1024 + (ob ^ (((ob >> 9) & 1) << 5)); }
__host__ __device__ __forceinline__ void stage_rc(int b, int& R, int& C) { const int st = b / 1024, sb = b % 1024, swz = sb ^ (((sb >> 9) & 1) << 5); R = (st >> 1) * 16 + swz / 64; C = (st & 1) * 32 + (swz % 64) / 2; }
__host__ __device__ __forceinline__ int perm32(int rho) { const int n = rho >> 4, i = rho & 15; return 8 * (i >> 2) + 4 * n + (i & 3); }

struct Unit { int pm, pn; };
struct Gemm { const bf16_t* A; const bf16_t* Bt; int M, N, K; };

struct StaticOrder {
    int nM, nN, nwg, G, c;
    __host__ __device__ void init(int M, int N, int G_, int c_) { nM = M / BM; nN = N / BM; nwg = nM * nN; G = G_; c = c_; }
    __host__ __device__ bool next(int i, Unit& u) const {
        const long L = (long)i * G + c; if (L >= nwg) return false;
        int wgid = (int)L; { const int q = nwg / NXCD, r = nwg % NXCD, xcd = wgid % NXCD, off = wgid / NXCD; wgid = (xcd < r ? xcd * (q + 1) : r * (q + 1) + (xcd - r) * q) + off; }
        const int nig = WGM * nN, gid = wgid / nig, fm = gid * WGM, gsz = (nM - fm) < WGM ? (nM - fm) : WGM;
        u.pm = fm + ((wgid % nig) % gsz); u.pn = (wgid % nig) / gsz; return true;
    }
    __device__ __forceinline__ void a_ready(const Unit&) const {}
    __device__ __forceinline__ void done(const Unit&) const {}
};

__device__ __forceinline__ unsigned cvt_pk_bf16(float lo, float hi) { unsigned r; asm volatile("v_cvt_pk_bf16_f32 %0, %1, %2" : "=v"(r) : "v"(lo), "v"(hi)); return r; }
typedef float f32x2 __attribute__((ext_vector_type(2)));
__device__ __forceinline__ f32x2 gelu_pk(f32x2 v) {
    const f32x2 av = __builtin_elementwise_abs(v), d = av * 0.2316418882f + 1.0f;
    f32x2 t; t.x = __builtin_amdgcn_rcpf(d.x); t.y = __builtin_amdgcn_rcpf(d.y);
    f32x2 q = t * 0.5307027145f + (-0.7265760135f); q = q * t + 0.7107068705f; q = q * t + (-0.142248368f); q = q * t + 0.127414796f; q = q * t;
    const f32x2 s = (v * v) * (-0.72134752044f);
    f32x2 e; e.x = __builtin_amdgcn_exp2f(s.x); e.y = __builtin_amdgcn_exp2f(s.y);
    const f32x2 m = v * (q * e), r = v - m;
    f32x2 o; o.x = v.x < 0.f ? m.x : r.x; o.y = v.y < 0.f ? m.y : r.y; return o;
}

template <int ACT  > struct EpiBf16 {
    static constexpr bool PERM = true, AFTER_DRAIN = false; static_assert(ACT == 0 || ACT == 1, "EpiBf16: ACT is 0 (none) or 1 (gelu_pk)");
    bf16_t* O; int ldc; const float* bias; int split_cols; size_t split_stride; float scale0;
    __device__ __forceinline__ void operator()(const f32x4 (&acc)[2][2][4][2], const Unit& u, int wr, int wc, int fr, int fq) const {
        const int row0 = u.pm * BM + wr * 64 + fr; int colt = u.pn * BM; bf16_t* base = O;
        float sc = 1.f; if (split_cols) { const int t = colt / split_cols; base += (size_t)t * split_stride; colt -= t * split_cols; if (t == 0) sc = scale0; }
        const int col0 = colt + wc * 32 + 8 * fq, bcol0 = u.pn * BM + wc * 32 + 8 * fq;
        f32x4 bv[2][2];
#pragma unroll
        for (int bj = 0; bj < 2; ++bj)
#pragma unroll
            for (int n = 0; n < 2; ++n) bv[bj][n] = bias ? *(const f32x4*)(bias + bcol0 + bj * HALF + 4 * n) : (f32x4){0.f, 0.f, 0.f, 0.f};
#pragma unroll
        for (int ai = 0; ai < 2; ++ai)
#pragma unroll
            for (int m = 0; m < 4; ++m) { bf16_t* rowp = base + (size_t)(row0 + ai * HALF + m * 16) * ldc + col0;
#pragma unroll
                for (int bj = 0; bj < 2; ++bj) { f32x4 v0 = acc[ai][bj][m][0] + bv[bj][0], v1 = acc[ai][bj][m][1] + bv[bj][1];
                    if (ACT == 1) { f32x2 a = gelu_pk((f32x2){v0[0], v0[1]}), b = gelu_pk((f32x2){v0[2], v0[3]}), c = gelu_pk((f32x2){v1[0], v1[1]}), d = gelu_pk((f32x2){v1[2], v1[3]});
                        v0 = (f32x4){a.x, a.y, b.x, b.y}; v1 = (f32x4){c.x, c.y, d.x, d.y}; }
                    v0 = v0 * sc; v1 = v1 * sc; u32x4 w; w.x = cvt_pk_bf16(v0[0], v0[1]); w.y = cvt_pk_bf16(v0[2], v0[3]); w.z = cvt_pk_bf16(v1[0], v1[1]); w.w = cvt_pk_bf16(v1[2], v1[3]);
                    *(u32x4*)(rowp + bj * HALF) = w; } }
    }
};

struct EpiResF32 {
    static constexpr bool PERM = false, AFTER_DRAIN = false;
    const float* X; float* Z; const float* gate; int ldc, rows_per_batch, gstride; float alpha;
    __device__ __forceinline__ void operator()(const f32x4 (&acc)[2][2][4][2], const Unit& u, int wr, int wc, int fr, int fq) const {
        const int row0 = u.pm * BM + wr * 64 + fr, col0 = u.pn * BM + wc * 32 + 4 * fq;
        const float* gb = gate + (size_t)((u.pm * BM) / rows_per_batch) * gstride;
        f32x4 gv[2][2];
#pragma unroll
        for (int bj = 0; bj < 2; ++bj)
#pragma unroll
            for (int n = 0; n < 2; ++n) gv[bj][n] = *(const f32x4*)(gb + col0 + bj * HALF + n * 16) + 1.0f;
#pragma unroll
        for (int ai = 0; ai < 2; ++ai)
#pragma unroll
            for (int m = 0; m < 4; ++m) { const size_t off = (size_t)(row0 + ai * HALF + m * 16) * ldc + col0;
#pragma unroll
                for (int bj = 0; bj < 2; ++bj)
#pragma unroll
                    for (int n = 0; n < 2; ++n) { const f32x4 xv = *(const f32x4*)(X + off + bj * HALF + n * 16);
                        *(f32x4*)(Z + off + bj * HALF + n * 16) = xv * alpha + gv[bj][n] * acc[ai][bj][m][n]; } }
    }
};

template <class Epi, class Sched, bool ALIGN_EPI = false, bool SP2 = false>
__device__ __forceinline__ void gemm_phase(PG8_LAS unsigned char* lds, const Gemm g, const Sched& S, const Epi& E) {
    const int tid = threadIdx.x, wid = __builtin_amdgcn_readfirstlane(tid >> 6), lane = tid & 63, wr = wid >> 2, wc = wid & 3, fr = lane & 15, fq = lane >> 4;
    const int K = g.K, nt = K / BK;
    unsigned voffA[2], voffB[2];
#pragma unroll
    for (int i = 0; i < 2; ++i) { int R, C; stage_rc(tid * 16 + i * 8192, R, C); const int Rb = Epi::PERM ? ((R & ~31) + perm32(R & 31)) : R;
        voffA[i] = (unsigned)(R * K + C) * 2u; voffB[i] = (unsigned)(Rb * K + C) * 2u; }
    const size_t kstep = (size_t)(BK * 2);
    const size_t hstep = (size_t)HALF * K * 2;
    const size_t tstep = 2 * hstep;
    const unsigned ldsw = (unsigned)wid * 1024u;
    const int aoff = lds_byte(wr * 64 + fr, fq * 8), boff = lds_byte(wc * 32 + fr, fq * 8);
#define PG8_SA(b, h) (((b) * 2 + (h)) * HTB)
#define PG8_SB(b, h) ((4 + (b) * 2 + (h)) * HTB)
#define PG8_STAGE(bufoff, gbase, voff) do { _Pragma("unroll") for (int _i = 0; _i < 2; ++_i) \
        __builtin_amdgcn_global_load_lds((const unsigned*)((const char*)(gbase) + (voff)[_i]), (PG8_LAS unsigned*)(lds + (bufoff) + ldsw + _i * 8192), 16, 0, 0); } while (0)
#define PG8_LDA(dst, b, h) do { _Pragma("unroll") for (int m = 0; m < 4; ++m) _Pragma("unroll") for (int k = 0; k < 2; ++k) dst[m][k] = *(const PG8_LAS bf16x8*)(lds + PG8_SA(b, h) + aoff + m * 2048 + k * 1024); } while (0)
#define PG8_LDB(dst, b, h) do { _Pragma("unroll") for (int n = 0; n < 2; ++n) _Pragma("unroll") for (int k = 0; k < 2; ++k) dst[n][k] = *(const PG8_LAS bf16x8*)(lds + PG8_SB(b, h) + boff + n * 2048 + k * 1024); } while (0)
#define PG8_MMA(ai, bj, At, Bt) do { __builtin_amdgcn_s_setprio(1); _Pragma("unroll") for (int m = 0; m < 4; ++m) _Pragma("unroll") for (int n = 0; n < 2; ++n) _Pragma("unroll") for (int k = 0; k < 2; ++k) \
        acc[ai][bj][m][n] = __builtin_amdgcn_mfma_f32_16x16x32_bf16(Bt[n][k], At[m][k], acc[ai][bj][m][n], 0, 0, 0); __builtin_amdgcn_s_setprio(0); } while (0)
#define PG8_WAIT_V(n) asm volatile("s_waitcnt vmcnt(" #n ")" ::: "memory")
#define PG8_WAIT_L(n) asm volatile("s_waitcnt lgkmcnt(" #n ")" ::: "memory")
#define PG8_BAR __builtin_amdgcn_s_barrier()
#define PG8_SCHED __builtin_amdgcn_sched_barrier(0)
    Unit cur, nxt; int ui = 0;
    if (!S.next(0, cur)) return;
    f32x4 acc[2][2][4][2];
#pragma unroll
    for (int a = 0; a < 2; ++a)
#pragma unroll
        for (int b = 0; b < 2; ++b)
#pragma unroll
            for (int m = 0; m < 4; ++m)
#pragma unroll
                for (int n = 0; n < 2; ++n) acc[a][b][m][n] = (f32x4){0.f, 0.f, 0.f, 0.f};
    bf16x8 At[4][2], B0[2][2], B1[2][2];
    const char* cA = (const char*)g.A + (size_t)cur.pm * tstep; const char* cB = (const char*)g.Bt + (size_t)cur.pn * tstep;
    S.a_ready(cur);
    if constexpr (SP2) {
        PG8_STAGE(PG8_SB(0, 0), cB, voffB); PG8_STAGE(PG8_SB(0, 1), cB + hstep, voffB); PG8_STAGE(PG8_SA(0, 0), cA, voffA); PG8_STAGE(PG8_SA(0, 1), cA + hstep, voffA);
        if (wr == 1) PG8_BAR;
        PG8_WAIT_V(2); PG8_BAR;
        PG8_STAGE(PG8_SB(1, 0), cB + kstep, voffB); PG8_STAGE(PG8_SA(1, 0), cA + kstep, voffA); PG8_STAGE(PG8_SB(1, 1), cB + hstep + kstep, voffB);
        PG8_WAIT_V(6); PG8_BAR;
    } else {
        PG8_STAGE(PG8_SB(0, 0), cB, voffB); PG8_STAGE(PG8_SA(0, 0), cA, voffA); PG8_STAGE(PG8_SB(0, 1), cB + hstep, voffB); PG8_STAGE(PG8_SA(0, 1), cA + hstep, voffA);
        if (wr == 1) PG8_BAR;
        PG8_WAIT_V(4); PG8_BAR;
        PG8_STAGE(PG8_SB(1, 0), cB + kstep, voffB); PG8_STAGE(PG8_SA(1, 0), cA + kstep, voffA); PG8_STAGE(PG8_SB(1, 1), cB + hstep + kstep, voffB);
        PG8_WAIT_V(6); PG8_BAR;
    }
    for (;;) {
        const bool has_next = S.next(ui + 1, nxt);
        const char* nA = has_next ? (const char*)g.A + (size_t)nxt.pm * tstep : cA; const char* nB = has_next ? (const char*)g.Bt + (size_t)nxt.pn * tstep : cB;
        for (int t = 0; t < nt; t += 2) {
            const bool last = (t == nt - 2);
            const char* a1 = cA + (size_t)(t + 1) * kstep;
            const char* a2 = last ? nA : cA + (size_t)(t + 2) * kstep; const char* b2 = last ? nB : cB + (size_t)(t + 2) * kstep;
            const char* a3 = a2 + kstep; const char* b3 = b2 + kstep;
            if (last && has_next) S.a_ready(nxt);
            if constexpr (SP2) {
            PG8_LDB(B0, 0, 0); PG8_LDB(B1, 0, 1); PG8_SCHED; PG8_LDA(At, 0, 0); PG8_STAGE(PG8_SA(1, 1), a1 + hstep, voffA);
            PG8_WAIT_V(8); PG8_WAIT_L(0); PG8_BAR; PG8_MMA(0, 0, At, B0); PG8_MMA(0, 1, At, B1); PG8_BAR; PG8_SCHED;
            PG8_LDA(At, 0, 1); PG8_STAGE(PG8_SB(0, 0), b2, voffB); PG8_STAGE(PG8_SB(0, 1), b2 + hstep, voffB); PG8_STAGE(PG8_SA(0, 0), a2, voffA);
            PG8_WAIT_V(8); PG8_WAIT_L(0); PG8_BAR; PG8_MMA(1, 0, At, B0); PG8_MMA(1, 1, At, B1); PG8_BAR; PG8_SCHED;
            PG8_LDB(B0, 1, 0); PG8_LDB(B1, 1, 1); PG8_SCHED; PG8_LDA(At, 1, 0); PG8_STAGE(PG8_SA(0, 1), a2 + hstep, voffA);
            PG8_WAIT_V(8); PG8_WAIT_L(0); PG8_BAR; PG8_MMA(0, 0, At, B0); PG8_MMA(0, 1, At, B1); PG8_BAR; PG8_SCHED;
            PG8_LDA(At, 1, 1); PG8_STAGE(PG8_SB(1, 0), b3, voffB); PG8_STAGE(PG8_SB(1, 1), b3 + hstep, voffB); PG8_STAGE(PG8_SA(1, 0), a3, voffA);
            PG8_WAIT_V(8); PG8_WAIT_L(0); PG8_BAR; PG8_MMA(1, 0, At, B0); PG8_MMA(1, 1, At, B1); PG8_BAR; PG8_SCHED;
            } else {
            PG8_LDB(B0, 0, 0); PG8_SCHED; PG8_LDA(At, 0, 0); PG8_STAGE(PG8_SA(1, 1), a1 + hstep, voffA);
            PG8_WAIT_L(8); PG8_BAR; PG8_WAIT_L(0); PG8_MMA(0, 0, At, B0); PG8_BAR; PG8_SCHED;
            PG8_LDB(B1, 0, 1); PG8_STAGE(PG8_SB(0, 0), b2, voffB);
            PG8_BAR; PG8_WAIT_L(0); PG8_MMA(0, 1, At, B1); PG8_BAR;
            PG8_LDA(At, 0, 1); PG8_STAGE(PG8_SA(0, 0), a2, voffA);
            PG8_BAR; PG8_WAIT_L(0); PG8_MMA(1, 0, At, B0); PG8_BAR; PG8_SCHED;
            PG8_STAGE(PG8_SB(0, 1), b2 + hstep, voffB);
            PG8_WAIT_V(6); PG8_BAR; PG8_MMA(1, 1, At, B1); PG8_BAR;
            PG8_LDB(B0, 1, 0); PG8_SCHED; PG8_LDA(At, 1, 0); PG8_STAGE(PG8_SA(0, 1), a2 + hstep, voffA);
            PG8_WAIT_L(8); PG8_BAR; PG8_WAIT_L(0); PG8_MMA(0, 0, At, B0); PG8_BAR; PG8_SCHED;
            PG8_LDB(B1, 1, 1); PG8_STAGE(PG8_SB(1, 0), b3, voffB);
            PG8_BAR; PG8_WAIT_L(0); PG8_MMA(0, 1, At, B1); PG8_BAR;
            PG8_LDA(At, 1, 1); PG8_STAGE(PG8_SA(1, 0), a3, voffA);
            PG8_BAR; PG8_WAIT_L(0); PG8_MMA(1, 0, At, B0); PG8_BAR; PG8_SCHED;
            PG8_STAGE(PG8_SB(1, 1), b3 + hstep, voffB);
            PG8_WAIT_V(6); PG8_BAR; PG8_MMA(1, 1, At, B1); PG8_BAR;
            }
        }
        if constexpr (ALIGN_EPI) { if (wr == 0) PG8_BAR; }
        if constexpr (!Epi::AFTER_DRAIN) { E(acc, cur, wr, wc, fr, fq); S.done(cur); }
        if (!has_next) break;
#pragma unroll
        for (int a = 0; a < 2; ++a)
#pragma unroll
            for (int b = 0; b < 2; ++b)
#pragma unroll
                for (int m = 0; m < 4; ++m)
#pragma unroll
                    for (int n = 0; n < 2; ++n) acc[a][b][m][n] = (f32x4){0.f, 0.f, 0.f, 0.f};
        cur = nxt; cA = nA; cB = nB; ++ui;
        if constexpr (ALIGN_EPI) { if (wr == 1) PG8_BAR; }
    }
    PG8_WAIT_V(0);
    if constexpr (!ALIGN_EPI) { if (wr == 0) PG8_BAR; }
    PG8_BAR;
    if constexpr (Epi::AFTER_DRAIN) { E.fused(acc, cur, wr, wc, fr, fq, lds, wid, lane); S.done(cur); }
#undef PG8_SA
#undef PG8_SB
#undef PG8_STAGE
#undef PG8_LDA
#undef PG8_LDB
#undef PG8_MMA
#undef PG8_WAIT_V
#undef PG8_WAIT_L
#undef PG8_BAR
#undef PG8_SCHED
}
}
namespace att {
using bf16 = __hip_bfloat16;
typedef short bf16x8 __attribute__((ext_vector_type(8)));
typedef short s16x4 __attribute__((ext_vector_type(4)));
typedef float f32x16 __attribute__((ext_vector_type(16)));
typedef float f32x4 __attribute__((ext_vector_type(4)));
typedef unsigned u32x4 __attribute__((ext_vector_type(4)));
template <class A, class Bt> struct same_t { static constexpr bool v = false; };
template <class A> struct same_t<A, A> { static constexpr bool v = true; };
constexpr int D = 128, PIN = 6144, POUT = 2048;
constexpr float THR = 8.f;
constexpr bool WSKIP = false;
constexpr float SCALE = 0.08838834764831845f;
constexpr int NW = 8, QBLK = 32, KVBLK = 64, QB = NW * QBLK;
constexpr int SHM_V = KVBLK * D * 2, SHM_K = KVBLK * D * 2;
constexpr int LDS_BYTES = 2 * SHM_V + 2 * SHM_K + NW * 64 * 4;
#define KSWZ(row, colB) ((row) * 256 + ((colB) ^ (((row) & 7) << 4)))
#define SBAR() __builtin_amdgcn_sched_barrier(0)
__device__ __forceinline__ int v_st(int k, int c) { const int kk = (k & ~0xC) | ((k & 4) << 1) | ((k & 8) >> 1); return ((kk >> 3) * 4 + (c >> 5)) * 512 + ((kk & 7) * 32 + (c & 31)) * 2; }
__device__ __forceinline__ int v_rd_base(int lane) { return ((lane & 3) << 3) | (((lane >> 2) & 3) << 6) | (((lane >> 4) & 1) << 5) | (((lane >> 5) & 1) << 8); }
constexpr int v_rd_off(int d0, int ks, int half) { return d0 * 512 + ks * 4096 + half * 2048; }
__device__ __forceinline__ int crow(int r, int hi) { return (r & 3) + 8 * (r >> 2) + 4 * hi; }
__device__ __forceinline__ unsigned cvtpk(float lo, float hi) {
    unsigned r; asm volatile("v_cvt_pk_bf16_f32 %0, %1, %2" : "=v"(r) : "v"(lo), "v"(hi)); return r;
}
__device__ __forceinline__ bf16x8 pack8(f32x4 a, f32x4 b) {
    u32x4 w = {cvtpk(a[0], a[1]), cvtpk(a[2], a[3]), cvtpk(b[0], b[1]), cvtpk(b[2], b[3])};
    return *reinterpret_cast<bf16x8*>(&w);
}
template <class T> __device__ __forceinline__ bf16x8 load8(const T* p) {
    if constexpr (same_t<T, float>::v) { return pack8(*(const f32x4*)p, *(const f32x4*)(p + 4)); }
    else { return *reinterpret_cast<const bf16x8*>(p); }
}
__device__ __forceinline__ void mask_tile(f32x16& p0, f32x16& p1, int dq, unsigned W) {
    const float NEG = -__builtin_inff();
#pragma unroll
    for (int r = 0; r < 16; ++r) {
        const int c = (r & 3) + 8 * (r >> 2);
        if ((unsigned)(dq - c) >= W) p0[r] = NEG;
        if ((unsigned)(dq - c - 32) >= W) p1[r] = NEG;
    }
}
__device__ __forceinline__ void bitmask_tile(f32x16& p0, f32x16& p1, unsigned mw) {
    const float NEG = -__builtin_inff();
#pragma unroll
    for (int r = 0; r < 16; ++r) {
        if (!((mw >> r) & 1u)) p0[r] = NEG;
        if (!((mw >> (16 + r)) & 1u)) p1[r] = NEG;
    }
}
__device__ __forceinline__ void partialSM(f32x16& p0, f32x16& p1, float& m_reg, float& mn, float& alpha) {
    float pmax = p0[0]; for (int r = 1; r < 16; ++r) pmax = fmaxf(pmax, p0[r]); for (int r = 0; r < 16; ++r) pmax = fmaxf(pmax, p1[r]);
    { auto rr = __builtin_amdgcn_permlane32_swap(__float_as_uint(pmax), __float_as_uint(pmax), false, false);
      pmax = fmaxf(__uint_as_float(rr[0]), __uint_as_float(rr[1])); }
    constexpr float C2 = 1.4426950408889634f * SCALE;
    if (__builtin_expect(__all((pmax - m_reg) * SCALE <= THR), 1)) { mn = m_reg; alpha = 1.f; }
    else { mn = fmaxf(m_reg, pmax); alpha = __builtin_amdgcn_exp2f((m_reg - mn) * C2); m_reg = mn; }
    const float mnL = -mn * C2;
    for (int r = 0; r < 16; ++r) p0[r] = fmaf(p0[r], C2, mnL); for (int r = 0; r < 16; ++r) p1[r] = fmaf(p1[r], C2, mnL);
    for (int r = 0; r < 16; ++r) p0[r] = __builtin_amdgcn_exp2f(p0[r]);
}
__device__ __forceinline__ void finishSM(f32x16& p0, f32x16& p1, float alpha, float& l_reg, bf16x8& pa0, bf16x8& pa1, bf16x8& pa2, bf16x8& pa3) {
    for (int r = 0; r < 16; ++r) p1[r] = __builtin_amdgcn_exp2f(p1[r]);
    float ps = 0; for (int r = 0; r < 16; ++r) ps += p0[r]; for (int r = 0; r < 16; ++r) ps += p1[r];
    { auto rr = __builtin_amdgcn_permlane32_swap(__float_as_uint(ps), __float_as_uint(ps), false, false);
      ps = __uint_as_float(rr[0]) + __uint_as_float(rr[1]); }
    l_reg = l_reg * alpha + ps;
#define PK4(P, B_, OUT) do { unsigned a0 = cvtpk(P[B_+0], P[B_+1]), a1 = cvtpk(P[B_+2], P[B_+3]);                          \
        unsigned b0 = cvtpk(P[B_+4], P[B_+5]), b1 = cvtpk(P[B_+6], P[B_+7]);                                             \
        auto r0 = __builtin_amdgcn_permlane32_swap(a0, b0, false, false); auto r1 = __builtin_amdgcn_permlane32_swap(a1, b1, false, false); \
        u32x4 w = {r0[0], r1[0], r0[1], r1[1]}; OUT = *reinterpret_cast<bf16x8*>(&w); } while (0)
    PK4(p0, 0, pa0); PK4(p0, 8, pa1); PK4(p1, 0, pa2); PK4(p1, 8, pa3);
#undef PK4
}
template <int KB, bool SK>
__device__ __forceinline__ void qkt(f32x16& p0, f32x16& p1, const char* K_lds, int r32, int hi, const bf16x8* qr, bool act) {
    if (SK && !act) { const float NEG = -__builtin_inff();
#pragma unroll
        for (int r = 0; r < 16; ++r) { p0[r] = NEG; p1[r] = NEG; } return; }
    p0 = f32x16{}; p1 = f32x16{};
    const char* kb[4];
#pragma unroll
    for (int dd = 0; dd < 4; ++dd) kb[dd] = K_lds + KB * SHM_K + KSWZ(r32, (dd * 16 + hi * 8) * 2);
#pragma unroll
    for (int d0 = 0; d0 < 8; ++d0) { const char* a = kb[d0 & 3] + (d0 >> 2) * 128;
        bf16x8 b0 = *reinterpret_cast<const bf16x8*>(a);
        bf16x8 b1 = *reinterpret_cast<const bf16x8*>(a + 32 * 256);
        p0 = __builtin_amdgcn_mfma_f32_32x32x16_bf16(b0, qr[d0], p0, 0, 0, 0);
        p1 = __builtin_amdgcn_mfma_f32_32x32x16_bf16(b1, qr[d0], p1, 0, 0, 0); }
}
template <int VB, bool SK>
__device__ __forceinline__ void pv_tile(f32x16* o, int vb0, bf16x8 pa0, bf16x8 pa1, bf16x8 pa2, bf16x8 pa3, bool act) {
    if (SK && !act) return;
#define TRRD(dst, off) asm volatile("ds_read_b64_tr_b16 %0, %1 offset:%2" : "=&v"(dst) : "v"(vb0), "i"(off) : "memory")
#define PV_D0(d0) do { s16x4 l0, l1, l2, l3, h0, h1, h2, h3; constexpr int b_ = VB * SHM_V + v_rd_off(d0, 0, 0);     \
        TRRD(l0, b_); TRRD(h0, b_ + 2048); TRRD(l1, b_ + 4096); TRRD(h1, b_ + 6144); TRRD(l2, b_ + 8192); TRRD(h2, b_ + 10240); TRRD(l3, b_ + 12288); TRRD(h3, b_ + 14336); \
        asm volatile("s_waitcnt lgkmcnt(0)" ::: "memory"); SBAR();                 \
        o[d0] = __builtin_amdgcn_mfma_f32_32x32x16_bf16(pa0, (bf16x8){l0[0], l0[1], l0[2], l0[3], h0[0], h0[1], h0[2], h0[3]}, o[d0], 0, 0, 0);   \
        o[d0] = __builtin_amdgcn_mfma_f32_32x32x16_bf16(pa1, (bf16x8){l1[0], l1[1], l1[2], l1[3], h1[0], h1[1], h1[2], h1[3]}, o[d0], 0, 0, 0);   \
        o[d0] = __builtin_amdgcn_mfma_f32_32x32x16_bf16(pa2, (bf16x8){l2[0], l2[1], l2[2], l2[3], h2[0], h2[1], h2[2], h2[3]}, o[d0], 0, 0, 0);   \
        o[d0] = __builtin_amdgcn_mfma_f32_32x32x16_bf16(pa3, (bf16x8){l3[0], l3[1], l3[2], l3[3], h3[0], h3[1], h3[2], h3[3]}, o[d0], 0, 0, 0); } while (0)
    PV_D0(0); PV_D0(1); PV_D0(2); PV_D0(3);
#undef PV_D0
#undef TRRD
}

template <class TIn, class TOut> struct BlockRef { const TIn* Q; const TIn* K; const TIn* V; TOut* O; const unsigned long long* M; int P0; };
template <class TIn> struct Seam {
    bf16x8 qr[8];
    bf16x8 st_v0, st_v1, st_k0, st_k1; f32x4 sf0, sf1, sf2, sf3;
    f32x4 tq[16];
};
__device__ __forceinline__ int swa_jlo(int P0, int W) { const int lowk = P0 - W + 1; return lowk > 0 ? lowk / KVBLK : 0; }
#define ROW(p, k0, rr) ((p) + (size_t)((k0) + (rr)) * PIN + sc)
#define VMW() asm volatile("s_waitcnt vmcnt(0)" ::: "memory")
#define VMWN(n) asm volatile("s_waitcnt vmcnt(%0)" :: "i"(n) : "memory")
#define SLOAD_H(Kp, Vp, k0) do { S.st_v0 = load8<TIn>(ROW(Vp, k0, sr)); S.st_v1 = load8<TIn>(ROW(Vp, k0, 32 + sr));              \
                         S.st_k0 = load8<TIn>(ROW(Kp, k0, sr)); S.st_k1 = load8<TIn>(ROW(Kp, k0, 32 + sr)); } while (0)
#define SWRITE_HK(bf) do { *(bf16x8*)(K_lds + (bf) * SHM_K + kws) = S.st_k0; *(bf16x8*)(K_lds + (bf) * SHM_K + kws + 32 * 256) = S.st_k1; } while (0)
#define SWRITE_HV(bf) do { *(bf16x8*)(V_lds + (bf) * SHM_V + vst0) = S.st_v0; *(bf16x8*)(V_lds + (bf) * SHM_V + vst1) = S.st_v1; } while (0)
#define SWRITE_H(bf) do { SWRITE_HV(bf); SWRITE_HK(bf); } while (0)
#define SLOAD_F(p, k0) do { S.sf0 = *(const f32x4*)ROW(p, k0, sr); S.sf1 = *(const f32x4*)(ROW(p, k0, sr) + 4);                \
                            S.sf2 = *(const f32x4*)ROW(p, k0, 32 + sr); S.sf3 = *(const f32x4*)(ROW(p, k0, 32 + sr) + 4); } while (0)
#define SWRITE_KF(bf) do { *(bf16x8*)(K_lds + (bf) * SHM_K + kws) = pack8(S.sf0, S.sf1); *(bf16x8*)(K_lds + (bf) * SHM_K + kws + 32 * 256) = pack8(S.sf2, S.sf3); } while (0)
#define SWRITE_VF(bf) do { *(bf16x8*)(V_lds + (bf) * SHM_V + vst0) = pack8(S.sf0, S.sf1); *(bf16x8*)(V_lds + (bf) * SHM_V + vst1) = pack8(S.sf2, S.sf3); } while (0)
template <class TIn, class TOut>
__device__ __forceinline__ void causal_swa_prime(const BlockRef<TIn, TOut>& cur, int W, char* lds, Seam<TIn>& S) {
    constexpr bool F32 = same_t<TIn, float>::v;
    const int tid = threadIdx.x, wid = __builtin_amdgcn_readfirstlane(tid >> 6), lane = tid & 63, r32 = lane & 31, hi = lane >> 5;
    const int sr = tid >> 4, sc = (tid & 15) * 8, kws = KSWZ(sr, sc * 2); char* K_lds = lds + 2 * SHM_V;
    const int kb0 = swa_jlo(cur.P0, W) * KVBLK;
    for (int d0 = 0; d0 < 8; ++d0) S.qr[d0] = load8<TIn>(cur.Q + (size_t)(wid * QBLK + r32) * PIN + d0 * 16 + hi * 8);
    if constexpr (F32) { SLOAD_F((const float*)cur.K, kb0); VMW(); SWRITE_KF(0); SBAR(); SLOAD_F((const float*)cur.V, kb0); }
    else { SLOAD_H(cur.K, cur.V, kb0); VMW(); SWRITE_HK(0); }
    __syncthreads();
}
template <class TIn, class TOut>
__device__ __forceinline__ void causal_swa_block(const BlockRef<TIn, TOut>& cur, const BlockRef<TIn, TOut>& nxt, int skv, int W, char* lds, Seam<TIn>& S) {
    constexpr bool F32 = same_t<TIn, float>::v;
    const int tid = threadIdx.x, wid = __builtin_amdgcn_readfirstlane(tid >> 6), lane = tid & 63, r32 = lane & 31, hi = lane >> 5;
    const int j_lo = swa_jlo(cur.P0, W);
    int j_hi = (cur.P0 + QB - 1) / KVBLK + 1; if (j_hi > skv / KVBLK) j_hi = skv / KVBLK;
    const int NT = j_hi - j_lo;
    const int kbn = swa_jlo(nxt.P0, W) * KVBLK;
    const unsigned* M32 = (const unsigned*)cur.M; const unsigned moff = (unsigned)((wid * QBLK + r32) * 128 + hi);
    const int qlo = cur.P0 + wid * QBLK;
    char* V_lds = lds; char* K_lds = lds + 2 * SHM_V;
    float* ws = (float*)(lds + 2 * SHM_V + 2 * SHM_K) + wid * 64; float* li_l = ws, * al_l = ws + 32;
    float m_reg = -1e30f, l_reg = 0; f32x16 o[4] = {};
    const int sr = tid >> 4, sc = (tid & 15) * 8, vst0 = v_st(sr, sc), vst1 = v_st(32 + sr, sc), kws = KSWZ(sr, sc * 2);
    const int vb0 = (int)(uintptr_t)V_lds + v_rd_base(lane);
    const TIn* Kh = cur.K; const TIn* Vh = cur.V;
#define RESC(a) do { if (__any((a) < 1.f)) { if (hi == 0) al_l[r32] = (a); asm volatile("s_waitcnt lgkmcnt(0)" ::: "memory");              \
                     for (int d_ = 0; d_ < 4; ++d_) for (int r = 0; r < 16; ++r) o[d_][r] *= al_l[crow(r, hi)]; } } while (0)
#define KBASE(t) ((j_lo + (t)) * KVBLK)
#define ACT(t) (KBASE(t) <= qlo + QBLK - 1 && KBASE(t) + KVBLK - 1 >= qlo - W + 1)
#define MASKT(P0_, P1_, t) do { bitmask_tile(P0_, P1_, mwn); } while (0)
    constexpr int NQL = F32 ? 16 : 8;
    constexpr bool SK = WSKIP && !F32;
#define SEAM_K0() do { VMWN(NQL); if constexpr (F32) { SWRITE_KF(0); SBAR(); SLOAD_F((const float*)nxt.V, kbn); } else { SWRITE_HK(0); } SBAR(); } while (0)
    f32x16 pA0, pA1, pB0, pB1; float mnA, mnB, alA, alB; bf16x8 pa0, pa1, pa2, pa3;
    if constexpr (F32) { VMW(); SWRITE_VF(0); SBAR(); } else { SWRITE_HV(0); SBAR(); }
    if (NT > 1) { if constexpr (F32) SLOAD_F((const float*)Kh, KBASE(1)); else SLOAD_H(Kh, Vh, KBASE(1)); }
    unsigned mwn = M32[moff + 2 * j_lo]; SBAR(); qkt<0, SK>(pA0, pA1, K_lds, r32, hi, S.qr, ACT(0));
    if constexpr (F32) { if (NT > 1) { VMW(); SWRITE_KF(1); SBAR(); SLOAD_F((const float*)Vh, KBASE(1)); } }
    MASKT(pA0, pA1, 0); partialSM(pA0, pA1, m_reg, mnA, alA);
    if (NT > 1) { VMW(); if constexpr (F32) { SWRITE_VF(1); SBAR(); if (NT > 2) SLOAD_F((const float*)Kh, KBASE(2)); } else SWRITE_H(1); }
    __syncthreads();
#define HALF_STEP(PX0, PX1, mnX, alX, PY0, PY1, alY, t, KB, VB, SB) do {                                                      \
        mwn = M32[moff + 2 * (j_lo + (t))]; SBAR(); qkt<KB, SK>(PX0, PX1, K_lds, r32, hi, S.qr, ACT(t));             \
        finishSM(PY0, PY1, alY, l_reg, pa0, pa1, pa2, pa3); SBAR();                                                           \
        if ((t) + 1 < NT) { if constexpr (F32) { VMW(); SWRITE_KF(SB); SBAR(); SLOAD_F((const float*)Vh, KBASE((t) + 1)); }  \
                            else { SLOAD_H(Kh, Vh, KBASE((t) + 1)); } SBAR(); }                                               \
        pv_tile<VB, SK>(o, vb0, pa0, pa1, pa2, pa3, ACT((t) - 1)); MASKT(PX0, PX1, (t)); partialSM(PX0, PX1, m_reg, mnX, alX);                                        \
        __syncthreads();                                                                                                      \
        if ((t) + 1 < NT) { VMW(); if constexpr (F32) { SWRITE_VF(SB); SBAR(); if ((t) + 2 < NT) SLOAD_F((const float*)Kh, KBASE((t) + 2)); } \
                            else { SWRITE_H(SB); } }                                                                          \
        RESC(alX); __syncthreads(); } while (0)
    for (int t = 1; t + 1 < NT; t += 2) {
        HALF_STEP(pB0, pB1, mnB, alB, pA0, pA1, alA, t, 1, 0, 0);
        HALF_STEP(pA0, pA1, mnA, alA, pB0, pB1, alB, t + 1, 0, 1, 1);
    }
    const bool even = (NT & 1) == 0;
    if (even) { mwn = M32[moff + 2 * (j_lo + NT - 1)]; SBAR(); qkt<1, SK>(pB0, pB1, K_lds, r32, hi, S.qr, ACT(NT - 1)); SBAR(); }
#define QROW(e) (nxt.Q + (size_t)(wid * QBLK + r32) * PIN + ((e) >> 1) * 16 + hi * 8 + ((e) & 1) * 4)
    if constexpr (F32) { SLOAD_F((const float*)nxt.K, kbn); SBAR();
#pragma unroll
        for (int e = 0; e < 8; ++e) S.tq[e] = *(const f32x4*)QROW(e); }
    else { SLOAD_H(nxt.K, nxt.V, kbn); SBAR();
#pragma unroll
        for (int d0 = 0; d0 < 8; ++d0) S.qr[d0] = load8<TIn>(nxt.Q + (size_t)(wid * QBLK + r32) * PIN + d0 * 16 + hi * 8); }
    SBAR();
    finishSM(pA0, pA1, alA, l_reg, pa0, pa1, pa2, pa3); SBAR();
    if constexpr (F32) {
#pragma unroll
        for (int e = 8; e < 16; ++e) S.tq[e] = *(const f32x4*)QROW(e); SBAR(); }
#undef QROW
    pv_tile<0, SK>(o, vb0, pa0, pa1, pa2, pa3, ACT(even ? NT - 2 : NT - 1));
    if (even) { MASKT(pB0, pB1, NT - 1); partialSM(pB0, pB1, m_reg, mnB, alB); __syncthreads(); RESC(alB);
        finishSM(pB0, pB1, alB, l_reg, pa0, pa1, pa2, pa3); SBAR(); pv_tile<1, SK>(o, vb0, pa0, pa1, pa2, pa3, ACT(NT - 1)); }
    SBAR(); SEAM_K0();
    if (hi == 0) li_l[r32] = l_reg; asm volatile("s_waitcnt lgkmcnt(0)" ::: "memory");
    float rli[16];
#pragma unroll
    for (int r = 0; r < 16; ++r) rli[r] = __builtin_amdgcn_rcpf(li_l[crow(r, hi)]);
    TOut* Ow = cur.O + (size_t)(wid * QBLK) * POUT;
#pragma unroll
    for (int r = 0; r < 16; ++r) { const int orow = crow(r, hi);
#pragma unroll
        for (int d0 = 0; d0 < 4; ++d0) { const float v = o[d0][r] * rli[r];
            if constexpr (same_t<TOut, float>::v) { Ow[(size_t)orow * POUT + d0 * 32 + r32] = v; }
            else { const float vn = __shfl_xor(v, 1);
                   if ((r32 & 1) == 0) *(unsigned*)(Ow + (size_t)orow * POUT + d0 * 32 + r32) = cvtpk(v, vn); } } }
    if constexpr (F32) {
#pragma unroll
        for (int d0 = 0; d0 < 8; ++d0) S.qr[d0] = pack8(S.tq[2 * d0], S.tq[2 * d0 + 1]); }
    __syncthreads();
#undef RESC
#undef KBASE
#undef ACT
#undef MASKT
#undef SEAM_K0
#undef HALF_STEP
}
#undef ROW
#undef VMW
#undef VMWN
#undef SLOAD_H
#undef SWRITE_HK
#undef SWRITE_HV
#undef SWRITE_H
#undef SLOAD_F
#undef SWRITE_KF
#undef SWRITE_VF

}
typedef GAS unsigned gu32;
#define XB_TMO      128
#define XB_XCNT(j)  (256  + 64 * (j))
#define XB_XSUB(j)  (1280 + 64 * (j))
#define XB_XGEN(j)  (2304 + 64 * (j))
#define XB_TOP      3328
#define XB_TOPGEN   3392
#define XCD_BAR_WORDS 3456
#define XB_SPIN_CAP (1u << 18)

__device__ __forceinline__ unsigned xb_ld(unsigned* p)              { return __hip_atomic_load(p, __ATOMIC_RELAXED, __HIP_MEMORY_SCOPE_AGENT); }
__device__ __forceinline__ unsigned xb_add(unsigned* p, unsigned v) { return __hip_atomic_fetch_add(p, v, __ATOMIC_RELAXED, __HIP_MEMORY_SCOPE_AGENT); }
__device__ __forceinline__ unsigned xb_xcc_id() { return (unsigned)__builtin_amdgcn_s_getreg((3 << 11) | 20) & 0xFu; }
#define XB_SPIN(cond, bar) do { unsigned _sp = 0; while (cond) { __builtin_amdgcn_s_sleep(1); \
    if ((++_sp & 255u) == 0u) { if (xb_ld(&(bar)[XB_TMO])) break; if (_sp > XB_SPIN_CAP) { atomicAdd(&(bar)[XB_TMO], 1u); break; } } } } while (0)

struct XcdBarrier {
    unsigned* bar; unsigned x;
    volatile LAS unsigned* st;
};

__device__ __forceinline__ XcdBarrier xcd_barrier_post(unsigned* bar, volatile LAS unsigned* st) {
    XcdBarrier b; b.bar = bar; b.x = xb_xcc_id(); b.st = st;
    if (threadIdx.x == 0) (void)xb_add(&bar[XB_XCNT(b.x)], 1u);
    return b;
}
__device__ __forceinline__ void xcd_barrier_complete(unsigned* bar, unsigned x, unsigned& nloc, unsigned& nx) {
    const unsigned G = gridDim.x * gridDim.y * gridDim.z;
    unsigned sum, cnt, mine, sp = 0u;
    for (;;) {
        sum = 0u; cnt = 0u; mine = 0u;
#pragma unroll
        for (unsigned j = 0; j < 16; ++j) { const unsigned c = xb_ld(&bar[XB_XCNT(j)]); sum += c; cnt += (c > 0u) ? 1u : 0u; mine = (j == x) ? c : mine; }
        if (sum == G) break;
        __builtin_amdgcn_s_sleep(1);
        if ((++sp & 255u) == 0u) { if (xb_ld(&bar[XB_TMO])) break; if (sp > XB_SPIN_CAP) { atomicAdd(&bar[XB_TMO], 1u); break; } }
    }
    nloc = mine > 0u ? mine : 1u; nx = cnt > 0u ? cnt : 1u;
}

__device__ __forceinline__ void xcd_barrier(const XcdBarrier& b) {
    asm volatile("s_waitcnt vmcnt(0)" ::: "memory");
    __syncthreads();
    if (threadIdx.x == 0) {
        unsigned* bar = b.bar;
        __builtin_amdgcn_s_waitcnt(0);
        unsigned nloc = b.st[0], nx = b.st[1];
        if (nloc == 0u) { xcd_barrier_complete(bar, b.x, nloc, nx); b.st[0] = nloc; b.st[1] = nx; }
        const unsigned old = xb_add(&bar[XB_XSUB(b.x)], 1u);
        const unsigned gen = old / nloc;
        if (old + 1u == (gen + 1u) * nloc) {
            __builtin_amdgcn_fence(__ATOMIC_RELEASE, "agent");
            asm volatile("s_waitcnt vmcnt(0)" ::: "memory");
            const unsigned og = xb_add(&bar[XB_TOP], 1u);
            const unsigned tg = og / nx;
            if (og + 1u == (tg + 1u) * nx) xb_add(&bar[XB_TOPGEN], 1u);
            else XB_SPIN(xb_ld(&bar[XB_TOPGEN]) == tg, bar);
            __builtin_amdgcn_fence(__ATOMIC_ACQUIRE, "agent");
            xb_add(&bar[XB_XGEN(b.x)], 1u);
            asm volatile("s_waitcnt vmcnt(0)" ::: "memory");
        } else {
            XB_SPIN(xb_ld(&bar[XB_XGEN(b.x)]) == gen, bar);
            __builtin_amdgcn_fence(__ATOMIC_ACQUIRE, "agent");
            asm volatile("s_waitcnt vmcnt(0)" ::: "memory");
        }
    }
    __syncthreads();
}

constexpr int LDS_BYTES = 147456;
constexpr int MISC_OFF = LDS_BYTES - 256;
constexpr int NWAVES = 8;

struct Args { const void* in[23]; float* out; unsigned char* ws; int ph_lo, ph_hi; };
enum { I_X = 0, I_C, I_POS, I_WADA, I_BADA, I_WIN, I_CONVW, I_CONVB, I_WRGA, I_BRGA, I_WRGX, I_BRGX, I_LAM, I_KIDXG, I_WOUT, I_LN1G, I_LN1B, I_WPQ, I_SUBK, I_PU, I_PV, I_LN2G, I_LN2B };

struct Ctx { LAS unsigned char* lds; unsigned char* ws; int tid, lane, wave, bid, G, gw, ngw; };

__device__ __forceinline__ f32x4 mfma16(bf16x8 a, bf16x8 b, f32x4 c) { return __builtin_amdgcn_mfma_f32_16x16x32_bf16(a, b, c, 0, 0, 0); }
__device__ __forceinline__ f32x16 mfma32(bf16x8 a, bf16x8 b, f32x16 c) { return __builtin_amdgcn_mfma_f32_32x32x16_bf16(a, b, c, 0, 0, 0); }

__device__ __forceinline__ void transpose_item(const float* W, int K, int N, bf16* WT, LAS float* scr, int item, int lane) {
    const int nblk = (N + 31) / 32, kb = item / nblk, nb = item % nblk, k0 = 64 * kb, n0 = 32 * nb;
    const int nc = n0 + (lane & 31); const bool okc = nc < N;
#pragma unroll 8
    for (int i = 0; i < 32; ++i) { const int kk = 2 * i + (lane >> 5); scr[kk * 33 + (lane & 31)] = okc ? W[(size_t)(k0 + kk) * N + nc] : 0.f; }
    LDS_WAIT(); asm volatile("" ::: "memory");
    const int c = lane & 7;
#pragma unroll
    for (int j = 0; j < 4; ++j) { const int n = (lane >> 3) + 8 * j; const LAS float* s = scr + (8 * c) * 33 + n;
        v4u o; o.x = pk2(s[0 * 33], s[1 * 33]); o.y = pk2(s[2 * 33], s[3 * 33]); o.z = pk2(s[4 * 33], s[5 * 33]); o.w = pk2(s[6 * 33], s[7 * 33]);
        if (n0 + n < N) *(v4u*)(WT + (size_t)(n0 + n) * K + k0 + 8 * c) = o; }
    LDS_WAIT(); asm volatile("" ::: "memory");
}
__device__ __forceinline__ void convert_stream(const float* src, bf16* dst, size_t n, int gw, int ngw, int lane) {
    const size_t niter = n / 512;
#pragma unroll 4
    for (size_t i = gw; i < niter; i += ngw) { const size_t e = i * 512 + (size_t)lane * 8;
        const f32x4 a = *(const f32x4*)(src + e), b = *(const f32x4*)(src + e + 4);
        v4u o; o.x = pk2(a.x, a.y); o.y = pk2(a.z, a.w); o.z = pk2(b.x, b.y); o.w = pk2(b.z, b.w);
        *(v4u*)(dst + e) = o; }
}
__device__ __forceinline__ void convert_rows_fp8(const float* src, unsigned* dst, float* inv_scale, int gw, int ngw, int lane) {
    for (int row = gw; row < NEXP; row += ngw) {
        f32x4 v[2][4]; float mx = 0.f;
#pragma unroll
        for (int cc = 0; cc < 2; ++cc)
#pragma unroll
            for (int w = 0; w < 4; ++w) { v[cc][w] = *(const f32x4*)(src + (size_t)row * DM + 1024 * cc + 16 * lane + 4 * w);
                mx = fmaxf(mx, fmaxf(fmaxf(fabsf(v[cc][w].x), fabsf(v[cc][w].y)), fmaxf(fabsf(v[cc][w].z), fabsf(v[cc][w].w)))); }
#pragma unroll
        for (int o = 1; o < 64; o <<= 1) mx = fmaxf(mx, __shfl_xor(mx, o));
        const float sc = mx > 0.f ? 256.0f / mx : 1.0f;
        if (lane == 0) inv_scale[row] = mx > 0.f ? mx * (1.0f / 256.0f) : 1.0f;
#pragma unroll
        for (int cc = 0; cc < 2; ++cc) { v4u o;
#pragma unroll
            for (int w = 0; w < 4; ++w) { int p = __builtin_amdgcn_cvt_pk_fp8_f32(v[cc][w].x * sc, v[cc][w].y * sc, 0, false); p = __builtin_amdgcn_cvt_pk_fp8_f32(v[cc][w].z * sc, v[cc][w].w * sc, p, true); o[w] = (unsigned)p; }
            *(v4u*)(dst + (size_t)row * (DM / 4) + 256 * cc + 4 * lane) = o; }
    }
}
__device__ __forceinline__ void p0_prologue(const Ctx& c, const Args& a) {
    const int tid = c.tid, lane = c.lane, gw = c.gw, ngw = c.ngw;
    LAS float* sl = (LAS float*)(c.lds + 8 * 8448);
    { const float* cc = (const float*)a.in[I_C];
      for (int i = tid; i < 2 * DM; i += 512) { const float v = cc[i]; sl[i] = v / (1.0f + __expf(-v)); } }
    __syncthreads();
    { const float* W = (const float*)a.in[I_WADA]; float* MODP = (float*)(c.ws + WS_MODP);
      for (int it = gw; it < 48 * 32; it += ngw) { const int cg = it % 48, ks = it / 48, col = cg * 256 + lane * 4, k0 = ks * 64;
          f32x4 a0 = {0.f, 0.f, 0.f, 0.f}, a1 = {0.f, 0.f, 0.f, 0.f};
#pragma unroll 8
          for (int kk = 0; kk < 64; ++kk) { const f32x4 w = *(const f32x4*)(W + (size_t)(k0 + kk) * (6 * DM) + col); const float s0 = sl[k0 + kk], s1 = sl[DM + k0 + kk]; a0 += w * s0; a1 += w * s1; }
          *(f32x4*)(MODP + ((size_t)ks * 2 + 0) * (6 * DM) + col) = a0; *(f32x4*)(MODP + ((size_t)ks * 2 + 1) * (6 * DM) + col) = a1; } }
    LAS float* scr = (LAS float*)(c.lds + c.wave * 8448);
    { constexpr int I_IN = (DM / 64) * ((DIN + 31) / 32), I_SQ = (DM / 64) * (DM / 32), I_G = 8 * 2 * 4;
      for (int it = gw; it < I_IN + 2 * I_SQ + 2 * I_G; it += ngw) { int r = it;
          if (r < I_IN) { transpose_item((const float*)a.in[I_WIN], DM, DIN, (bf16*)(c.ws + WS_WIN), scr, r, lane); continue; } r -= I_IN;
          if (r < I_SQ) { transpose_item((const float*)a.in[I_WOUT], DM, DM, (bf16*)(c.ws + WS_WOUT), scr, r, lane); continue; } r -= I_SQ;
          if (r < I_SQ) { transpose_item((const float*)a.in[I_WPQ], DM, DM, (bf16*)(c.ws + WS_WPQ), scr, r, lane); continue; } r -= I_SQ;
          if (r < I_G) { const int n = r / 8; transpose_item((const float*)a.in[I_WRGA] + n * 16384, 128, 128, (bf16*)(c.ws + WS_WRG) + n * 16384, scr, r % 8, lane); continue; } r -= I_G;
          { const int n = r / 8; transpose_item((const float*)a.in[I_WRGX] + n * 16384, 128, 128, (bf16*)(c.ws + WS_WRG) + (8 + n) * 16384, scr, r % 8, lane); } } }
    convert_stream((const float*)a.in[I_SUBK], (bf16*)(c.ws + WS_SUBK), (size_t)8 * 2 * 128 * 128, gw, ngw, lane);
    convert_rows_fp8((const float*)a.in[I_PU], (unsigned*)(c.ws + WS_PU), (float*)(c.ws + WS_PUS), gw, ngw, lane);
    convert_rows_fp8((const float*)a.in[I_PV], (unsigned*)(c.ws + WS_PV), (float*)(c.ws + WS_PVS), gw, ngw, lane);
    __syncthreads();
}

__device__ __forceinline__ void p1_u1(const Ctx& c, const Args& a) {
    const int tid = c.tid, lane = c.lane;
    const float* MODP = (const float*)(c.ws + WS_MODP); const float* bada = (const float*)a.in[I_BADA]; float* MODF = (float*)(c.ws + WS_MODF);
    { const int g = c.bid * 512 + tid;
      for (int e = g; e < 2 * 6 * DM; e += c.G * 512) { const int b = e / (6 * DM), j = e % (6 * DM); float s = bada[j];
          for (int ks = 0; ks < 32; ++ks) s += MODP[((size_t)ks * 2 + b) * (6 * DM) + j];
          MODF[e] = s; } }
    LAS float* ms = (LAS float*)c.lds;
    for (int i = tid; i < 2 * 2 * DM; i += 512) { const int b = i / (2 * DM), j = i % (2 * DM); float s = bada[j];
        for (int ks = 0; ks < 32; ++ks) s += MODP[((size_t)ks * 2 + b) * (6 * DM) + j];
        ms[i] = s; }
    __syncthreads();
    const float* x = (const float*)a.in[I_X]; bf16* U1 = (bf16*)(c.ws + WS_U1);
    for (int row = c.gw; row < NTOK; row += c.ngw) { const int b = row / SEQ;
        const f32x4* xr = (const f32x4*)(x + (size_t)row * DM) + lane;
        f32x4 v[8]; float s = 0.f;
#pragma unroll
        for (int j = 0; j < 8; ++j) { v[j] = xr[64 * j]; s += (v[j].x + v[j].y) + (v[j].z + v[j].w); }
        const float mean = wave_sum(s) * (1.f / DM); float s2 = 0.f;
#pragma unroll
        for (int j = 0; j < 8; ++j) { v[j] = v[j] - mean; s2 += (v[j].x * v[j].x + v[j].y * v[j].y) + (v[j].z * v[j].z + v[j].w * v[j].w); }
        const float rstd = 1.f / sqrtf(wave_sum(s2) * (1.f / DM) + LN_EPS);
#pragma unroll
        for (int j = 0; j < 8; ++j) { const int col = 4 * lane + 256 * j;
            const f32x4 sh = *(const LAS f32x4*)(ms + b * 4096 + col), sc = *(const LAS f32x4*)(ms + b * 4096 + DM + col);
            const f32x4 y = v[j] * rstd * (sc + 1.0f) + sh;
            v2u o; o.x = pk2(y.x, y.y); o.y = pk2(y.z, y.w);
            *(v2u*)(U1 + (size_t)row * DM + col) = o; }
    }
    __syncthreads();
}

__device__ __forceinline__ void p3_post(const Ctx& c, const Args& a) {
    const int tid = c.tid, lane = c.lane, wave = c.wave, fr = lane & 15, fq = lane >> 4;
    bf16* PROJ = (bf16*)(c.ws + WS_PROJ); const bf16* U1 = (const bf16*)(c.ws + WS_U1); const bf16* WinT = (const bf16*)(c.ws + WS_WIN);
    const int* pos = (const int*)a.in[I_POS];
    for (int it = c.bid; it < NTOK / 32; it += c.G) {
        const int t0 = it * 32, b = t0 / SEQ;
        LAS float* red = (LAS float*)c.lds;
        LAS float* kw = red + 8 * 32 * 80;
        LAS float* cst = kw + 32 * 80;
        { f32x4 acc[2][5];
#pragma unroll
          for (int m = 0; m < 2; ++m)
#pragma unroll
              for (int n = 0; n < 5; ++n) acc[m][n] = (f32x4){0.f, 0.f, 0.f, 0.f};
          for (int ks = 0; ks < 8; ++ks) { const int kb = wave * 256 + ks * 32 + 8 * fq;
              const bf16x8 a0 = *(const bf16x8*)(U1 + (size_t)(t0 + fr) * DM + kb), a1 = *(const bf16x8*)(U1 + (size_t)(t0 + 16 + fr) * DM + kb);
#pragma unroll
              for (int n = 0; n < 5; ++n) { const bf16x8 bb = *(const bf16x8*)(WinT + (size_t)(NMAIN + 16 * n + fr) * DM + kb);
                  acc[0][n] = mfma16(a0, bb, acc[0][n]); acc[1][n] = mfma16(a1, bb, acc[1][n]); } }
#pragma unroll
          for (int m = 0; m < 2; ++m)
#pragma unroll
              for (int n = 0; n < 5; ++n)
#pragma unroll
                  for (int r = 0; r < 4; ++r) red[(wave * 32 + 16 * m + 4 * fq + r) * 80 + 16 * n + fr] = acc[m][n][r]; }
        for (int i = tid; i < 32 * 24; i += 512) { const int tk = i / 24, j = i % 24;
            const float ex = j < 16 ? -(float)j / 16.0f : -(float)(j - 16) / 8.0f;
            const float inv = exp2f(ex * 18.931568569324174f);
            const float ang = (float)pos[t0 + tk] * inv;
            double rev = (double)ang * 0.15915494309189535; rev -= floor(rev);
            if (rev > 0.5) rev -= 1.0;
            const float rr = (float)(rev * 6.283185307179586);
            float sn, cs; sincosf(rr, &sn, &cs);
            cst[2 * i] = cs; cst[2 * i + 1] = sn; }
        __syncthreads();
        for (int i = tid; i < 32 * 80; i += 512) { float s = 0.f;
#pragma unroll
            for (int w = 0; w < 8; ++w) s += red[w * 2560 + i];
            kw[i] = s; }
        __syncthreads();
        if (tid < 32) { const int tk = tid; const LAS float* row = kw + tk * 80; const float* kg = (const float*)a.in[I_KIDXG];
            float s = 0.f;
            for (int d = 0; d < 64; ++d) s += row[d];
            const float mean = s * (1.f / 64.f); float s2 = 0.f;
            for (int d = 0; d < 64; ++d) { const float dv = row[d] - mean; s2 += dv * dv; }
            const float rstd = 1.f / sqrtf(s2 * (1.f / 64.f) + LN_EPS);
            bf16* ko = (bf16*)(c.ws + WS_KIDX) + (size_t)(t0 + tk) * 64;
            for (int d = 0; d < 8; ++d) { const float x1 = (row[d] - mean) * rstd * kg[d], x2 = (row[d + 8] - mean) * rstd * kg[d + 8];
                const float cs = cst[2 * (tk * 24 + 16 + d)], sn = cst[2 * (tk * 24 + 16 + d) + 1];
                ko[d] = (bf16)f2bf(x1 * cs - x2 * sn); ko[d + 8] = (bf16)f2bf(x2 * cs + x1 * sn); }
            for (int d = 16; d < 64; ++d) ko[d] = (bf16)f2bf((row[d] - mean) * rstd * kg[d]);
            float* wo = (float*)(c.ws + WS_WIDX) + (size_t)(t0 + tk) * 16;
            for (int h = 0; h < 16; ++h) wo[h] = row[64 + h] * (0.25f * 0.125f); }
        for (int i = tid; i < 32 * 8 * 16; i += 512) { const int tk = i >> 7, h = (i >> 4) & 7, d = i & 15;
            const float cs = cst[2 * (tk * 24 + d)], sn = cst[2 * (tk * 24 + d) + 1];
            bf16* p = PROJ + (size_t)(t0 + tk) * NMAIN + C_Q + h * 128 + d;
            { const float x1 = bf2f(p[0]), x2 = bf2f(p[16]); p[0] = (bf16)f2bf(x1 * cs - x2 * sn); p[16] = (bf16)f2bf(x2 * cs + x1 * sn); }
            p += (C_K - C_Q);
            { const float x1 = bf2f(p[0]), x2 = bf2f(p[16]); p[0] = (bf16)f2bf(x1 * cs - x2 * sn); p[16] = (bf16)f2bf(x2 * cs + x1 * sn); } }
        for (int i = tid; i < 32 * 16 * 8; i += 512) { const int tk = i >> 7, h = (i >> 3) & 15, d = i & 7;
            const float cs = cst[2 * (tk * 24 + 16 + d)], sn = cst[2 * (tk * 24 + 16 + d) + 1];
            bf16* p = PROJ + (size_t)(t0 + tk) * NMAIN + C_QI + h * 64 + d;
            const float x1 = bf2f(p[0]), x2 = bf2f(p[8]); p[0] = (bf16)f2bf(x1 * cs - x2 * sn); p[8] = (bf16)f2bf(x2 * cs + x1 * sn); }
        __syncthreads();
        { const int n = wave; LAS float* xcs = (LAS float*)c.lds + wave * (32 * 132);
          const float* convw = (const float*)a.in[I_CONVW]; const float* convb = (const float*)a.in[I_CONVB]; const bf16* WRG = (const bf16*)(c.ws + WS_WRG);
          const float* brga = (const float*)a.in[I_BRGA]; const float* brgx = (const float*)a.in[I_BRGX]; const float* lam = (const float*)a.in[I_LAM];
          float* AG = (float*)(c.ws + WS_AG); float* BG = (float*)(c.ws + WS_BG);
#pragma unroll 1
          for (int m = 0; m < 2; ++m) { const int tk = 16 * m + fr, tok = t0 + tk;
              f32x4 accA[8], accX[8];
#pragma unroll
              for (int nt = 0; nt < 8; ++nt) { accA[nt] = (f32x4){0.f, 0.f, 0.f, 0.f}; accX[nt] = (f32x4){0.f, 0.f, 0.f, 0.f}; }
#pragma unroll 1
              for (int ks = 0; ks < 4; ++ks) { int fq8 = 8 * fq; asm volatile("" : "+v"(fq8));
                  const int chl = ks * 32 + fq8, ch = n * 128 + chl;
                  f32x4 x0 = *(const f32x4*)(convb + ch), x1 = *(const f32x4*)(convb + ch + 4);
#pragma unroll
                  for (int j = 0; j < 4; ++j) { const int tt = tok - 3 + j;
                      if (tt >= b * SEQ) { const v4u raw = *(const v4u*)(PROJ + (size_t)tt * NMAIN + C_XL + ch);
                          const f32x4 w0 = *(const f32x4*)(convw + j * D_LRU + ch), w1 = *(const f32x4*)(convw + j * D_LRU + ch + 4);
                          x0.x += w0.x * bflo(raw.x); x0.y += w0.y * bfhi(raw.x); x0.z += w0.z * bflo(raw.y); x0.w += w0.w * bfhi(raw.y);
                          x1.x += w1.x * bflo(raw.z); x1.y += w1.y * bfhi(raw.z); x1.z += w1.z * bflo(raw.w); x1.w += w1.w * bfhi(raw.w); } }
                  *(LAS f32x4*)(xcs + tk * 132 + chl) = x0; *(LAS f32x4*)(xcs + tk * 132 + chl + 4) = x1;
                  v4u o; o.x = pk2(x0.x, x0.y); o.y = pk2(x0.z, x0.w); o.z = pk2(x1.x, x1.y); o.w = pk2(x1.z, x1.w);
                  const bf16x8 af = __builtin_bit_cast(bf16x8, o);
#pragma unroll
                  for (int nt = 0; nt < 8; ++nt) { const size_t wo = ((size_t)n * 128 + 16 * nt + fr) * 128 + ks * 32 + fq8;
                      const bf16x8 ba = *(const bf16x8*)(WRG + wo), bx = *(const bf16x8*)(WRG + (size_t)8 * 16384 + wo);
                      accA[nt] = mfma16(af, ba, accA[nt]); accX[nt] = mfma16(af, bx, accX[nt]); } }
              LDS_WAIT(); asm volatile("" ::: "memory");
#pragma unroll
              for (int nt = 0; nt < 8; ++nt) { const int chl = 16 * nt + fr, ch = n * 128 + chl;
                  const float ba_ = brga[ch], bx_ = brgx[ch], sp = log1pf(__expf(-lam[ch]));
#pragma unroll
                  for (int r = 0; r < 4; ++r) { const int tk2 = 16 * m + 4 * fq + r;
                      const float ra = sigmoidf_(accA[nt][r] + ba_), ix = sigmoidf_(accX[nt][r] + bx_);
                      const float la = -8.0f * ra * sp, av = __expf(la), bc = sqrtf(-expm1f(2.0f * la)), xv = xcs[tk2 * 132 + chl];
                      AG[(size_t)(t0 + tk2) * D_LRU + ch] = av; BG[(size_t)(t0 + tk2) * D_LRU + ch] = bc * ix * xv; } } } }
        __syncthreads();
    }
}

__device__ __forceinline__ void p4_lru_scan(const Ctx& c) {
    float* AG = (float*)(c.ws + WS_AG); float* BG = (float*)(c.ws + WS_BG); float* AGG = (float*)(c.ws + WS_AGG);
    for (int li = c.gw; li < 2048; li += c.ngw) { const int b = li >> 10, ck = (li >> 4) & 63, ch = (li & 15) * 64 + c.lane; const size_t base = ((size_t)b * SEQ + ck * 64) * D_LRU + ch;
        float h = 0.f, P = 1.f;
        for (int t8 = 0; t8 < 64; t8 += 8) { float av[8], bv[8];
#pragma unroll
            for (int t = 0; t < 8; ++t) { av[t] = AG[base + (size_t)(t8 + t) * D_LRU]; bv[t] = BG[base + (size_t)(t8 + t) * D_LRU]; }
#pragma unroll
            for (int t = 0; t < 8; ++t) { h = av[t] * h + bv[t]; P *= av[t]; av[t] = P; bv[t] = h; }
#pragma unroll
            for (int t = 0; t < 8; ++t) { AG[base + (size_t)(t8 + t) * D_LRU] = av[t]; BG[base + (size_t)(t8 + t) * D_LRU] = bv[t]; } }
        AGG[((size_t)(0 * 2 + b) * 64 + ck) * D_LRU + ch] = P; AGG[((size_t)(1 * 2 + b) * 64 + ck) * D_LRU + ch] = h; }
}

constexpr int IDX_ROWB = 144;
constexpr int IDX_TILE = 256, IDX_BUFB = IDX_TILE * IDX_ROWB;
__device__ __forceinline__ void p4_indexer_item(const Ctx& c, int b, int q0) {
    const int tid = c.tid, lane = c.lane, wave = c.wave, r32 = lane & 31, hh = lane >> 5;
    const bf16* PROJ = (const bf16*)(c.ws + WS_PROJ); const bf16* KIDX = (const bf16*)(c.ws + WS_KIDX); const float* WIDX = (const float*)(c.ws + WS_WIDX);
    const int n = 64 * (q0 / 64 + 1), ntile = (n + IDX_TILE - 1) / IDX_TILE, nj = n / 32;
    const int tokA = b * SEQ + q0 + 2 * wave, myq = tokA + ((r32 >> 2) & 1), myh = (r32 & 3) + 4 * (r32 >> 3);
    bf16x8 af[4];
#pragma unroll
    for (int s = 0; s < 4; ++s) af[s] = *(const bf16x8*)(PROJ + (size_t)myq * NMAIN + C_QI + myh * 64 + 16 * s + 8 * hh);
    float wv[16];
#pragma unroll
    for (int r = 0; r < 16; ++r) wv[r] = WIDX[(size_t)(tokA + hh) * 16 + r];
    const int skey = tid >> 1, shalf = tid & 1;
    const bf16* kbase = KIDX + (size_t)b * SEQ * 64;
    v4u st[4];
    auto stage_load = [&](int tile) { int key = tile * IDX_TILE + skey; key = key < SEQ ? key : SEQ - 1;
#pragma unroll
        for (int q = 0; q < 4; ++q) st[q] = *(const v4u*)(kbase + (size_t)key * 64 + shalf * 32 + 8 * q); };
    auto stage_write = [&](int buf) {
#pragma unroll
        for (int q = 0; q < 4; ++q) *(LAS v4u*)(c.lds + buf * IDX_BUFB + skey * IDX_ROWB + shalf * 64 + 16 * q) = st[q]; };
    unsigned key_[128];
    stage_load(0); stage_write(0); __syncthreads();
#pragma unroll
    for (int tile = 0; tile < 16; ++tile) {
        if (tile < ntile) {
            if (tile + 1 < ntile) stage_load(tile + 1);
            const LAS unsigned char* kb = c.lds + (tile & 1) * IDX_BUFB + r32 * IDX_ROWB + hh * 16;
#pragma unroll
            for (int jj = 0; jj < 8; ++jj) { const int j = tile * 8 + jj;
                if (j < nj) {
                    f32x16 acc = {};
#pragma unroll
                    for (int s = 0; s < 4; ++s) { const bf16x8 bb = *(const LAS bf16x8*)(kb + jj * 32 * IDX_ROWB + s * 32); acc = mfma32(af[s], bb, acc); }
                    float sc = 0.f;
#pragma unroll
                    for (int r = 0; r < 16; ++r) sc += wv[r] * fmaxf(acc[r], 0.f);
                    const unsigned u = __builtin_bit_cast(unsigned, sc);
                    key_[j] = (u & 0x80000000u) ? ~u : (u | 0x80000000u);
                } else key_[j] = 0u; }
            if (tile + 1 < ntile) stage_write((tile + 1) & 1);
            __syncthreads();
        } else {
#pragma unroll
            for (int jj = 0; jj < 8; ++jj) key_[tile * 8 + jj] = 0u;
        }
    }
    unsigned prefix = 0u;
    for (int bit = 31; bit >= 0; --bit) { const unsigned cand = prefix | (1u << bit); int cnt = 0;
#pragma unroll
        for (int g = 0; g < 8; ++g) if (g * 16 < nj) {
#pragma unroll
            for (int jj = 0; jj < 16; ++jj) cnt += (key_[g * 16 + jj] >= cand) ? 1 : 0; }
#pragma unroll
        for (int o = 1; o < 32; o <<= 1) cnt += __shfl_xor(cnt, o);
        if (cnt >= 256) prefix = cand; }
    unsigned wA0 = 0u, wA1 = 0u, wB0 = 0u, wB1 = 0u;
#define CMP16(x_) (((x_) & 0xFu) | (((x_) >> 4) & 0xF0u) | (((x_) >> 8) & 0xF00u) | (((x_) >> 12) & 0xF000u))
    const unsigned thr = prefix > 1u ? prefix : 1u;
#pragma unroll
    for (int g = 0; g < 8; ++g) if (g * 16 < nj) {
#pragma unroll
    for (int jj = 0; jj < 16; ++jj) { const int j = g * 16 + jj; const unsigned long long m = __ballot(key_[j] >= thr);
        const unsigned ma = (unsigned)m, mb = (unsigned)(m >> 32);
        const unsigned a0 = CMP16(ma) << (16 * (j & 1)), a1 = CMP16(ma >> 4) << (16 * (j & 1)), b0 = CMP16(mb) << (16 * (j & 1)), b1 = CMP16(mb >> 4) << (16 * (j & 1));
        const int idx = 2 * (j >> 1);
        if (idx < 64) { if (lane == idx) { wA0 |= a0; wB0 |= b0; } if (lane == idx + 1) { wA0 |= a1; wB0 |= b1; } }
        else { if (lane == idx - 64) { wA1 |= a0; wB1 |= b0; } if (lane == idx - 63) { wA1 |= a1; wB1 |= b1; } } } }
#undef CMP16
    unsigned* MASK = (unsigned*)(c.ws + WS_MASK);
    MASK[(size_t)tokA * 128 + lane] = wA0; MASK[(size_t)tokA * 128 + 64 + lane] = wA1;
    MASK[(size_t)(tokA + 1) * 128 + lane] = wB0; MASK[(size_t)(tokA + 1) * 128 + 64 + lane] = wB1;
    __syncthreads();
}
__device__ __forceinline__ void p4_indexer(const Ctx& c) {
    for (int w = c.bid; w < 256; w += c.G) { const int b = w & 1, p = w >> 1;
        p4_indexer_item(c, b, 16 * p); p4_indexer_item(c, b, 16 * (255 - p)); }
}

__device__ __forceinline__ void p5_lru_apply(const Ctx& c) {
    const float* AG = (const float*)(c.ws + WS_AG); const float* BG = (const float*)(c.ws + WS_BG); const float* AGG = (const float*)(c.ws + WS_AGG);
    const bf16* PROJ = (const bf16*)(c.ws + WS_PROJ); bf16* YMIX = (bf16*)(c.ws + WS_YMIX);
    for (int li = c.gw; li < 2048; li += c.ngw) { const int b = li >> 10, ck = (li >> 4) & 63, ch = (li & 15) * 64 + c.lane; const size_t tok0 = (size_t)b * SEQ + ck * 64;
        float hc = 0.f;
        for (int cc = 0; cc < ck; ++cc) hc = AGG[((size_t)(0 * 2 + b) * 64 + cc) * D_LRU + ch] * hc + AGG[((size_t)(1 * 2 + b) * 64 + cc) * D_LRU + ch];
#pragma unroll 8
        for (int t = 0; t < 64; ++t) { const size_t tok = tok0 + t; const float h = BG[tok * D_LRU + ch] + AG[tok * D_LRU + ch] * hc;
            const float gl = bf2f(PROJ[tok * NMAIN + C_GL + ch]);
            YMIX[tok * DM + ch] = (bf16)f2bf(h * gelu_tanh(gl)); } }
}
__device__ __forceinline__ void p5_attention(const Ctx& c) {
    typedef att::bf16 abf;
    const abf* PROJ = (const abf*)(c.ws + WS_PROJ); abf* YMIX = (abf*)(c.ws + WS_YMIX); const unsigned long long* MASK = (const unsigned long long*)(c.ws + WS_MASK);
    for (int w = c.bid; w < 256; w += c.G) {
        const int xcd = w & 7, slot = w >> 3, bh = xcd * 2 + (slot >> 4), x = 15 - (slot & 15), b = bh >> 3, h = bh & 7;
        att::BlockRef<abf, abf> cur;
        const size_t tokb = (size_t)b * SEQ, tok0 = tokb + (size_t)x * 256;
        cur.Q = PROJ + tok0 * NMAIN + C_Q + h * 128; cur.K = PROJ + tokb * NMAIN + C_K + h * 128; cur.V = PROJ + tokb * NMAIN + C_V + h * 128;
        cur.O = YMIX + tok0 * DM + D_LRU + h * 128; cur.M = MASK + tok0 * 64; cur.P0 = x * 256;
        att::Seam<abf> S;
        att::causal_swa_prime<abf, abf>(cur, 1 << 30, (char*)c.lds, S);
        att::causal_swa_block<abf, abf>(cur, cur, SEQ, 1 << 30, (char*)c.lds, S);
        VM_WAIT(); __syncthreads();
    }
}

__device__ __forceinline__ void p7_rows(const Ctx& c, const Args& a) {
    const int lane = c.lane;
    float* X1 = (float*)(c.ws + WS_X1); bf16* U2 = (bf16*)(c.ws + WS_U2); const float* MODF = (const float*)(c.ws + WS_MODF);
    const float* g1 = (const float*)a.in[I_LN1G]; const float* b1 = (const float*)a.in[I_LN1B];
    for (int row = c.gw; row < NTOK; row += c.ngw) { const int b = row / SEQ;
        f32x4* xr = (f32x4*)(X1 + (size_t)row * DM) + lane;
        f32x4 v[8]; float s = 0.f;
#pragma unroll
        for (int j = 0; j < 8; ++j) { v[j] = xr[64 * j]; s += (v[j].x + v[j].y) + (v[j].z + v[j].w); }
        float mean = wave_sum(s) * (1.f / DM), s2 = 0.f;
#pragma unroll
        for (int j = 0; j < 8; ++j) { v[j] = v[j] - mean; s2 += (v[j].x * v[j].x + v[j].y * v[j].y) + (v[j].z * v[j].z + v[j].w * v[j].w); }
        float rstd = 1.f / sqrtf(wave_sum(s2) * (1.f / DM) + LN_EPS);
        s = 0.f;
#pragma unroll
        for (int j = 0; j < 8; ++j) { const int col = 4 * lane + 256 * j;
            v[j] = v[j] * rstd * *(const f32x4*)(g1 + col) + *(const f32x4*)(b1 + col);
            xr[64 * j] = v[j]; s += (v[j].x + v[j].y) + (v[j].z + v[j].w); }
        mean = wave_sum(s) * (1.f / DM); s2 = 0.f;
#pragma unroll
        for (int j = 0; j < 8; ++j) { v[j] = v[j] - mean; s2 += (v[j].x * v[j].x + v[j].y * v[j].y) + (v[j].z * v[j].z + v[j].w * v[j].w); }
        rstd = 1.f / sqrtf(wave_sum(s2) * (1.f / DM) + LN_EPS);
#pragma unroll
        for (int j = 0; j < 8; ++j) { const int col = 4 * lane + 256 * j;
            const f32x4 sh = *(const f32x4*)(MODF + (size_t)b * (6 * DM) + 3 * DM + col), sc = *(const f32x4*)(MODF + (size_t)b * (6 * DM) + 4 * DM + col);
            const f32x4 y = v[j] * rstd * (sc + 1.0f) + sh;
            v2u o; o.x = pk2(y.x, y.y); o.y = pk2(y.z, y.w);
            *(v2u*)(U2 + (size_t)row * DM + col) = o; }
    }
}

__device__ __forceinline__ unsigned f2key(float f) { const unsigned u = __builtin_bit_cast(unsigned, f); return u ^ ((unsigned)((int)u >> 31) | 0x80000000u); }
__device__ __forceinline__ float key2f(unsigned k) { const unsigned u = (k & 0x80000000u) ? (k ^ 0x80000000u) : ~k; return __builtin_bit_cast(float, u); }
#define INSK(k_, T) do { _Pragma("unroll") for (int q_ = 0; q_ < 16; ++q_) { const unsigned t_ = T[q_]; const unsigned mx_ = t_ > k_ ? t_ : k_; const unsigned mn_ = t_ > k_ ? k_ : t_; T[q_] = mx_; k_ = mn_; } } while (0)
__device__ __forceinline__ float wave_sum_u(float v) {
    v += __builtin_bit_cast(float, __builtin_amdgcn_mov_dpp(__builtin_bit_cast(int, v), 0xB1, 0xf, 0xf, true));
    v += __builtin_bit_cast(float, __builtin_amdgcn_mov_dpp(__builtin_bit_cast(int, v), 0x4E, 0xf, 0xf, true));
    v += __builtin_bit_cast(float, __builtin_amdgcn_mov_dpp(__builtin_bit_cast(int, v), 0x141, 0xf, 0xf, true));
    v += __builtin_bit_cast(float, __builtin_amdgcn_mov_dpp(__builtin_bit_cast(int, v), 0x140, 0xf, 0xf, true));
    const int iv = __builtin_bit_cast(int, v);
    return (__builtin_bit_cast(float, __builtin_amdgcn_readlane(iv, 0)) + __builtin_bit_cast(float, __builtin_amdgcn_readlane(iv, 16)))
         + (__builtin_bit_cast(float, __builtin_amdgcn_readlane(iv, 32)) + __builtin_bit_cast(float, __builtin_amdgcn_readlane(iv, 48)));
}
__device__ __forceinline__ float dot2bf(unsigned a, unsigned b, float c) {
    c = fmaf(bflo(a), bflo(b), c); return fmaf(bfhi(a), bfhi(b), c);
}
__device__ __forceinline__ void p9_peer(const Ctx& c, const Args& a) {
    const int lane = c.lane, wave = c.wave, fr = lane & 15, fq = lane >> 4;
    const bf16* QP = (const bf16*)(c.ws + WS_QP); const bf16* SUBK = (const bf16*)(c.ws + WS_SUBK); const bf16* U2 = (const bf16*)(c.ws + WS_U2);
    const unsigned char* PU8 = c.ws + WS_PU; const unsigned char* PV8 = c.ws + WS_PV; const float* PUS = (const float*)(c.ws + WS_PUS); const float* PVS = (const float*)(c.ws + WS_PVS); const float* X1 = (const float*)(c.ws + WS_X1);
    const float* MODF = (const float*)(c.ws + WS_MODF); const float* g2 = (const float*)a.in[I_LN2G]; const float* b2 = (const float*)a.in[I_LN2B];
    int* EIDX = (int*)(c.ws + WS_U1); float* PGW = (float*)(c.ws + WS_U1 + 4 * MiB);
    for (int it = c.bid; it < NTOK / 32; it += c.G) {
        const int t0 = it * 32;
#ifndef P9_NOROUTE
        for (int rrep = 0; rrep < NREP(91); ++rrep)
        { LAS float* sb = (LAS float*)c.lds + wave * (32 * 129); const int h = wave;
#pragma unroll 1
          for (int m = 0; m < 2; ++m) {
              int fq8 = 8 * fq; asm volatile("" : "+v"(fq8));
              { f32x4 acc[2][8];
#pragma unroll
                for (int p = 0; p < 2; ++p)
#pragma unroll
                    for (int nt = 0; nt < 8; ++nt) acc[p][nt] = (f32x4){0.f, 0.f, 0.f, 0.f};
#pragma unroll
                for (int p = 0; p < 2; ++p)
#pragma unroll
                    for (int ks = 0; ks < 4; ++ks) { const bf16x8 av = *(const bf16x8*)(QP + (size_t)(t0 + 16 * m + fr) * DM + h * 256 + p * 128 + ks * 32 + fq8);
#pragma unroll
                        for (int nt = 0; nt < 8; ++nt) { const bf16x8 bv = *(const bf16x8*)(SUBK + ((size_t)(h * 2 + p) * 128 + 16 * nt + fr) * 128 + ks * 32 + fq8);
                            acc[p][nt] = mfma16(av, bv, acc[p][nt]); } }
#pragma unroll
                for (int p = 0; p < 2; ++p)
#pragma unroll
                    for (int nt = 0; nt < 8; ++nt)
#pragma unroll
                        for (int r = 0; r < 4; ++r) sb[(p * 16 + 4 * fq + r) * 129 + 16 * nt + fr] = acc[p][nt][r]; }
              LDS_WAIT(); asm volatile("" ::: "memory");
              unsigned T[16];
#pragma unroll
              for (int q = 0; q < 16; ++q) T[q] = 0u;
              { const int half = lane >> 5; const LAS float* row = sb + (lane & 31) * 129 + half * 64;
#pragma unroll 4
                for (int k = 0; k < 64; ++k) { unsigned key = (f2key(row[k]) & 0xFFFFFF80u) | (unsigned)(127 - (half * 64 + k)); INSK(key, T); } }
              { unsigned P[16];
#pragma unroll
                for (int q = 0; q < 16; ++q) P[q] = (unsigned)__shfl_xor((int)T[q], 32);
#pragma unroll
                for (int q = 0; q < 16; ++q) { unsigned key = P[q]; INSK(key, T); } }
              unsigned T2[16];
#pragma unroll
              for (int q = 0; q < 16; ++q) T2[q] = (unsigned)__shfl((int)T[q], (lane & 15) + 16);
              LDS_WAIT(); asm volatile("" ::: "memory");
              LAS int* ib = (LAS int*)sb;
              if (lane < 16) {
#pragma unroll
                  for (int q = 0; q < 16; ++q) { ib[lane * 33 + q] = 127 - (int)(T[q] & 0x7Fu); ib[lane * 33 + 16 + q] = 127 - (int)(T2[q] & 0x7Fu); } }
              float f1[16], f2[16];
#pragma unroll
              for (int q = 0; q < 16; ++q) { f1[q] = key2f(T[q] & 0xFFFFFF80u); f2[q] = key2f(T2[q] & 0xFFFFFF80u); }
              unsigned C[16];
#pragma unroll
              for (int q = 0; q < 16; ++q) C[q] = 0u;
#pragma unroll
              for (int a_ = 0; a_ < 16; ++a_)
#pragma unroll
                  for (int b_ = 0; b_ < 16; ++b_) if ((a_ + 1) * (b_ + 1) <= 16) { unsigned key = (f2key(f1[a_] + f2[b_]) & 0xFFFFFF00u) | (unsigned)(255 - (a_ * 16 + b_)); INSK(key, C); }
              LDS_WAIT(); asm volatile("" ::: "memory");
              if (lane < 16) {
                  const float mx = key2f(C[0] & 0xFFFFFF00u); float ev[16], sum = 0.f;
#pragma unroll
                  for (int q = 0; q < 16; ++q) { ev[q] = __expf(key2f(C[q] & 0xFFFFFF00u) - mx); sum += ev[q]; }
                  const float rs = 1.0f / sum;
#pragma unroll
                  for (int q = 0; q < 16; ++q) { const int code = 255 - (int)(C[q] & 0xFFu);
                      const int eid = ib[lane * 33 + (code >> 4)] * 128 + ib[lane * 33 + 16 + (code & 15)];
                      EIDX[(size_t)(t0 + 16 * m + lane) * 128 + h * 16 + q] = eid; PGW[(size_t)(t0 + 16 * m + lane) * 128 + h * 16 + q] = ev[q] * rs; } }
              LDS_WAIT(); asm volatile("" ::: "memory");
          } }
#endif
        VM_WAIT(); __syncthreads();
#ifndef P9_NOGATHER
        for (int grep_ = 0; grep_ < NREP(92); ++grep_)
#pragma unroll 1
        for (int i4 = 0; i4 < 4; ++i4) { const int tok = t0 + wave * 4 + i4, b = tok / SEQ;
            int l16 = 16 * lane; asm volatile("" : "+v"(l16));
            f32x2 uu[2][8];
#pragma unroll
            for (int cc = 0; cc < 2; ++cc)
#pragma unroll
                for (int hq = 0; hq < 2; ++hq) { const v4u r = *(const v4u*)(U2 + (size_t)tok * DM + 1024 * cc + l16 + 8 * hq);
                    uu[cc][4 * hq + 0] = (f32x2){bflo(r.x), bfhi(r.x)}; uu[cc][4 * hq + 1] = (f32x2){bflo(r.y), bfhi(r.y)}; uu[cc][4 * hq + 2] = (f32x2){bflo(r.z), bfhi(r.z)}; uu[cc][4 * hq + 3] = (f32x2){bflo(r.w), bfhi(r.w)}; }
            f32x2 acc[2][8];
#pragma unroll
            for (int cc = 0; cc < 2; ++cc)
#pragma unroll
                for (int q = 0; q < 8; ++q) acc[cc][q] = (f32x2){0.f, 0.f};
#pragma unroll 1
            for (int hf = 0; hf < 2; ++hf) {
                const int myi = EIDX[(size_t)tok * 128 + hf * 64 + lane]; const float myg = PGW[(size_t)tok * 128 + hf * 64 + lane];
                const float mysu = PUS[myi], mysv = PVS[myi];
#pragma unroll 1
                for (int e4 = 0; e4 < 64; e4 += 4) {
                    int ex[4]; float gu[4], gv[4];
#pragma unroll
                    for (int q = 0; q < 4; ++q) { ex[q] = __builtin_amdgcn_readlane(myi, e4 + q);
                        gu[q] = __builtin_bit_cast(float, __builtin_amdgcn_readlane(__builtin_bit_cast(int, mysu), e4 + q));
                        gv[q] = __builtin_bit_cast(float, __builtin_amdgcn_readlane(__builtin_bit_cast(int, myg * mysv), e4 + q)); }
                    v4u ru[4][2];
#pragma unroll
                    for (int q = 0; q < 4; ++q)
#pragma unroll
                        for (int cc = 0; cc < 2; ++cc) ru[q][cc] = *(const v4u*)(PU8 + (size_t)ex[q] * DM + 1024 * cc + l16);
                    __builtin_amdgcn_sched_barrier(0);
                    v4u rv[4][2];
#pragma unroll
                    for (int q = 0; q < 4; ++q)
#pragma unroll
                        for (int cc = 0; cc < 2; ++cc) rv[q][cc] = *(const v4u*)(PV8 + (size_t)ex[q] * DM + 1024 * cc + l16);
                    __builtin_amdgcn_sched_barrier(0);
                    float hk[4];
#pragma unroll
                    for (int q = 0; q < 4; ++q) { f32x2 d = {0.f, 0.f};
#pragma unroll
                        for (int cc = 0; cc < 2; ++cc)
#pragma unroll
                            for (int w = 0; w < 4; ++w) { const int wd = (int)ru[q][cc][w];
                                d += __builtin_amdgcn_cvt_pk_f32_fp8(wd, false) * uu[cc][2 * w]; d += __builtin_amdgcn_cvt_pk_f32_fp8(wd, true) * uu[cc][2 * w + 1]; }
                        hk[q] = gv[q] * gelu_tanh(wave_sum_u(d.x + d.y) * gu[q]); }
                    __builtin_amdgcn_sched_barrier(0);
#pragma unroll
                    for (int q = 0; q < 4; ++q)
#pragma unroll
                        for (int cc = 0; cc < 2; ++cc)
#pragma unroll
                            for (int w = 0; w < 4; ++w) { const int wd = (int)rv[q][cc][w];
                                acc[cc][2 * w] += __builtin_amdgcn_cvt_pk_f32_fp8(wd, false) * hk[q]; acc[cc][2 * w + 1] += __builtin_amdgcn_cvt_pk_f32_fp8(wd, true) * hk[q]; }
                    __builtin_amdgcn_sched_barrier(0);
                } }
            float s = 0.f; f32x4 z[2][4];
#pragma unroll
            for (int cc = 0; cc < 2; ++cc)
#pragma unroll
                for (int w = 0; w < 4; ++w) { const int col = 1024 * cc + l16 + 4 * w;
                    const f32x4 xv = *(const f32x4*)(X1 + (size_t)tok * DM + col), gt = *(const f32x4*)(MODF + (size_t)b * (6 * DM) + 5 * DM + col);
                    const f32x4 yv = {acc[cc][2 * w].x, acc[cc][2 * w].y, acc[cc][2 * w + 1].x, acc[cc][2 * w + 1].y};
                    z[cc][w] = xv * DN_ALPHA + (gt + 1.0f) * yv;
                    s += (z[cc][w].x + z[cc][w].y) + (z[cc][w].z + z[cc][w].w); }
            const float mean = wave_sum_u(s) * (1.f / DM); float s2 = 0.f;
#pragma unroll
            for (int cc = 0; cc < 2; ++cc)
#pragma unroll
                for (int w = 0; w < 4; ++w) { z[cc][w] = z[cc][w] - mean; s2 += (z[cc][w].x * z[cc][w].x + z[cc][w].y * z[cc][w].y) + (z[cc][w].z * z[cc][w].z + z[cc][w].w * z[cc][w].w); }
            const float rstd = 1.f / sqrtf(wave_sum_u(s2) * (1.f / DM) + LN_EPS);
#pragma unroll
            for (int cc = 0; cc < 2; ++cc)
#pragma unroll
                for (int w = 0; w < 4; ++w) { const int col = 1024 * cc + l16 + 4 * w;
                    *(f32x4*)(a.out + (size_t)tok * DM + col) = z[cc][w] * rstd * *(const f32x4*)(g2 + col) + *(const f32x4*)(b2 + col); }
        }
#endif
        __syncthreads();
    }
}

#ifndef MK_SINGLE
#define MK_SINGLE 1
#endif
constexpr int NPHASE = 10;
constexpr int CW_BAR = 4096;

__global__ void __launch_bounds__(NWAVES * 64, 2) fwd_kernel(Args args) {
    extern __shared__ __attribute__((aligned(16))) unsigned char lds_raw[];
    Ctx c;
    c.lds = (LAS unsigned char*)lds_raw; c.ws = args.ws;
    c.tid = threadIdx.x; c.lane = c.tid & 63; c.wave = __builtin_amdgcn_readfirstlane(c.tid >> 6);
    c.bid = blockIdx.x; c.G = gridDim.x; c.gw = c.bid * NWAVES + c.wave; c.ngw = c.G * NWAVES;
    volatile LAS unsigned* MISC = (volatile LAS unsigned*)(c.lds + MISC_OFF);
    if (c.tid < 64) MISC[c.tid] = 0u;
    __syncthreads();
    const int lo = args.ph_lo, hi = args.ph_hi;
    XcdBarrier bar; bar.bar = (unsigned*)(c.ws + WS_CTL) + CW_BAR; bar.x = 0; bar.st = nullptr;
    if (hi - lo > 1) bar = xcd_barrier_post((unsigned*)(c.ws + WS_CTL) + CW_BAR, MISC + 8);
#ifdef ONLY
#define IN(k) ((k) == ONLY)
#else
#define IN(k) (lo <= (k) && (k) < hi)
#endif
#define SEAM(k) do { if (IN(k) && IN((k) + 1)) xcd_barrier(bar); } while (0)

    if (IN(0)) { for (int rep = 0; rep < NREP(0); ++rep) { p0_prologue(c, args); } } SEAM(0);
    if (IN(1)) { for (int rep = 0; rep < NREP(1); ++rep) { p1_u1(c, args); } } SEAM(1);
    if (IN(2)) {
        pg8::Gemm g{(const pg8::bf16_t*)(c.ws + WS_U1), (const pg8::bf16_t*)(c.ws + WS_WIN), NTOK, NMAIN, DM}; pg8::StaticOrder S; S.init(NTOK, NMAIN, c.G, c.bid);
        pg8::EpiBf16<0> E{(pg8::bf16_t*)(c.ws + WS_PROJ), NMAIN, nullptr, 0, 0, 1.f};
        for (int rep = 0; rep < NREP(2); ++rep) pg8::gemm_phase<pg8::EpiBf16<0>, pg8::StaticOrder, true, true>(c.lds, g, S, E);
    } SEAM(2);
    if (IN(3)) { p3_post(c, args); } SEAM(3);
    if (IN(4)) { p4_lru_scan(c); for (int rep = 0; rep < NREP(4); ++rep) { p4_indexer(c); } } SEAM(4);
    if (IN(5)) { for (int rep = 0; rep < NREP(50); ++rep) { p5_lru_apply(c); } for (int rep = 0; rep < NREP(5); ++rep) { p5_attention(c); } } SEAM(5);
    if (IN(6)) {
        pg8::Gemm g{(const pg8::bf16_t*)(c.ws + WS_YMIX), (const pg8::bf16_t*)(c.ws + WS_WOUT), NTOK, DM, DM}; pg8::StaticOrder S; S.init(NTOK, DM, c.G, c.bid);
        pg8::EpiResF32 E{(const float*)args.in[I_X], (float*)(c.ws + WS_X1), (const float*)(c.ws + WS_MODF) + 2 * DM, DM, SEQ, 6 * DM, DN_ALPHA};
        for (int rep = 0; rep < NREP(6); ++rep) pg8::gemm_phase<pg8::EpiResF32, pg8::StaticOrder, true, true>(c.lds, g, S, E);
    } SEAM(6);
    if (IN(7)) { p7_rows(c, args); } SEAM(7);
    if (IN(8)) {
        pg8::Gemm g{(const pg8::bf16_t*)(c.ws + WS_U2), (const pg8::bf16_t*)(c.ws + WS_WPQ), NTOK, DM, DM}; pg8::StaticOrder S; S.init(NTOK, DM, c.G, c.bid);
        pg8::EpiBf16<0> E{(pg8::bf16_t*)(c.ws + WS_QP), DM, nullptr, 0, 0, 1.f};
        for (int rep = 0; rep < NREP(8); ++rep) pg8::gemm_phase<pg8::EpiBf16<0>, pg8::StaticOrder, true, true>(c.lds, g, S, E);
    } SEAM(8);
    if (IN(9)) { for (int rep = 0; rep < NREP(9); ++rep) { p9_peer(c, args); } }
#undef IN
#undef SEAM
}

extern "C" void kernel_launch(void* const* d_in, const int* in_sizes, int n_in, void* d_out, int out_size, void* d_ws, size_t ws_size, hipStream_t stream) {
    static int grid = 0;
    if (grid == 0) {
        if (n_in != 23 || in_sizes[0] != NTOK * DM || out_size != NTOK * DM || ws_size < WS_END) {
            fprintf(stderr, "kernel_launch: unexpected shapes (n_in %d, in0 %d, out %d, ws %zu); nothing launched\n", n_in, n_in > 0 ? in_sizes[0] : -1, out_size, ws_size); grid = -1; return; }
        int dev = 0, cus = 0, per_cu = 0;
        if (hipGetDevice(&dev) != hipSuccess || hipDeviceGetAttribute(&cus, hipDeviceAttributeMultiprocessorCount, dev) != hipSuccess) { grid = -1; return; }
        if (hipFuncSetAttribute((const void*)fwd_kernel, hipFuncAttributeMaxDynamicSharedMemorySize, LDS_BYTES) != hipSuccess) { fprintf(stderr, "kernel_launch: hipFuncSetAttribute failed\n"); grid = -1; return; }
        if (hipOccupancyMaxActiveBlocksPerMultiprocessor(&per_cu, (const void*)fwd_kernel, NWAVES * 64, LDS_BYTES) != hipSuccess || per_cu < 1) { fprintf(stderr, "kernel_launch: occupancy query says %d\n", per_cu); }
        (void)hipGetLastError();
        grid = cus;
    }
    if (grid < 0) return;
    (void)hipMemsetAsync((char*)d_ws + WS_CTL, 0, CTL_ZERO_BYTES, stream);
    Args a{};
    for (int i = 0; i < 23; ++i) a.in[i] = d_in[i];
    a.out = (float*)d_out; a.ws = (unsigned char*)d_ws;
#if MK_SINGLE
    a.ph_lo = 0; a.ph_hi = NPHASE;
    hipLaunchKernelGGL(fwd_kernel, dim3(grid), dim3(NWAVES * 64), LDS_BYTES, stream, a);
#else
    for (int p = 0; p < NPHASE; ++p) { a.ph_lo = p; a.ph_hi = p + 1; hipLaunchKernelGGL(fwd_kernel, dim3(grid), dim3(NWAVES * 64), LDS_BYTES, stream, a); }
#endif
}
```

```cpp
#include <hip/hip_runtime.h>
#include <hip/hip_bf16.h>
#include <cstdio>
#include <cstdint>
#include <cmath>
#ifndef REP_PHASE
#define REP_PHASE -1
#endif
#define NREP(k) ((k) == REP_PHASE ? 2 : 1)

constexpr int NB = 2, SEQ = 4096, NTOK = NB * SEQ, DM = 2048;
constexpr int D_LRU = 1024, D_ATT = 1024, NHEAD = 8, HDIM = 128, NIH = 16, IDIM = 64;
constexpr int DIN = 6224, NMAIN = 6144;
constexpr int C_XL = 0, C_GL = 1024, C_Q = 2048, C_K = 3072, C_V = 4096, C_QI = 5120, C_KI = 6144, C_WI = 6208;
constexpr int NEXP = 16384, PKD = 256, PTOPK = 16, PHEADS = 8, NKEYS = 128;
constexpr float LN_EPS = 1e-5f;
constexpr float DN_ALPHA = 1.189207115002721f;

constexpr size_t MiB = 1u << 20;
constexpr size_t WS_CTL = 0, CTL_ZERO_BYTES = 1 * MiB;
constexpr size_t WS_MODP = 1 * MiB;
constexpr size_t WS_MODF = 4 * MiB;
constexpr size_t WS_PUS = 4 * MiB + 256 * 1024, WS_PVS = 4 * MiB + 512 * 1024;
constexpr size_t WS_WRG  = 5 * MiB;
constexpr size_t WS_SUBK = 6 * MiB;
constexpr size_t WS_KIDX = 7 * MiB;
constexpr size_t WS_WIDX = 8 * MiB;
constexpr size_t WS_AGG  = 9 * MiB;
constexpr size_t WS_MASK = 10 * MiB;
constexpr size_t WS_WIN  = 14 * MiB;
constexpr size_t WS_WOUT = 40 * MiB;
constexpr size_t WS_WPQ  = 48 * MiB;
constexpr size_t WS_PU   = 56 * MiB;
constexpr size_t WS_PV   = 120 * MiB;
constexpr size_t WS_U1   = 184 * MiB;
constexpr size_t WS_PROJ = 216 * MiB;
constexpr size_t WS_AG   = 312 * MiB;
constexpr size_t WS_BG   = 344 * MiB;
constexpr size_t WS_ROPE = 376 * MiB;
constexpr size_t WS_END  = 378 * MiB;
constexpr size_t WS_MODA = 512 * 1024;
constexpr size_t WS_YMIX = WS_U1, WS_X1 = WS_PROJ, WS_U2 = WS_PROJ + 64 * MiB, WS_QP = WS_AG;

#define GAS __attribute__((address_space(1)))
#define LAS __attribute__((address_space(3)))
typedef unsigned short bf16;
typedef unsigned v4u __attribute__((ext_vector_type(4)));
typedef unsigned v2u __attribute__((ext_vector_type(2)));
typedef float f32x4 __attribute__((ext_vector_type(4)));
typedef float f32x2 __attribute__((ext_vector_type(2)));
typedef float f32x16 __attribute__((ext_vector_type(16)));
typedef short bf16x8 __attribute__((ext_vector_type(8)));
typedef short s16x4 __attribute__((ext_vector_type(4)));
#define RLX_AGENT __ATOMIC_RELAXED, __HIP_MEMORY_SCOPE_AGENT
#define LDS_WAIT() asm volatile("s_waitcnt lgkmcnt(0)" ::: "memory")
#define VM_WAIT() asm volatile("s_waitcnt vmcnt(0)" ::: "memory")
__device__ __forceinline__ unsigned f2bf(float f) { unsigned u = __builtin_bit_cast(unsigned, f); return (u + 0x7fffu + ((u >> 16) & 1u)) >> 16; }
__device__ __forceinline__ unsigned pk2(float lo, float hi) { return f2bf(lo) | (f2bf(hi) << 16); }
__device__ __forceinline__ float bflo(unsigned w) { return __builtin_bit_cast(float, w << 16); }
__device__ __forceinline__ float bfhi(unsigned w) { return __builtin_bit_cast(float, w & 0xffff0000u); }
__device__ __forceinline__ float bf2f(bf16 h) { return __builtin_bit_cast(float, (unsigned)h << 16); }
__device__ __forceinline__ float wave_sum(float v) {
#pragma unroll
    for (int o = 1; o < 64; o <<= 1) v += __shfl_xor(v, o);
    return v;
}
__device__ __forceinline__ float sigmoidf_(float x) { return 1.0f / (1.0f + __expf(-x)); }
__device__ __forceinline__ float gelu_tanh(float x) {
    const float u = 1.5957691216057308f * (x + 0.044715f * x * x * x);
    return x / (1.0f + __expf(-u));
}
namespace pg8 {
#define PG8_LAS __attribute__((address_space(3)))
typedef unsigned short bf16_t;
typedef short bf16x8 __attribute__((ext_vector_type(8)));
typedef float f32x4 __attribute__((ext_vector_type(4)));
typedef unsigned u32x4 __attribute__((ext_vector_type(4)));
constexpr int BM = 256, BK = 64, HALF = 128, HTB = HALF * BK * 2  , STAGE_BYTES = 8 * HTB, NXCD = 8, WGM = 8;

__host__ __device__ __forceinline__ int lds_byte(int r, int c) { const int st = (r >> 4) * 2 + (c >> 5), rr = r & 15, cc = c & 31, ob = rr * 64 + cc * 2; return st * 1024 + (ob ^ (((ob >> 9) & 1) << 5)); }
__host__ __device__ __forceinline__ void stage_rc(int b, int& R, int& C) { const int st = b / 1024, sb = b % 1024, swz = sb ^ (((sb >> 9) & 1) << 5); R = (st >> 1) * 16 + swz / 64; C = (st & 1) * 32 + (swz % 64) / 2; }
__host__ __device__ __forceinline__ int perm32(int rho) { const int n = rho >> 4, i = rho & 15; return 8 * (i >> 2) + 4 * n + (i & 3); }

struct Unit { int pm, pn; };
struct Gemm { const bf16_t* A; const bf16_t* Bt; int M, N, K; };

struct StaticOrder {
    int nM, nN, nwg, G, c;
    __host__ __device__ void init(int M, int N, int G_, int c_) { nM = M / BM; nN = N / BM; nwg = nM * nN; G = G_; c = c_; }
    __host__ __device__ bool next(int i, Unit& u) const {
        const long L = (long)i * G + c; if (L >= nwg) return false;
        int wgid = (int)L; { const int q = nwg / NXCD, r = nwg % NXCD, xcd = wgid % NXCD, off = wgid / NXCD; wgid = (xcd < r ? xcd * (q + 1) : r * (q + 1) + (xcd - r) * q) + off; }
        const int nig = WGM * nN, gid = wgid / nig, fm = gid * WGM, gsz = (nM - fm) < WGM ? (nM - fm) : WGM;
        u.pm = fm + ((wgid % nig) % gsz); u.pn = (wgid % nig) / gsz; return true;
    }
    __device__ __forceinline__ void a_ready(const Unit&) const {}
    __device__ __forceinline__ void done(const Unit&) const {}
};

__device__ __forceinline__ unsigned cvt_pk_bf16(float lo, float hi) { unsigned r; asm volatile("v_cvt_pk_bf16_f32 %0, %1, %2" : "=v"(r) : "v"(lo), "v"(hi)); return r; }
typedef float f32x2 __attribute__((ext_vector_type(2)));
__device__ __forceinline__ f32x2 gelu_pk(f32x2 v) {
    const f32x2 av = __builtin_elementwise_abs(v), d = av * 0.2316418882f + 1.0f;
    f32x2 t; t.x = __builtin_amdgcn_rcpf(d.x); t.y = __builtin_amdgcn_rcpf(d.y);
    f32x2 q = t * 0.5307027145f + (-0.7265760135f); q = q * t + 0.7107068705f; q = q * t + (-0.142248368f); q = q * t + 0.127414796f; q = q * t;
    const f32x2 s = (v * v) * (-0.72134752044f);
    f32x2 e; e.x = __builtin_amdgcn_exp2f(s.x); e.y = __builtin_amdgcn_exp2f(s.y);
    const f32x2 m = v * (q * e), r = v - m;
    f32x2 o; o.x = v.x < 0.f ? m.x : r.x; o.y = v.y < 0.f ? m.y : r.y; return o;
}

template <int ACT  > struct EpiBf16 {
    static constexpr bool PERM = true, AFTER_DRAIN = false; static_assert(ACT == 0 || ACT == 1, "EpiBf16: ACT is 0 (none) or 1 (gelu_pk)");
    bf16_t* O; int ldc; const float* bias; int split_cols; size_t split_stride; float scale0;
    __device__ __forceinline__ void operator()(const f32x4 (&acc)[2][2][4][2], const Unit& u, int wr, int wc, int fr, int fq) const {
        const int row0 = u.pm * BM + wr * 64 + fr; int colt = u.pn * BM; bf16_t* base = O;
        float sc = 1.f; if (split_cols) { const int t = colt / split_cols; base += (size_t)t * split_stride; colt -= t * split_cols; if (t == 0) sc = scale0; }
        const int col0 = colt + wc * 32 + 8 * fq, bcol0 = u.pn * BM + wc * 32 + 8 * fq;
        f32x4 bv[2][2];
#pragma unroll
        for (int bj = 0; bj < 2; ++bj)
#pragma unroll
            for (int n = 0; n < 2; ++n) bv[bj][n] = bias ? *(const f32x4*)(bias + bcol0 + bj * HALF + 4 * n) : (f32x4){0.f, 0.f, 0.f, 0.f};
#pragma unroll
        for (int ai = 0; ai < 2; ++ai)
#pragma unroll
            for (int m = 0; m < 4; ++m) { bf16_t* rowp = base + (size_t)(row0 + ai * HALF + m * 16) * ldc + col0;
#pragma unroll
                for (int bj = 0; bj < 2; ++bj) { f32x4 v0 = acc[ai][bj][m][0] + bv[bj][0], v1 = acc[ai][bj][m][1] + bv[bj][1];
                    if (ACT == 1) { f32x2 a = gelu_pk((f32x2){v0[0], v0[1]}), b = gelu_pk((f32x2){v0[2], v0[3]}), c = gelu_pk((f32x2){v1[0], v1[1]}), d = gelu_pk((f32x2){v1[2], v1[3]});
                        v0 = (f32x4){a.x, a.y, b.x, b.y}; v1 = (f32x4){c.x, c.y, d.x, d.y}; }
                    v0 = v0 * sc; v1 = v1 * sc; u32x4 w; w.x = cvt_pk_bf16(v0[0], v0[1]); w.y = cvt_pk_bf16(v0[2], v0[3]); w.z = cvt_pk_bf16(v1[0], v1[1]); w.w = cvt_pk_bf16(v1[2], v1[3]);
                    *(u32x4*)(rowp + bj * HALF) = w; } }
    }
};

struct EpiProj {
    static constexpr bool PERM = true, AFTER_DRAIN = false;
    bf16_t* O; int ldc; const float* CS;
    __device__ __forceinline__ void operator()(const f32x4 (&acc)[2][2][4][2], const Unit& u, int wr, int wc, int fr, int fq) const {
        const int row0 = u.pm * BM + wr * 64 + fr, col0 = u.pn * BM + wc * 32 + 8 * fq, region = (u.pn * BM) >> 10;
        const int mode = (region == 2 || region == 3) ? (wc == 0 ? 1 : 0) : (region == 5 ? ((wc & 1) == 0 ? 2 : 0) : 0);
#pragma unroll
        for (int ai = 0; ai < 2; ++ai)
#pragma unroll
            for (int m = 0; m < 4; ++m) { const int row = row0 + ai * HALF + m * 16; bf16_t* rowp = O + (size_t)row * ldc + col0;
                f32x4 c0 = {1.f, 1.f, 1.f, 1.f}, c1 = c0, s0 = {0.f, 0.f, 0.f, 0.f}, s1 = s0;
                if (mode == 1) { const float* cs = CS + (size_t)row * 48 + 8 * (fq & 1); c0 = *(const f32x4*)cs; c1 = *(const f32x4*)(cs + 4); s0 = *(const f32x4*)(cs + 16); s1 = *(const f32x4*)(cs + 20); if (fq < 2) { s0 = -s0; s1 = -s1; } }
                if (mode == 2) { const float* cs = CS + (size_t)row * 48 + 32; if (fq < 2) { c0 = *(const f32x4*)cs; c1 = *(const f32x4*)(cs + 4); s0 = *(const f32x4*)(cs + 8); s1 = *(const f32x4*)(cs + 12); if (fq == 0) { s0 = -s0; s1 = -s1; } } }
#pragma unroll
                for (int bj = 0; bj < 2; ++bj) { f32x4 v0 = acc[ai][bj][m][0], v1 = acc[ai][bj][m][1];
                    if (mode != 0) { const int xm = mode == 1 ? 32 : 16; f32x4 o0, o1;
#pragma unroll
                        for (int e = 0; e < 4; ++e) { o0[e] = __shfl_xor(v0[e], xm); o1[e] = __shfl_xor(v1[e], xm); }
                        v0 = v0 * c0 + o0 * s0; v1 = v1 * c1 + o1 * s1; }
                    u32x4 w; w.x = cvt_pk_bf16(v0[0], v0[1]); w.y = cvt_pk_bf16(v0[2], v0[3]); w.z = cvt_pk_bf16(v1[0], v1[1]); w.w = cvt_pk_bf16(v1[2], v1[3]);
                    *(u32x4*)(rowp + bj * HALF) = w; } }
    }
};

struct EpiResF32 {
    static constexpr bool PERM = false, AFTER_DRAIN = false;
    const float* X; float* Z; const float* gate; int ldc, rows_per_batch, gstride; float alpha;
    __device__ __forceinline__ void operator()(const f32x4 (&acc)[2][2][4][2], const Unit& u, int wr, int wc, int fr, int fq) const {
        const int row0 = u.pm * BM + wr * 64 + fr, col0 = u.pn * BM + wc * 32 + 4 * fq;
        const float* gb = gate + (size_t)((u.pm * BM) / rows_per_batch) * gstride;
        f32x4 gv[2][2];
#pragma unroll
        for (int bj = 0; bj < 2; ++bj)
#pragma unroll
            for (int n = 0; n < 2; ++n) gv[bj][n] = *(const f32x4*)(gb + col0 + bj * HALF + n * 16) + 1.0f;
#pragma unroll
        for (int ai = 0; ai < 2; ++ai)
#pragma unroll
            for (int m = 0; m < 4; ++m) { const size_t off = (size_t)(row0 + ai * HALF + m * 16) * ldc + col0;
#pragma unroll
                for (int bj = 0; bj < 2; ++bj)
#pragma unroll
                    for (int n = 0; n < 2; ++n) { const f32x4 xv = *(const f32x4*)(X + off + bj * HALF + n * 16);
                        *(f32x4*)(Z + off + bj * HALF + n * 16) = xv * alpha + gv[bj][n] * acc[ai][bj][m][n]; } }
    }
};

template <class Epi, class Sched, bool ALIGN_EPI = false, bool SP2 = false>
__device__ __forceinline__ void gemm_phase(PG8_LAS unsigned char* lds, const Gemm g, const Sched& S, const Epi& E) {
    const int tid = threadIdx.x, wid = __builtin_amdgcn_readfirstlane(tid >> 6), lane = tid & 63, wr = wid >> 2, wc = wid & 3, fr = lane & 15, fq = lane >> 4;
    const int K = g.K, nt = K / BK;
    unsigned voffA[2], voffB[2];
#pragma unroll
    for (int i = 0; i < 2; ++i) { int R, C; stage_rc(tid * 16 + i * 8192, R, C); const int Rb = Epi::PERM ? ((R & ~31) + perm32(R & 31)) : R;
        voffA[i] = (unsigned)(R * K + C) * 2u; voffB[i] = (unsigned)(Rb * K + C) * 2u; }
    const size_t kstep = (size_t)(BK * 2);
    const size_t hstep = (size_t)HALF * K * 2;
    const size_t tstep = 2 * hstep;
    const unsigned ldsw = (unsigned)wid * 1024u;
    const int aoff = lds_byte(wr * 64 + fr, fq * 8), boff = lds_byte(wc * 32 + fr, fq * 8);
#define PG8_SA(b, h) (((b) * 2 + (h)) * HTB)
#define PG8_SB(b, h) ((4 + (b) * 2 + (h)) * HTB)
#define PG8_STAGE(bufoff, gbase, voff) do { _Pragma("unroll") for (int _i = 0; _i < 2; ++_i) \
        __builtin_amdgcn_global_load_lds((const unsigned*)((const char*)(gbase) + (voff)[_i]), (PG8_LAS unsigned*)(lds + (bufoff) + ldsw + _i * 8192), 16, 0, 0); } while (0)
#define PG8_LDA(dst, b, h) do { _Pragma("unroll") for (int m = 0; m < 4; ++m) _Pragma("unroll") for (int k = 0; k < 2; ++k) dst[m][k] = *(const PG8_LAS bf16x8*)(lds + PG8_SA(b, h) + aoff + m * 2048 + k * 1024); } while (0)
#define PG8_LDB(dst, b, h) do { _Pragma("unroll") for (int n = 0; n < 2; ++n) _Pragma("unroll") for (int k = 0; k < 2; ++k) dst[n][k] = *(const PG8_LAS bf16x8*)(lds + PG8_SB(b, h) + boff + n * 2048 + k * 1024); } while (0)
#define PG8_MMA(ai, bj, At, Bt) do { __builtin_amdgcn_s_setprio(1); _Pragma("unroll") for (int m = 0; m < 4; ++m) _Pragma("unroll") for (int n = 0; n < 2; ++n) _Pragma("unroll") for (int k = 0; k < 2; ++k) \
        acc[ai][bj][m][n] = __builtin_amdgcn_mfma_f32_16x16x32_bf16(Bt[n][k], At[m][k], acc[ai][bj][m][n], 0, 0, 0); __builtin_amdgcn_s_setprio(0); } while (0)
#define PG8_WAIT_V(n) asm volatile("s_waitcnt vmcnt(" #n ")" ::: "memory")
#define PG8_WAIT_L(n) asm volatile("s_waitcnt lgkmcnt(" #n ")" ::: "memory")
#define PG8_BAR __builtin_amdgcn_s_barrier()
#define PG8_SCHED __builtin_amdgcn_sched_barrier(0)
    Unit cur, nxt; int ui = 0;
    if (!S.next(0, cur)) return;
    f32x4 acc[2][2][4][2];
#pragma unroll
    for (int a = 0; a < 2; ++a)
#pragma unroll
        for (int b = 0; b < 2; ++b)
#pragma unroll
            for (int m = 0; m < 4; ++m)
#pragma unroll
                for (int n = 0; n < 2; ++n) acc[a][b][m][n] = (f32x4){0.f, 0.f, 0.f, 0.f};
    bf16x8 At[4][2], B0[2][2], B1[2][2];
    const char* cA = (const char*)g.A + (size_t)cur.pm * tstep; const char* cB = (const char*)g.Bt + (size_t)cur.pn * tstep;
    S.a_ready(cur);
    if constexpr (SP2) {
        PG8_STAGE(PG8_SB(0, 0), cB, voffB); PG8_STAGE(PG8_SB(0, 1), cB + hstep, voffB); PG8_STAGE(PG8_SA(0, 0), cA, voffA); PG8_STAGE(PG8_SA(0, 1), cA + hstep, voffA);
        if (wr == 1) PG8_BAR;
        PG8_WAIT_V(2); PG8_BAR;
        PG8_STAGE(PG8_SB(1, 0), cB + kstep, voffB); PG8_STAGE(PG8_SA(1, 0), cA + kstep, voffA); PG8_STAGE(PG8_SB(1, 1), cB + hstep + kstep, voffB);
        PG8_WAIT_V(6); PG8_BAR;
    } else {
        PG8_STAGE(PG8_SB(0, 0), cB, voffB); PG8_STAGE(PG8_SA(0, 0), cA, voffA); PG8_STAGE(PG8_SB(0, 1), cB + hstep, voffB); PG8_STAGE(PG8_SA(0, 1), cA + hstep, voffA);
        if (wr == 1) PG8_BAR;
        PG8_WAIT_V(4); PG8_BAR;
        PG8_STAGE(PG8_SB(1, 0), cB + kstep, voffB); PG8_STAGE(PG8_SA(1, 0), cA + kstep, voffA); PG8_STAGE(PG8_SB(1, 1), cB + hstep + kstep, voffB);
        PG8_WAIT_V(6); PG8_BAR;
    }
    for (;;) {
        const bool has_next = S.next(ui + 1, nxt);
        const char* nA = has_next ? (const char*)g.A + (size_t)nxt.pm * tstep : cA; const char* nB = has_next ? (const char*)g.Bt + (size_t)nxt.pn * tstep : cB;
        for (int t = 0; t < nt; t += 2) {
            const bool last = (t == nt - 2);
            const char* a1 = cA + (size_t)(t + 1) * kstep;
            const char* a2 = last ? nA : cA + (size_t)(t + 2) * kstep; const char* b2 = last ? nB : cB + (size_t)(t + 2) * kstep;
            const char* a3 = a2 + kstep; const char* b3 = b2 + kstep;
            if (last && has_next) S.a_ready(nxt);
            if constexpr (SP2) {
            PG8_LDB(B0, 0, 0); PG8_LDB(B1, 0, 1); PG8_SCHED; PG8_LDA(At, 0, 0); PG8_STAGE(PG8_SA(1, 1), a1 + hstep, voffA);
            PG8_WAIT_V(8); PG8_WAIT_L(0); PG8_BAR; PG8_MMA(0, 0, At, B0); PG8_MMA(0, 1, At, B1); PG8_BAR; PG8_SCHED;
            PG8_LDA(At, 0, 1); PG8_STAGE(PG8_SB(0, 0), b2, voffB); PG8_STAGE(PG8_SB(0, 1), b2 + hstep, voffB); PG8_STAGE(PG8_SA(0, 0), a2, voffA);
            PG8_WAIT_V(8); PG8_WAIT_L(0); PG8_BAR; PG8_MMA(1, 0, At, B0); PG8_MMA(1, 1, At, B1); PG8_BAR; PG8_SCHED;
            PG8_LDB(B0, 1, 0); PG8_LDB(B1, 1, 1); PG8_SCHED; PG8_LDA(At, 1, 0); PG8_STAGE(PG8_SA(0, 1), a2 + hstep, voffA);
            PG8_WAIT_V(8); PG8_WAIT_L(0); PG8_BAR; PG8_MMA(0, 0, At, B0); PG8_MMA(0, 1, At, B1); PG8_BAR; PG8_SCHED;
            PG8_LDA(At, 1, 1); PG8_STAGE(PG8_SB(1, 0), b3, voffB); PG8_STAGE(PG8_SB(1, 1), b3 + hstep, voffB); PG8_STAGE(PG8_SA(1, 0), a3, voffA);
            PG8_WAIT_V(8); PG8_WAIT_L(0); PG8_BAR; PG8_MMA(1, 0, At, B0); PG8_MMA(1, 1, At, B1); PG8_BAR; PG8_SCHED;
            } else {
            PG8_LDB(B0, 0, 0); PG8_SCHED; PG8_LDA(At, 0, 0); PG8_STAGE(PG8_SA(1, 1), a1 + hstep, voffA);
            PG8_WAIT_L(8); PG8_BAR; PG8_WAIT_L(0); PG8_MMA(0, 0, At, B0); PG8_BAR; PG8_SCHED;
            PG8_LDB(B1, 0, 1); PG8_STAGE(PG8_SB(0, 0), b2, voffB);
            PG8_BAR; PG8_WAIT_L(0); PG8_MMA(0, 1, At, B1); PG8_BAR;
            PG8_LDA(At, 0, 1); PG8_STAGE(PG8_SA(0, 0), a2, voffA);
            PG8_BAR; PG8_WAIT_L(0); PG8_MMA(1, 0, At, B0); PG8_BAR; PG8_SCHED;
            PG8_STAGE(PG8_SB(0, 1), b2 + hstep, voffB);
            PG8_WAIT_V(6); PG8_BAR; PG8_MMA(1, 1, At, B1); PG8_BAR;
            PG8_LDB(B0, 1, 0); PG8_SCHED; PG8_LDA(At, 1, 0); PG8_STAGE(PG8_SA(0, 1), a2 + hstep, voffA);
            PG8_WAIT_L(8); PG8_BAR; PG8_WAIT_L(0); PG8_MMA(0, 0, At, B0); PG8_BAR; PG8_SCHED;
            PG8_LDB(B1, 1, 1); PG8_STAGE(PG8_SB(1, 0), b3, voffB);
            PG8_BAR; PG8_WAIT_L(0); PG8_MMA(0, 1, At, B1); PG8_BAR;
            PG8_LDA(At, 1, 1); PG8_STAGE(PG8_SA(1, 0), a3, voffA);
            PG8_BAR; PG8_WAIT_L(0); PG8_MMA(1, 0, At, B0); PG8_BAR; PG8_SCHED;
            PG8_STAGE(PG8_SB(1, 1), b3 + hstep, voffB);
            PG8_WAIT_V(6); PG8_BAR; PG8_MMA(1, 1, At, B1); PG8_BAR;
            }
        }
        if constexpr (ALIGN_EPI) { if (wr == 0) PG8_BAR; }
        if constexpr (!Epi::AFTER_DRAIN) { E(acc, cur, wr, wc, fr, fq); S.done(cur); }
        if (!has_next) break;
#pragma unroll
        for (int a = 0; a < 2; ++a)
#pragma unroll
            for (int b = 0; b < 2; ++b)
#pragma unroll
                for (int m = 0; m < 4; ++m)
#pragma unroll
                    for (int n = 0; n < 2; ++n) acc[a][b][m][n] = (f32x4){0.f, 0.f, 0.f, 0.f};
        cur = nxt; cA = nA; cB = nB; ++ui;
        if constexpr (ALIGN_EPI) { if (wr == 1) PG8_BAR; }
    }
    PG8_WAIT_V(0);
    if constexpr (!ALIGN_EPI) { if (wr == 0) PG8_BAR; }
    PG8_BAR;
    if constexpr (Epi::AFTER_DRAIN) { E.fused(acc, cur, wr, wc, fr, fq, lds, wid, lane); S.done(cur); }
#undef PG8_SA
#undef PG8_SB
#undef PG8_STAGE
#undef PG8_LDA
#undef PG8_LDB
#undef PG8_MMA
#undef PG8_WAIT_V
#undef PG8_WAIT_L
#undef PG8_BAR
#undef PG8_SCHED
}
}
namespace att {
using bf16 = __hip_bfloat16;
typedef short bf16x8 __attribute__((ext_vector_type(8)));
typedef short s16x4 __attribute__((ext_vector_type(4)));
typedef float f32x16 __attribute__((ext_vector_type(16)));
typedef float f32x4 __attribute__((ext_vector_type(4)));
typedef unsigned u32x4 __attribute__((ext_vector_type(4)));
template <class A, class Bt> struct same_t { static constexpr bool v = false; };
template <class A> struct same_t<A, A> { static constexpr bool v = true; };
constexpr int D = 128, PIN = 6144, POUT = 2048;
constexpr float THR = 8.f;
constexpr bool WSKIP = false;
constexpr float SCALE = 0.08838834764831845f;
constexpr int NW = 8, QBLK = 32, KVBLK = 64, QB = NW * QBLK;
constexpr int SHM_V = KVBLK * D * 2, SHM_K = KVBLK * D * 2;
constexpr int LDS_BYTES = 2 * SHM_V + 2 * SHM_K + NW * 64 * 4;
#define KSWZ(row, colB) ((row) * 256 + ((colB) ^ (((row) & 7) << 4)))
#define SBAR() __builtin_amdgcn_sched_barrier(0)
__device__ __forceinline__ int v_st(int k, int c) { const int kk = (k & ~0xC) | ((k & 4) << 1) | ((k & 8) >> 1); return ((kk >> 3) * 4 + (c >> 5)) * 512 + ((kk & 7) * 32 + (c & 31)) * 2; }
__device__ __forceinline__ int v_rd_base(int lane) { return ((lane & 3) << 3) | (((lane >> 2) & 3) << 6) | (((lane >> 4) & 1) << 5) | (((lane >> 5) & 1) << 8); }
constexpr int v_rd_off(int d0, int ks, int half) { return d0 * 512 + ks * 4096 + half * 2048; }
__device__ __forceinline__ int crow(int r, int hi) { return (r & 3) + 8 * (r >> 2) + 4 * hi; }
__device__ __forceinline__ unsigned cvtpk(float lo, float hi) {
    unsigned r; asm volatile("v_cvt_pk_bf16_f32 %0, %1, %2" : "=v"(r) : "v"(lo), "v"(hi)); return r;
}
__device__ __forceinline__ bf16x8 pack8(f32x4 a, f32x4 b) {
    u32x4 w = {cvtpk(a[0], a[1]), cvtpk(a[2], a[3]), cvtpk(b[0], b[1]), cvtpk(b[2], b[3])};
    return *reinterpret_cast<bf16x8*>(&w);
}
template <class T> __device__ __forceinline__ bf16x8 load8(const T* p) {
    if constexpr (same_t<T, float>::v) { return pack8(*(const f32x4*)p, *(const f32x4*)(p + 4)); }
    else { return *reinterpret_cast<const bf16x8*>(p); }
}
__device__ __forceinline__ void mask_tile(f32x16& p0, f32x16& p1, int dq, unsigned W) {
    const float NEG = -__builtin_inff();
#pragma unroll
    for (int r = 0; r < 16; ++r) {
        const int c = (r & 3) + 8 * (r >> 2);
        if ((unsigned)(dq - c) >= W) p0[r] = NEG;
        if ((unsigned)(dq - c - 32) >= W) p1[r] = NEG;
    }
}
__device__ __forceinline__ void bitmask_tile(f32x16& p0, f32x16& p1, unsigned mw) {
    const float NEG = -__builtin_inff();
#pragma unroll
    for (int r = 0; r < 16; ++r) {
        if (!((mw >> r) & 1u)) p0[r] = NEG;
        if (!((mw >> (16 + r)) & 1u)) p1[r] = NEG;
    }
}
__device__ __forceinline__ void partialSM(f32x16& p0, f32x16& p1, float& m_reg, float& mn, float& alpha) {
    float pmax = p0[0]; for (int r = 1; r < 16; ++r) pmax = fmaxf(pmax, p0[r]); for (int r = 0; r < 16; ++r) pmax = fmaxf(pmax, p1[r]);
    { auto rr = __builtin_amdgcn_permlane32_swap(__float_as_uint(pmax), __float_as_uint(pmax), false, false);
      pmax = fmaxf(__uint_as_float(rr[0]), __uint_as_float(rr[1])); }
    constexpr float C2 = 1.4426950408889634f * SCALE;
    if (__builtin_expect(__all((pmax - m_reg) * SCALE <= THR), 1)) { mn = m_reg; alpha = 1.f; }
    else { mn = fmaxf(m_reg, pmax); alpha = __builtin_amdgcn_exp2f((m_reg - mn) * C2); m_reg = mn; }
    const float mnL = -mn * C2;
    for (int r = 0; r < 16; ++r) p0[r] = fmaf(p0[r], C2, mnL); for (int r = 0; r < 16; ++r) p1[r] = fmaf(p1[r], C2, mnL);
    for (int r = 0; r < 16; ++r) p0[r] = __builtin_amdgcn_exp2f(p0[r]);
}
__device__ __forceinline__ void finishSM(f32x16& p0, f32x16& p1, float alpha, float& l_reg, bf16x8& pa0, bf16x8& pa1, bf16x8& pa2, bf16x8& pa3) {
    for (int r = 0; r < 16; ++r) p1[r] = __builtin_amdgcn_exp2f(p1[r]);
    float ps = 0; for (int r = 0; r < 16; ++r) ps += p0[r]; for (int r = 0; r < 16; ++r) ps += p1[r];
    { auto rr = __builtin_amdgcn_permlane32_swap(__float_as_uint(ps), __float_as_uint(ps), false, false);
      ps = __uint_as_float(rr[0]) + __uint_as_float(rr[1]); }
    l_reg = l_reg * alpha + ps;
#define PK4(P, B_, OUT) do { unsigned a0 = cvtpk(P[B_+0], P[B_+1]), a1 = cvtpk(P[B_+2], P[B_+3]);                          \
        unsigned b0 = cvtpk(P[B_+4], P[B_+5]), b1 = cvtpk(P[B_+6], P[B_+7]);                                             \
        auto r0 = __builtin_amdgcn_permlane32_swap(a0, b0, false, false); auto r1 = __builtin_amdgcn_permlane32_swap(a1, b1, false, false); \
        u32x4 w = {r0[0], r1[0], r0[1], r1[1]}; OUT = *reinterpret_cast<bf16x8*>(&w); } while (0)
    PK4(p0, 0, pa0); PK4(p0, 8, pa1); PK4(p1, 0, pa2); PK4(p1, 8, pa3);
#undef PK4
}
template <int KB, bool SK>
__device__ __forceinline__ void qkt(f32x16& p0, f32x16& p1, const char* K_lds, int r32, int hi, const bf16x8* qr, bool act) {
    if (SK && !act) { const float NEG = -__builtin_inff();
#pragma unroll
        for (int r = 0; r < 16; ++r) { p0[r] = NEG; p1[r] = NEG; } return; }
    p0 = f32x16{}; p1 = f32x16{};
    const char* kb[4];
#pragma unroll
    for (int dd = 0; dd < 4; ++dd) kb[dd] = K_lds + KB * SHM_K + KSWZ(r32, (dd * 16 + hi * 8) * 2);
#pragma unroll
    for (int d0 = 0; d0 < 8; ++d0) { const char* a = kb[d0 & 3] + (d0 >> 2) * 128;
        bf16x8 b0 = *reinterpret_cast<const bf16x8*>(a);
        bf16x8 b1 = *reinterpret_cast<const bf16x8*>(a + 32 * 256);
        p0 = __builtin_amdgcn_mfma_f32_32x32x16_bf16(b0, qr[d0], p0, 0, 0, 0);
        p1 = __builtin_amdgcn_mfma_f32_32x32x16_bf16(b1, qr[d0], p1, 0, 0, 0); }
}
template <int VB, bool SK>
__device__ __forceinline__ void pv_tile(f32x16* o, int vb0, bf16x8 pa0, bf16x8 pa1, bf16x8 pa2, bf16x8 pa3, bool act) {
    if (SK && !act) return;
#define TRRD(dst, off) asm volatile("ds_read_b64_tr_b16 %0, %1 offset:%2" : "=&v"(dst) : "v"(vb0), "i"(off) : "memory")
#define PV_D0(d0) do { s16x4 l0, l1, l2, l3, h0, h1, h2, h3; constexpr int b_ = VB * SHM_V + v_rd_off(d0, 0, 0);     \
        TRRD(l0, b_); TRRD(h0, b_ + 2048); TRRD(l1, b_ + 4096); TRRD(h1, b_ + 6144); TRRD(l2, b_ + 8192); TRRD(h2, b_ + 10240); TRRD(l3, b_ + 12288); TRRD(h3, b_ + 14336); \
        asm volatile("s_waitcnt lgkmcnt(0)" ::: "memory"); SBAR();                 \
        o[d0] = __builtin_amdgcn_mfma_f32_32x32x16_bf16(pa0, (bf16x8){l0[0], l0[1], l0[2], l0[3], h0[0], h0[1], h0[2], h0[3]}, o[d0], 0, 0, 0);   \
        o[d0] = __builtin_amdgcn_mfma_f32_32x32x16_bf16(pa1, (bf16x8){l1[0], l1[1], l1[2], l1[3], h1[0], h1[1], h1[2], h1[3]}, o[d0], 0, 0, 0);   \
        o[d0] = __builtin_amdgcn_mfma_f32_32x32x16_bf16(pa2, (bf16x8){l2[0], l2[1], l2[2], l2[3], h2[0], h2[1], h2[2], h2[3]}, o[d0], 0, 0, 0);   \
        o[d0] = __builtin_amdgcn_mfma_f32_32x32x16_bf16(pa3, (bf16x8){l3[0], l3[1], l3[2], l3[3], h3[0], h3[1], h3[2], h3[3]}, o[d0], 0, 0, 0); } while (0)
    PV_D0(0); PV_D0(1); PV_D0(2); PV_D0(3);
#undef PV_D0
#undef TRRD
}

template <class TIn, class TOut> struct BlockRef { const TIn* Q; const TIn* K; const TIn* V; TOut* O; const unsigned long long* M; int P0; };
template <class TIn> struct Seam {
    bf16x8 qr[8];
    bf16x8 st_v0, st_v1, st_k0, st_k1; f32x4 sf0, sf1, sf2, sf3;
    f32x4 tq[16];
};
__device__ __forceinline__ int swa_jlo(int P0, int W) { const int lowk = P0 - W + 1; return lowk > 0 ? lowk / KVBLK : 0; }
#define ROW(p, k0, rr) ((p) + (size_t)((k0) + (rr)) * PIN + sc)
#define VMW() asm volatile("s_waitcnt vmcnt(0)" ::: "memory")
#define VMWN(n) asm volatile("s_waitcnt vmcnt(%0)" :: "i"(n) : "memory")
#define SLOAD_H(Kp, Vp, k0) do { S.st_v0 = load8<TIn>(ROW(Vp, k0, sr)); S.st_v1 = load8<TIn>(ROW(Vp, k0, 32 + sr));              \
                         S.st_k0 = load8<TIn>(ROW(Kp, k0, sr)); S.st_k1 = load8<TIn>(ROW(Kp, k0, 32 + sr)); } while (0)
#define SWRITE_HK(bf) do { *(bf16x8*)(K_lds + (bf) * SHM_K + kws) = S.st_k0; *(bf16x8*)(K_lds + (bf) * SHM_K + kws + 32 * 256) = S.st_k1; } while (0)
#define SWRITE_HV(bf) do { *(bf16x8*)(V_lds + (bf) * SHM_V + vst0) = S.st_v0; *(bf16x8*)(V_lds + (bf) * SHM_V + vst1) = S.st_v1; } while (0)
#define SWRITE_H(bf) do { SWRITE_HV(bf); SWRITE_HK(bf); } while (0)
#define SLOAD_F(p, k0) do { S.sf0 = *(const f32x4*)ROW(p, k0, sr); S.sf1 = *(const f32x4*)(ROW(p, k0, sr) + 4);                \
                            S.sf2 = *(const f32x4*)ROW(p, k0, 32 + sr); S.sf3 = *(const f32x4*)(ROW(p, k0, 32 + sr) + 4); } while (0)
#define SWRITE_KF(bf) do { *(bf16x8*)(K_lds + (bf) * SHM_K + kws) = pack8(S.sf0, S.sf1); *(bf16x8*)(K_lds + (bf) * SHM_K + kws + 32 * 256) = pack8(S.sf2, S.sf3); } while (0)
#define SWRITE_VF(bf) do { *(bf16x8*)(V_lds + (bf) * SHM_V + vst0) = pack8(S.sf0, S.sf1); *(bf16x8*)(V_lds + (bf) * SHM_V + vst1) = pack8(S.sf2, S.sf3); } while (0)
template <class TIn, class TOut>
__device__ __forceinline__ void causal_swa_prime(const BlockRef<TIn, TOut>& cur, int W, char* lds, Seam<TIn>& S) {
    constexpr bool F32 = same_t<TIn, float>::v;
    const int tid = threadIdx.x, wid = __builtin_amdgcn_readfirstlane(tid >> 6), lane = tid & 63, r32 = lane & 31, hi = lane >> 5;
    const int sr = tid >> 4, sc = (tid & 15) * 8, kws = KSWZ(sr, sc * 2); char* K_lds = lds + 2 * SHM_V;
    const int kb0 = swa_jlo(cur.P0, W) * KVBLK;
    for (int d0 = 0; d0 < 8; ++d0) S.qr[d0] = load8<TIn>(cur.Q + (size_t)(wid * QBLK + r32) * PIN + d0 * 16 + hi * 8);
    if constexpr (F32) { SLOAD_F((const float*)cur.K, kb0); VMW(); SWRITE_KF(0); SBAR(); SLOAD_F((const float*)cur.V, kb0); }
    else { SLOAD_H(cur.K, cur.V, kb0); VMW(); SWRITE_HK(0); }
    __syncthreads();
}
template <class TIn, class TOut>
__device__ __forceinline__ void causal_swa_block(const BlockRef<TIn, TOut>& cur, const BlockRef<TIn, TOut>& nxt, int skv, int W, char* lds, Seam<TIn>& S) {
    constexpr bool F32 = same_t<TIn, float>::v;
    const int tid = threadIdx.x, wid = __builtin_amdgcn_readfirstlane(tid >> 6), lane = tid & 63, r32 = lane & 31, hi = lane >> 5;
    const int j_lo = swa_jlo(cur.P0, W);
    int j_hi = (cur.P0 + QB - 1) / KVBLK + 1; if (j_hi > skv / KVBLK) j_hi = skv / KVBLK;
    const int NT = j_hi - j_lo;
    const int kbn = swa_jlo(nxt.P0, W) * KVBLK;
    const unsigned* M32 = (const unsigned*)cur.M; const unsigned moff = (unsigned)((wid * QBLK + r32) * 128 + hi);
    const int qlo = cur.P0 + wid * QBLK;
    char* V_lds = lds; char* K_lds = lds + 2 * SHM_V;
    float* ws = (float*)(lds + 2 * SHM_V + 2 * SHM_K) + wid * 64; float* li_l = ws, * al_l = ws + 32;
    float m_reg = -1e30f, l_reg = 0; f32x16 o[4] = {};
    const int sr = tid >> 4, sc = (tid & 15) * 8, vst0 = v_st(sr, sc), vst1 = v_st(32 + sr, sc), kws = KSWZ(sr, sc * 2);
    const int vb0 = (int)(uintptr_t)V_lds + v_rd_base(lane);
    const TIn* Kh = cur.K; const TIn* Vh = cur.V;
#define RESC(a) do { if (__any((a) < 1.f)) { if (hi == 0) al_l[r32] = (a); asm volatile("s_waitcnt lgkmcnt(0)" ::: "memory");              \
                     for (int d_ = 0; d_ < 4; ++d_) for (int r = 0; r < 16; ++r) o[d_][r] *= al_l[crow(r, hi)]; } } while (0)
#define KBASE(t) ((j_lo + (t)) * KVBLK)
#define ACT(t) (KBASE(t) <= qlo + QBLK - 1 && KBASE(t) + KVBLK - 1 >= qlo - W + 1)
#define MASKT(P0_, P1_, t) do { bitmask_tile(P0_, P1_, mwn); } while (0)
    constexpr int NQL = F32 ? 16 : 8;
    constexpr bool SK = WSKIP && !F32;
#define SEAM_K0() do { VMWN(NQL); if constexpr (F32) { SWRITE_KF(0); SBAR(); SLOAD_F((const float*)nxt.V, kbn); } else { SWRITE_HK(0); } SBAR(); } while (0)
    f32x16 pA0, pA1, pB0, pB1; float mnA, mnB, alA, alB; bf16x8 pa0, pa1, pa2, pa3;
    if constexpr (F32) { VMW(); SWRITE_VF(0); SBAR(); } else { SWRITE_HV(0); SBAR(); }
    if (NT > 1) { if constexpr (F32) SLOAD_F((const float*)Kh, KBASE(1)); else SLOAD_H(Kh, Vh, KBASE(1)); }
    unsigned mwn = M32[moff + 2 * j_lo]; SBAR(); qkt<0, SK>(pA0, pA1, K_lds, r32, hi, S.qr, ACT(0));
    if constexpr (F32) { if (NT > 1) { VMW(); SWRITE_KF(1); SBAR(); SLOAD_F((const float*)Vh, KBASE(1)); } }
    MASKT(pA0, pA1, 0); partialSM(pA0, pA1, m_reg, mnA, alA);
    if (NT > 1) { VMW(); if constexpr (F32) { SWRITE_VF(1); SBAR(); if (NT > 2) SLOAD_F((const float*)Kh, KBASE(2)); } else SWRITE_H(1); }
    __syncthreads();
#define HALF_STEP(PX0, PX1, mnX, alX, PY0, PY1, alY, t, KB, VB, SB) do {                                                      \
        mwn = M32[moff + 2 * (j_lo + (t))]; SBAR(); qkt<KB, SK>(PX0, PX1, K_lds, r32, hi, S.qr, ACT(t));             \
        finishSM(PY0, PY1, alY, l_reg, pa0, pa1, pa2, pa3); SBAR();                                                           \
        if ((t) + 1 < NT) { if constexpr (F32) { VMW(); SWRITE_KF(SB); SBAR(); SLOAD_F((const float*)Vh, KBASE((t) + 1)); }  \
                            else { SLOAD_H(Kh, Vh, KBASE((t) + 1)); } SBAR(); }                                               \
        pv_tile<VB, SK>(o, vb0, pa0, pa1, pa2, pa3, ACT((t) - 1)); MASKT(PX0, PX1, (t)); partialSM(PX0, PX1, m_reg, mnX, alX);                                        \
        __syncthreads();                                                                                                      \
        if ((t) + 1 < NT) { VMW(); if constexpr (F32) { SWRITE_VF(SB); SBAR(); if ((t) + 2 < NT) SLOAD_F((const float*)Kh, KBASE((t) + 2)); } \
                            else { SWRITE_H(SB); } }                                                                          \
        RESC(alX); __syncthreads(); } while (0)
    for (int t = 1; t + 1 < NT; t += 2) {
        HALF_STEP(pB0, pB1, mnB, alB, pA0, pA1, alA, t, 1, 0, 0);
        HALF_STEP(pA0, pA1, mnA, alA, pB0, pB1, alB, t + 1, 0, 1, 1);
    }
    const bool even = (NT & 1) == 0;
    if (even) { mwn = M32[moff + 2 * (j_lo + NT - 1)]; SBAR(); qkt<1, SK>(pB0, pB1, K_lds, r32, hi, S.qr, ACT(NT - 1)); SBAR(); }
#define QROW(e) (nxt.Q + (size_t)(wid * QBLK + r32) * PIN + ((e) >> 1) * 16 + hi * 8 + ((e) & 1) * 4)
    if constexpr (F32) { SLOAD_F((const float*)nxt.K, kbn); SBAR();
#pragma unroll
        for (int e = 0; e < 8; ++e) S.tq[e] = *(const f32x4*)QROW(e); }
    else { SLOAD_H(nxt.K, nxt.V, kbn); SBAR();
#pragma unroll
        for (int d0 = 0; d0 < 8; ++d0) S.qr[d0] = load8<TIn>(nxt.Q + (size_t)(wid * QBLK + r32) * PIN + d0 * 16 + hi * 8); }
    SBAR();
    finishSM(pA0, pA1, alA, l_reg, pa0, pa1, pa2, pa3); SBAR();
    if constexpr (F32) {
#pragma unroll
        for (int e = 8; e < 16; ++e) S.tq[e] = *(const f32x4*)QROW(e); SBAR(); }
#undef QROW
    pv_tile<0, SK>(o, vb0, pa0, pa1, pa2, pa3, ACT(even ? NT - 2 : NT - 1));
    if (even) { MASKT(pB0, pB1, NT - 1); partialSM(pB0, pB1, m_reg, mnB, alB); __syncthreads(); RESC(alB);
        finishSM(pB0, pB1, alB, l_reg, pa0, pa1, pa2, pa3); SBAR(); pv_tile<1, SK>(o, vb0, pa0, pa1, pa2, pa3, ACT(NT - 1)); }
    SBAR(); SEAM_K0();
    if (hi == 0) li_l[r32] = l_reg; asm volatile("s_waitcnt lgkmcnt(0)" ::: "memory");
    float rli[16];
#pragma unroll
    for (int r = 0; r < 16; ++r) rli[r] = __builtin_amdgcn_rcpf(li_l[crow(r, hi)]);
    TOut* Ow = cur.O + (size_t)(wid * QBLK) * POUT;
#pragma unroll
    for (int r = 0; r < 16; ++r) { const int orow = crow(r, hi);
#pragma unroll
        for (int d0 = 0; d0 < 4; ++d0) { const float v = o[d0][r] * rli[r];
            if constexpr (same_t<TOut, float>::v) { Ow[(size_t)orow * POUT + d0 * 32 + r32] = v; }
            else { const float vn = __shfl_xor(v, 1);
                   if ((r32 & 1) == 0) *(unsigned*)(Ow + (size_t)orow * POUT + d0 * 32 + r32) = cvtpk(v, vn); } } }
    if constexpr (F32) {
#pragma unroll
        for (int d0 = 0; d0 < 8; ++d0) S.qr[d0] = pack8(S.tq[2 * d0], S.tq[2 * d0 + 1]); }
    __syncthreads();
#undef RESC
#undef KBASE
#undef ACT
#undef MASKT
#undef SEAM_K0
#undef HALF_STEP
}
#undef ROW
#undef VMW
#undef VMWN
#undef SLOAD_H
#undef SWRITE_HK
#undef SWRITE_HV
#undef SWRITE_H
#undef SLOAD_F
#undef SWRITE_KF
#undef SWRITE_VF

}
typedef GAS unsigned gu32;
#define XB_TMO      128
#define XB_XCNT(j)  (256  + 64 * (j))
#define XB_XSUB(j)  (1280 + 64 * (j))
#define XB_XGEN(j)  (2304 + 64 * (j))
#define XB_TOP      3328
#define XB_TOPGEN   3392
#define XCD_BAR_WORDS 3456
#define XB_SPIN_CAP (1u << 18)

__device__ __forceinline__ unsigned xb_ld(unsigned* p)              { return __hip_atomic_load(p, __ATOMIC_RELAXED, __HIP_MEMORY_SCOPE_AGENT); }
__device__ __forceinline__ unsigned xb_add(unsigned* p, unsigned v) { return __hip_atomic_fetch_add(p, v, __ATOMIC_RELAXED, __HIP_MEMORY_SCOPE_AGENT); }
__device__ __forceinline__ unsigned xb_xcc_id() { return (unsigned)__builtin_amdgcn_s_getreg((3 << 11) | 20) & 0xFu; }
#define XB_SPIN(cond, bar) do { unsigned _sp = 0; while (cond) { __builtin_amdgcn_s_sleep(1); \
    if ((++_sp & 255u) == 0u) { if (xb_ld(&(bar)[XB_TMO])) break; if (_sp > XB_SPIN_CAP) { atomicAdd(&(bar)[XB_TMO], 1u); break; } } } } while (0)

struct XcdBarrier {
    unsigned* bar; unsigned x;
    volatile LAS unsigned* st;
};

__device__ __forceinline__ XcdBarrier xcd_barrier_post(unsigned* bar, volatile LAS unsigned* st) {
    XcdBarrier b; b.bar = bar; b.x = xb_xcc_id(); b.st = st;
    if (threadIdx.x == 0) (void)xb_add(&bar[XB_XCNT(b.x)], 1u);
    return b;
}
__device__ __forceinline__ void xcd_barrier_complete(unsigned* bar, unsigned x, unsigned& nloc, unsigned& nx) {
    const unsigned G = gridDim.x * gridDim.y * gridDim.z;
    unsigned sum, cnt, mine, sp = 0u;
    for (;;) {
        sum = 0u; cnt = 0u; mine = 0u;
#pragma unroll
        for (unsigned j = 0; j < 16; ++j) { const unsigned c = xb_ld(&bar[XB_XCNT(j)]); sum += c; cnt += (c > 0u) ? 1u : 0u; mine = (j == x) ? c : mine; }
        if (sum == G) break;
        __builtin_amdgcn_s_sleep(1);
        if ((++sp & 255u) == 0u) { if (xb_ld(&bar[XB_TMO])) break; if (sp > XB_SPIN_CAP) { atomicAdd(&bar[XB_TMO], 1u); break; } }
    }
    nloc = mine > 0u ? mine : 1u; nx = cnt > 0u ? cnt : 1u;
}

__device__ __forceinline__ void xcd_barrier(const XcdBarrier& b) {
    asm volatile("s_waitcnt vmcnt(0)" ::: "memory");
    __syncthreads();
    if (threadIdx.x == 0) {
        unsigned* bar = b.bar;
        __builtin_amdgcn_s_waitcnt(0);
        unsigned nloc = b.st[0], nx = b.st[1];
        if (nloc == 0u) { xcd_barrier_complete(bar, b.x, nloc, nx); b.st[0] = nloc; b.st[1] = nx; }
        const unsigned old = xb_add(&bar[XB_XSUB(b.x)], 1u);
        const unsigned gen = old / nloc;
        if (old + 1u == (gen + 1u) * nloc) {
            __builtin_amdgcn_fence(__ATOMIC_RELEASE, "agent");
            asm volatile("s_waitcnt vmcnt(0)" ::: "memory");
            const unsigned og = xb_add(&bar[XB_TOP], 1u);
            const unsigned tg = og / nx;
            if (og + 1u == (tg + 1u) * nx) xb_add(&bar[XB_TOPGEN], 1u);
            else XB_SPIN(xb_ld(&bar[XB_TOPGEN]) == tg, bar);
            __builtin_amdgcn_fence(__ATOMIC_ACQUIRE, "agent");
            xb_add(&bar[XB_XGEN(b.x)], 1u);
            asm volatile("s_waitcnt vmcnt(0)" ::: "memory");
        } else {
            XB_SPIN(xb_ld(&bar[XB_XGEN(b.x)]) == gen, bar);
            __builtin_amdgcn_fence(__ATOMIC_ACQUIRE, "agent");
            asm volatile("s_waitcnt vmcnt(0)" ::: "memory");
        }
    }
    __syncthreads();
}

constexpr int LDS_BYTES = 147456;
constexpr int MISC_OFF = LDS_BYTES - 256;
constexpr int NWAVES = 8;

struct Args { const void* in[23]; float* out; unsigned char* ws; int ph_lo, ph_hi; };
enum { I_X = 0, I_C, I_POS, I_WADA, I_BADA, I_WIN, I_CONVW, I_CONVB, I_WRGA, I_BRGA, I_WRGX, I_BRGX, I_LAM, I_KIDXG, I_WOUT, I_LN1G, I_LN1B, I_WPQ, I_SUBK, I_PU, I_PV, I_LN2G, I_LN2B };

struct Ctx { LAS unsigned char* lds; unsigned char* ws; int tid, lane, wave, bid, G, gw, ngw; };

__device__ __forceinline__ f32x4 mfma16(bf16x8 a, bf16x8 b, f32x4 c) { return __builtin_amdgcn_mfma_f32_16x16x32_bf16(a, b, c, 0, 0, 0); }
__device__ __forceinline__ f32x16 mfma32(bf16x8 a, bf16x8 b, f32x16 c) { return __builtin_amdgcn_mfma_f32_32x32x16_bf16(a, b, c, 0, 0, 0); }

__device__ __forceinline__ void transpose_item(const float* W, int K, int N, bf16* WT, LAS float* scr, int item, int lane) {
    const int nblk = (N + 31) / 32, kb = item / nblk, nb = item % nblk, k0 = 64 * kb, n0 = 32 * nb;
    const int nc = n0 + (lane & 31); const bool okc = nc < N;
#pragma unroll 8
    for (int i = 0; i < 32; ++i) { const int kk = 2 * i + (lane >> 5); scr[kk * 33 + (lane & 31)] = okc ? W[(size_t)(k0 + kk) * N + nc] : 0.f; }
    LDS_WAIT(); asm volatile("" ::: "memory");
    const int c = lane & 7;
#pragma unroll
    for (int j = 0; j < 4; ++j) { const int n = (lane >> 3) + 8 * j; const LAS float* s = scr + (8 * c) * 33 + n;
        v4u o; o.x = pk2(s[0 * 33], s[1 * 33]); o.y = pk2(s[2 * 33], s[3 * 33]); o.z = pk2(s[4 * 33], s[5 * 33]); o.w = pk2(s[6 * 33], s[7 * 33]);
        if (n0 + n < N) *(v4u*)(WT + (size_t)(n0 + n) * K + k0 + 8 * c) = o; }
    LDS_WAIT(); asm volatile("" ::: "memory");
}
__device__ __forceinline__ void convert_stream(const float* src, bf16* dst, size_t n, int gw, int ngw, int lane) {
    const size_t niter = n / 512;
#pragma unroll 4
    for (size_t i = gw; i < niter; i += ngw) { const size_t e = i * 512 + (size_t)lane * 8;
        const f32x4 a = *(const f32x4*)(src + e), b = *(const f32x4*)(src + e + 4);
        v4u o; o.x = pk2(a.x, a.y); o.y = pk2(a.z, a.w); o.z = pk2(b.x, b.y); o.w = pk2(b.z, b.w);
        *(v4u*)(dst + e) = o; }
}
__device__ __forceinline__ void convert_rows_fp8(const float* src, unsigned* dst, float* inv_scale, int gw, int ngw, int lane) {
    for (int row = gw; row < NEXP; row += ngw) {
        f32x4 v[2][4]; float mx = 0.f;
#pragma unroll
        for (int cc = 0; cc < 2; ++cc)
#pragma unroll
            for (int w = 0; w < 4; ++w) { v[cc][w] = *(const f32x4*)(src + (size_t)row * DM + 1024 * cc + 16 * lane + 4 * w);
                mx = fmaxf(mx, fmaxf(fmaxf(fabsf(v[cc][w].x), fabsf(v[cc][w].y)), fmaxf(fabsf(v[cc][w].z), fabsf(v[cc][w].w)))); }
#pragma unroll
        for (int o = 1; o < 64; o <<= 1) mx = fmaxf(mx, __shfl_xor(mx, o));
        const float sc = mx > 0.f ? 256.0f / mx : 1.0f;
        if (lane == 0) inv_scale[row] = mx > 0.f ? mx * (1.0f / 256.0f) : 1.0f;
#pragma unroll
        for (int cc = 0; cc < 2; ++cc) { v4u o;
#pragma unroll
            for (int w = 0; w < 4; ++w) { int p = __builtin_amdgcn_cvt_pk_fp8_f32(v[cc][w].x * sc, v[cc][w].y * sc, 0, false); p = __builtin_amdgcn_cvt_pk_fp8_f32(v[cc][w].z * sc, v[cc][w].w * sc, p, true); o[w] = (unsigned)p; }
            *(v4u*)(dst + (size_t)row * (DM / 4) + 256 * cc + 4 * lane) = o; }
    }
}
__device__ __forceinline__ void p0_prologue(const Ctx& c, const Args& a) {
    const int tid = c.tid, lane = c.lane, gw = c.gw, ngw = c.ngw;
    LAS float* sl = (LAS float*)(c.lds + 8 * 8448);
    { const float* cc = (const float*)a.in[I_C];
      for (int i = tid; i < 2 * DM; i += 512) { const float v = cc[i]; sl[i] = v / (1.0f + __expf(-v)); } }
    __syncthreads();
    { const float* W = (const float*)a.in[I_WADA]; float* MODP = (float*)(c.ws + WS_MODP); LAS float* red = (LAS float*)(c.lds + 8 * 8448 + 16384);
      for (int it = c.bid; it < 48 * 4; it += c.G) { const int cg = it % 48, kq = it / 48, col = cg * 256 + lane * 4, k0 = kq * 512 + c.wave * 64;
          f32x4 a0 = {0.f, 0.f, 0.f, 0.f}, a1 = {0.f, 0.f, 0.f, 0.f};
#pragma unroll 16
          for (int kk = 0; kk < 64; ++kk) { const f32x4 w = *(const f32x4*)(W + (size_t)(k0 + kk) * (6 * DM) + col); const float s0 = sl[k0 + kk], s1 = sl[DM + k0 + kk]; a0 += w * s0; a1 += w * s1; }
          *(LAS f32x4*)(red + (c.wave * 2 + 0) * 256 + lane * 4) = a0; *(LAS f32x4*)(red + (c.wave * 2 + 1) * 256 + lane * 4) = a1;
          __syncthreads();
          { const int b = tid >> 8, cc = tid & 255; float s = 0.f;
#pragma unroll
            for (int w = 0; w < 8; ++w) s += red[(w * 2 + b) * 256 + cc];
            MODP[((size_t)kq * 2 + b) * (6 * DM) + cg * 256 + cc] = s; }
          __syncthreads(); } }
    LAS float* scr = (LAS float*)(c.lds + c.wave * 8448);
    { constexpr int I_IN = (DM / 64) * ((DIN + 31) / 32), I_SQ = (DM / 64) * (DM / 32), I_G = 8 * 2 * 4;
      for (int it = gw; it < I_IN + 2 * I_SQ + 2 * I_G; it += ngw) { int r = it;
          if (r < I_IN) { transpose_item((const float*)a.in[I_WIN], DM, DIN, (bf16*)(c.ws + WS_WIN), scr, r, lane); continue; } r -= I_IN;
          if (r < I_SQ) { transpose_item((const float*)a.in[I_WOUT], DM, DM, (bf16*)(c.ws + WS_WOUT), scr, r, lane); continue; } r -= I_SQ;
          if (r < I_SQ) { transpose_item((const float*)a.in[I_WPQ], DM, DM, (bf16*)(c.ws + WS_WPQ), scr, r, lane); continue; } r -= I_SQ;
          if (r < I_G) { const int n = r / 8; transpose_item((const float*)a.in[I_WRGA] + n * 16384, 128, 128, (bf16*)(c.ws + WS_WRG) + n * 16384, scr, r % 8, lane); continue; } r -= I_G;
          { const int n = r / 8; transpose_item((const float*)a.in[I_WRGX] + n * 16384, 128, 128, (bf16*)(c.ws + WS_WRG) + (8 + n) * 16384, scr, r % 8, lane); } } }
    convert_stream((const float*)a.in[I_SUBK], (bf16*)(c.ws + WS_SUBK), (size_t)8 * 2 * 128 * 128, gw, ngw, lane);
    convert_rows_fp8((const float*)a.in[I_PU], (unsigned*)(c.ws + WS_PU), (float*)(c.ws + WS_PUS), gw, ngw, lane);
    convert_rows_fp8((const float*)a.in[I_PV], (unsigned*)(c.ws + WS_PV), (float*)(c.ws + WS_PVS), gw, ngw, lane);
    __syncthreads();
}

__device__ __forceinline__ void p1_u1(const Ctx& c, const Args& a) {
    const int tid = c.tid, lane = c.lane;
    const float* MODP = (const float*)(c.ws + WS_MODP); const float* bada = (const float*)a.in[I_BADA]; float* MODF = (float*)(c.ws + WS_MODF);
    { const int g = c.bid * 512 + tid;
      for (int e = g; e < 2 * 6 * DM; e += c.G * 512) { const int b = e / (6 * DM), j = e % (6 * DM); MODF[e] = bada[j] + ((MODP[((size_t)0 * 2 + b) * (6 * DM) + j] + MODP[((size_t)1 * 2 + b) * (6 * DM) + j]) + (MODP[((size_t)2 * 2 + b) * (6 * DM) + j] + MODP[((size_t)3 * 2 + b) * (6 * DM) + j])); }
      const int* pos = (const int*)a.in[I_POS]; float* CS = (float*)(c.ws + WS_ROPE);
      for (int i = g; i < NTOK * 24; i += c.G * 512) { const int tk = i / 24, j = i % 24;
          const float ex = j < 16 ? -(float)j / 16.0f : -(float)(j - 16) / 8.0f;
          const float inv = exp2f(ex * 18.931568569324174f);
          const float ang = (float)pos[tk] * inv;
          double rev = (double)ang * 0.15915494309189535; rev -= floor(rev);
          if (rev > 0.5) rev -= 1.0;
          const float rr = (float)(rev * 6.283185307179586);
          float sn, cs; sincosf(rr, &sn, &cs);
          if (j < 16) { CS[tk * 48 + j] = cs; CS[tk * 48 + 16 + j] = sn; } else { CS[tk * 48 + 32 + (j - 16)] = cs; CS[tk * 48 + 40 + (j - 16)] = sn; } } }
    LAS float* ms = (LAS float*)c.lds;
    for (int i = tid; i < 2 * 2 * DM; i += 512) { const int b = i / (2 * DM), j = i % (2 * DM); ms[i] = bada[j] + ((MODP[((size_t)0 * 2 + b) * (6 * DM) + j] + MODP[((size_t)1 * 2 + b) * (6 * DM) + j]) + (MODP[((size_t)2 * 2 + b) * (6 * DM) + j] + MODP[((size_t)3 * 2 + b) * (6 * DM) + j])); }
    __syncthreads();
    const float* x = (const float*)a.in[I_X]; bf16* U1 = (bf16*)(c.ws + WS_U1);
    for (int row = c.gw; row < NTOK; row += c.ngw) { const int b = row / SEQ;
        const f32x4* xr = (const f32x4*)(x + (size_t)row * DM) + lane;
        f32x4 v[8]; float s = 0.f;
#pragma unroll
        for (int j = 0; j < 8; ++j) { v[j] = xr[64 * j]; s += (v[j].x + v[j].y) + (v[j].z + v[j].w); }
        const float mean = wave_sum(s) * (1.f / DM); float s2 = 0.f;
#pragma unroll
        for (int j = 0; j < 8; ++j) { v[j] = v[j] - mean; s2 += (v[j].x * v[j].x + v[j].y * v[j].y) + (v[j].z * v[j].z + v[j].w * v[j].w); }
        const float rstd = 1.f / sqrtf(wave_sum(s2) * (1.f / DM) + LN_EPS);
#pragma unroll
        for (int j = 0; j < 8; ++j) { const int col = 4 * lane + 256 * j;
            const f32x4 sh = *(const LAS f32x4*)(ms + b * 4096 + col), sc = *(const LAS f32x4*)(ms + b * 4096 + DM + col);
            const f32x4 y = v[j] * rstd * (sc + 1.0f) + sh;
            v2u o; o.x = pk2(y.x, y.y); o.y = pk2(y.z, y.w);
            *(v2u*)(U1 + (size_t)row * DM + col) = o; }
    }
    __syncthreads();
}

__device__ __forceinline__ void p3_post(const Ctx& c, const Args& a) {
    const int tid = c.tid, lane = c.lane, wave = c.wave, fr = lane & 15, fq = lane >> 4;
    bf16* PROJ = (bf16*)(c.ws + WS_PROJ); const bf16* U1 = (const bf16*)(c.ws + WS_U1); const bf16* WinT = (const bf16*)(c.ws + WS_WIN);
    for (int it = c.bid; it < NTOK / 32; it += c.G) {
        const int t0 = it * 32, b = t0 / SEQ;
        LAS float* red = (LAS float*)c.lds;
        LAS float* kw = red + 8 * 32 * 80;
        { f32x4 acc[2][5];
#pragma unroll
          for (int m = 0; m < 2; ++m)
#pragma unroll
              for (int n = 0; n < 5; ++n) acc[m][n] = (f32x4){0.f, 0.f, 0.f, 0.f};
          for (int ks = 0; ks < 8; ++ks) { const int kb = wave * 256 + ks * 32 + 8 * fq;
              const bf16x8 a0 = *(const bf16x8*)(U1 + (size_t)(t0 + fr) * DM + kb), a1 = *(const bf16x8*)(U1 + (size_t)(t0 + 16 + fr) * DM + kb);
#pragma unroll
              for (int n = 0; n < 5; ++n) { const bf16x8 bb = *(const bf16x8*)(WinT + (size_t)(NMAIN + 16 * n + fr) * DM + kb);
                  acc[0][n] = mfma16(a0, bb, acc[0][n]); acc[1][n] = mfma16(a1, bb, acc[1][n]); } }
#pragma unroll
          for (int m = 0; m < 2; ++m)
#pragma unroll
              for (int n = 0; n < 5; ++n)
#pragma unroll
                  for (int r = 0; r < 4; ++r) red[(wave * 32 + 16 * m + 4 * fq + r) * 80 + 16 * n + fr] = acc[m][n][r]; }
        __syncthreads();
        for (int i = tid; i < 32 * 80; i += 512) { float s = 0.f;
#pragma unroll
            for (int w = 0; w < 8; ++w) s += red[w * 2560 + i];
            kw[i] = s; }
        __syncthreads();
        { const float* kg = (const float*)a.in[I_KIDXG]; const float* CS = (const float*)(c.ws + WS_ROPE);
#pragma unroll
          for (int i4 = 0; i4 < 4; ++i4) { const int tk = wave * 4 + i4, tok = t0 + tk;
              const float v = kw[tk * 80 + lane]; const float mean = wave_sum(v) * (1.f / 64.f); const float dv = v - mean;
              const float rstd = 1.f / sqrtf(wave_sum(dv * dv) * (1.f / 64.f) + LN_EPS);
              float y = dv * rstd * kg[lane]; const float py = __shfl_xor(y, 8);
              if (lane < 16) { const float cs = CS[(size_t)tok * 48 + 32 + (lane & 7)], sn = CS[(size_t)tok * 48 + 40 + (lane & 7)]; y = lane < 8 ? y * cs - py * sn : y * cs + py * sn; }
              ((bf16*)(c.ws + WS_KIDX))[(size_t)tok * 64 + lane] = (bf16)f2bf(y);
              if (lane < 16) ((float*)(c.ws + WS_WIDX))[(size_t)tok * 16 + lane] = kw[tk * 80 + 64 + lane] * (0.25f * 0.125f); } }
        __syncthreads();
        { const int n = wave; LAS float* xcs = (LAS float*)c.lds + wave * (32 * 132);
          const float* convw = (const float*)a.in[I_CONVW]; const float* convb = (const float*)a.in[I_CONVB]; const bf16* WRG = (const bf16*)(c.ws + WS_WRG);
          const float* brga = (const float*)a.in[I_BRGA]; const float* brgx = (const float*)a.in[I_BRGX]; const float* lam = (const float*)a.in[I_LAM];
          float* AG = (float*)(c.ws + WS_AG); float* BG = (float*)(c.ws + WS_BG);
#pragma unroll 1
          for (int m = 0; m < 2; ++m) { const int tk = 16 * m + fr, tok = t0 + tk;
              f32x4 accA[8], accX[8];
#pragma unroll
              for (int nt = 0; nt < 8; ++nt) { accA[nt] = (f32x4){0.f, 0.f, 0.f, 0.f}; accX[nt] = (f32x4){0.f, 0.f, 0.f, 0.f}; }
#pragma unroll 1
              for (int ks = 0; ks < 4; ++ks) { int fq8 = 8 * fq; asm volatile("" : "+v"(fq8));
                  const int chl = ks * 32 + fq8, ch = n * 128 + chl;
                  f32x4 x0 = *(const f32x4*)(convb + ch), x1 = *(const f32x4*)(convb + ch + 4);
#pragma unroll
                  for (int j = 0; j < 4; ++j) { const int tt = tok - 3 + j;
                      if (tt >= b * SEQ) { const v4u raw = *(const v4u*)(PROJ + (size_t)tt * NMAIN + C_XL + ch);
                          const f32x4 w0 = *(const f32x4*)(convw + j * D_LRU + ch), w1 = *(const f32x4*)(convw + j * D_LRU + ch + 4);
                          x0.x += w0.x * bflo(raw.x); x0.y += w0.y * bfhi(raw.x); x0.z += w0.z * bflo(raw.y); x0.w += w0.w * bfhi(raw.y);
                          x1.x += w1.x * bflo(raw.z); x1.y += w1.y * bfhi(raw.z); x1.z += w1.z * bflo(raw.w); x1.w += w1.w * bfhi(raw.w); } }
                  *(LAS f32x4*)(xcs + tk * 132 + chl) = x0; *(LAS f32x4*)(xcs + tk * 132 + chl + 4) = x1;
                  v4u o; o.x = pk2(x0.x, x0.y); o.y = pk2(x0.z, x0.w); o.z = pk2(x1.x, x1.y); o.w = pk2(x1.z, x1.w);
                  const bf16x8 af = __builtin_bit_cast(bf16x8, o);
#pragma unroll
                  for (int nt = 0; nt < 8; ++nt) { const size_t wo = ((size_t)n * 128 + 16 * nt + fr) * 128 + ks * 32 + fq8;
                      const bf16x8 ba = *(const bf16x8*)(WRG + wo), bx = *(const bf16x8*)(WRG + (size_t)8 * 16384 + wo);
                      accA[nt] = mfma16(af, ba, accA[nt]); accX[nt] = mfma16(af, bx, accX[nt]); } }
              LDS_WAIT(); asm volatile("" ::: "memory");
#pragma unroll
              for (int nt = 0; nt < 8; ++nt) { const int chl = 16 * nt + fr, ch = n * 128 + chl;
                  const float ba_ = brga[ch], bx_ = brgx[ch], sp = log1pf(__expf(-lam[ch]));
#pragma unroll
                  for (int r = 0; r < 4; ++r) { const int tk2 = 16 * m + 4 * fq + r;
                      const float ra = sigmoidf_(accA[nt][r] + ba_), ix = sigmoidf_(accX[nt][r] + bx_);
                      const float la = -8.0f * ra * sp, av = __expf(la), bc = sqrtf(-expm1f(2.0f * la)), xv = xcs[tk2 * 132 + chl];
                      AG[(size_t)(t0 + tk2) * D_LRU + ch] = av; BG[(size_t)(t0 + tk2) * D_LRU + ch] = bc * ix * xv; } } } }
        __syncthreads();
    }
}

__device__ __forceinline__ void p4_lru_scan(const Ctx& c) {
    float* AG = (float*)(c.ws + WS_AG); float* BG = (float*)(c.ws + WS_BG); float* AGG = (float*)(c.ws + WS_AGG);
    for (int li = c.gw; li < 2048; li += c.ngw) { const int b = li >> 10, ck = (li >> 4) & 63, ch = (li & 15) * 64 + c.lane; const size_t base = ((size_t)b * SEQ + ck * 64) * D_LRU + ch;
        float h = 0.f, P = 1.f;
        for (int t8 = 0; t8 < 64; t8 += 8) { float av[8], bv[8];
#pragma unroll
            for (int t = 0; t < 8; ++t) { av[t] = AG[base + (size_t)(t8 + t) * D_LRU]; bv[t] = BG[base + (size_t)(t8 + t) * D_LRU]; }
#pragma unroll
            for (int t = 0; t < 8; ++t) { h = av[t] * h + bv[t]; P *= av[t]; av[t] = P; bv[t] = h; }
#pragma unroll
            for (int t = 0; t < 8; ++t) { AG[base + (size_t)(t8 + t) * D_LRU] = av[t]; BG[base + (size_t)(t8 + t) * D_LRU] = bv[t]; } }
        AGG[((size_t)(0 * 2 + b) * 64 + ck) * D_LRU + ch] = P; AGG[((size_t)(1 * 2 + b) * 64 + ck) * D_LRU + ch] = h; }
}

constexpr int IDX_ROWB = 144;
constexpr int IDX_TILE = 256, IDX_BUFB = IDX_TILE * IDX_ROWB;
__device__ __forceinline__ void p4_indexer_item(const Ctx& c, int b, int q0) {
    const int tid = c.tid, lane = c.lane, wave = c.wave, r32 = lane & 31, hh = lane >> 5;
    const bf16* PROJ = (const bf16*)(c.ws + WS_PROJ); const bf16* KIDX = (const bf16*)(c.ws + WS_KIDX); const float* WIDX = (const float*)(c.ws + WS_WIDX);
    const int n = 64 * (q0 / 64 + 1), ntile = (n + IDX_TILE - 1) / IDX_TILE, nj = n / 32;
    const int tokA = b * SEQ + q0 + 2 * wave, myq = tokA + ((r32 >> 2) & 1), myh = (r32 & 3) + 4 * (r32 >> 3);
    bf16x8 af[4];
#pragma unroll
    for (int s = 0; s < 4; ++s) af[s] = *(const bf16x8*)(PROJ + (size_t)myq * NMAIN + C_QI + myh * 64 + 16 * s + 8 * hh);
    float wv[16];
#pragma unroll
    for (int r = 0; r < 16; ++r) wv[r] = WIDX[(size_t)(tokA + hh) * 16 + r];
    const int skey = tid >> 1, shalf = tid & 1;
    const bf16* kbase = KIDX + (size_t)b * SEQ * 64;
    v4u st[4];
    auto stage_load = [&](int tile) { int key = tile * IDX_TILE + skey; key = key < SEQ ? key : SEQ - 1;
#pragma unroll
        for (int q = 0; q < 4; ++q) st[q] = *(const v4u*)(kbase + (size_t)key * 64 + shalf * 32 + 8 * q); };
    auto stage_write = [&](int buf) {
#pragma unroll
        for (int q = 0; q < 4; ++q) *(LAS v4u*)(c.lds + buf * IDX_BUFB + skey * IDX_ROWB + shalf * 64 + 16 * q) = st[q]; };
    unsigned key_[128];
    stage_load(0); stage_write(0); __syncthreads();
#pragma unroll
    for (int tile = 0; tile < 16; ++tile) {
        if (tile < ntile) {
            if (tile + 1 < ntile) stage_load(tile + 1);
            const LAS unsigned char* kb = c.lds + (tile & 1) * IDX_BUFB + r32 * IDX_ROWB + hh * 16;
#pragma unroll
            for (int jj = 0; jj < 8; ++jj) { const int j = tile * 8 + jj;
                if (j < nj) {
                    f32x16 acc = {};
#pragma unroll
                    for (int s = 0; s < 4; ++s) { const bf16x8 bb = *(const LAS bf16x8*)(kb + jj * 32 * IDX_ROWB + s * 32); acc = mfma32(af[s], bb, acc); }
                    float sc = 0.f;
#pragma unroll
                    for (int r = 0; r < 16; ++r) sc += wv[r] * fmaxf(acc[r], 0.f);
                    const unsigned u = __builtin_bit_cast(unsigned, sc);
                    key_[j] = (u & 0x80000000u) ? ~u : (u | 0x80000000u);
                } else key_[j] = 0u; }
            if (tile + 1 < ntile) stage_write((tile + 1) & 1);
            __syncthreads();
        } else {
#pragma unroll
            for (int jj = 0; jj < 8; ++jj) key_[tile * 8 + jj] = 0u;
        }
    }
    unsigned prefix = 0u;
    for (int bit = 31; bit >= 0; --bit) { const unsigned cand = prefix | (1u << bit); int cnt = 0;
#pragma unroll
        for (int g = 0; g < 8; ++g) if (g * 16 < nj) {
#pragma unroll
            for (int jj = 0; jj < 16; ++jj) cnt += (key_[g * 16 + jj] >= cand) ? 1 : 0; }
#pragma unroll
        for (int o = 1; o < 32; o <<= 1) cnt += __shfl_xor(cnt, o);
        if (cnt >= 256) prefix = cand; }
    unsigned wA0 = 0u, wA1 = 0u, wB0 = 0u, wB1 = 0u;
#define CMP16(x_) (((x_) & 0xFu) | (((x_) >> 4) & 0xF0u) | (((x_) >> 8) & 0xF00u) | (((x_) >> 12) & 0xF000u))
    const unsigned thr = prefix > 1u ? prefix : 1u;
#pragma unroll
    for (int g = 0; g < 8; ++g) if (g * 16 < nj) {
#pragma unroll
    for (int jj = 0; jj < 16; ++jj) { const int j = g * 16 + jj; const unsigned long long m = __ballot(key_[j] >= thr);
        const unsigned ma = (unsigned)m, mb = (unsigned)(m >> 32);
        const unsigned a0 = CMP16(ma) << (16 * (j & 1)), a1 = CMP16(ma >> 4) << (16 * (j & 1)), b0 = CMP16(mb) << (16 * (j & 1)), b1 = CMP16(mb >> 4) << (16 * (j & 1));
        const int idx = 2 * (j >> 1);
        if (idx < 64) { if (lane == idx) { wA0 |= a0; wB0 |= b0; } if (lane == idx + 1) { wA0 |= a1; wB0 |= b1; } }
        else { if (lane == idx - 64) { wA1 |= a0; wB1 |= b0; } if (lane == idx - 63) { wA1 |= a1; wB1 |= b1; } } } }
#undef CMP16
    unsigned* MASK = (unsigned*)(c.ws + WS_MASK);
    MASK[(size_t)tokA * 128 + lane] = wA0; MASK[(size_t)tokA * 128 + 64 + lane] = wA1;
    MASK[(size_t)(tokA + 1) * 128 + lane] = wB0; MASK[(size_t)(tokA + 1) * 128 + 64 + lane] = wB1;
    __syncthreads();
}
__device__ __forceinline__ void p4_indexer(const Ctx& c) {
    for (int w = c.bid; w < 256; w += c.G) { const int b = w & 1, p = w >> 1;
        p4_indexer_item(c, b, 16 * p); p4_indexer_item(c, b, 16 * (255 - p)); }
}

__device__ __forceinline__ void p5_lru_apply(const Ctx& c) {
    const float* AG = (const float*)(c.ws + WS_AG); const float* BG = (const float*)(c.ws + WS_BG); const float* AGG = (const float*)(c.ws + WS_AGG);
    const bf16* PROJ = (const bf16*)(c.ws + WS_PROJ); bf16* YMIX = (bf16*)(c.ws + WS_YMIX);
    for (int li = c.gw; li < 2048; li += c.ngw) { const int b = li >> 10, ck = (li >> 4) & 63, ch = (li & 15) * 64 + c.lane; const size_t tok0 = (size_t)b * SEQ + ck * 64;
        float hc = 0.f;
        for (int cc = 0; cc < ck; ++cc) hc = AGG[((size_t)(0 * 2 + b) * 64 + cc) * D_LRU + ch] * hc + AGG[((size_t)(1 * 2 + b) * 64 + cc) * D_LRU + ch];
#pragma unroll 8
        for (int t = 0; t < 64; ++t) { const size_t tok = tok0 + t; const float h = BG[tok * D_LRU + ch] + AG[tok * D_LRU + ch] * hc;
            const float gl = bf2f(PROJ[tok * NMAIN + C_GL + ch]);
            YMIX[tok * DM + ch] = (bf16)f2bf(h * gelu_tanh(gl)); } }
}
__device__ __forceinline__ void p5_attention(const Ctx& c) {
    typedef att::bf16 abf;
    const abf* PROJ = (const abf*)(c.ws + WS_PROJ); abf* YMIX = (abf*)(c.ws + WS_YMIX); const unsigned long long* MASK = (const unsigned long long*)(c.ws + WS_MASK);
    for (int w = c.bid; w < 256; w += c.G) {
        const int xcd = w & 7, slot = w >> 3, bh = xcd * 2 + (slot >> 4), x = 15 - (slot & 15), b = bh >> 3, h = bh & 7;
        att::BlockRef<abf, abf> cur;
        const size_t tokb = (size_t)b * SEQ, tok0 = tokb + (size_t)x * 256;
        cur.Q = PROJ + tok0 * NMAIN + C_Q + h * 128; cur.K = PROJ + tokb * NMAIN + C_K + h * 128; cur.V = PROJ + tokb * NMAIN + C_V + h * 128;
        cur.O = YMIX + tok0 * DM + D_LRU + h * 128; cur.M = MASK + tok0 * 64; cur.P0 = x * 256;
        att::Seam<abf> S;
        att::causal_swa_prime<abf, abf>(cur, 1 << 30, (char*)c.lds, S);
        att::causal_swa_block<abf, abf>(cur, cur, SEQ, 1 << 30, (char*)c.lds, S);
        VM_WAIT(); __syncthreads();
    }
}

__device__ __forceinline__ void p7_rows(const Ctx& c, const Args& a) {
    const int lane = c.lane;
    float* X1 = (float*)(c.ws + WS_X1); bf16* U2 = (bf16*)(c.ws + WS_U2); const float* MODF = (const float*)(c.ws + WS_MODF);
    const float* g1 = (const float*)a.in[I_LN1G]; const float* b1 = (const float*)a.in[I_LN1B];
    for (int row = c.gw; row < NTOK; row += c.ngw) { const int b = row / SEQ;
        f32x4* xr = (f32x4*)(X1 + (size_t)row * DM) + lane;
        f32x4 v[8]; float s = 0.f;
#pragma unroll
        for (int j = 0; j < 8; ++j) { v[j] = xr[64 * j]; s += (v[j].x + v[j].y) + (v[j].z + v[j].w); }
        float mean = wave_sum(s) * (1.f / DM), s2 = 0.f;
#pragma unroll
        for (int j = 0; j < 8; ++j) { v[j] = v[j] - mean; s2 += (v[j].x * v[j].x + v[j].y * v[j].y) + (v[j].z * v[j].z + v[j].w * v[j].w); }
        float rstd = 1.f / sqrtf(wave_sum(s2) * (1.f / DM) + LN_EPS);
        s = 0.f;
#pragma unroll
        for (int j = 0; j < 8; ++j) { const int col = 4 * lane + 256 * j;
            v[j] = v[j] * rstd * *(const f32x4*)(g1 + col) + *(const f32x4*)(b1 + col);
            xr[64 * j] = v[j]; s += (v[j].x + v[j].y) + (v[j].z + v[j].w); }
        mean = wave_sum(s) * (1.f / DM); s2 = 0.f;
#pragma unroll
        for (int j = 0; j < 8; ++j) { v[j] = v[j] - mean; s2 += (v[j].x * v[j].x + v[j].y * v[j].y) + (v[j].z * v[j].z + v[j].w * v[j].w); }
        rstd = 1.f / sqrtf(wave_sum(s2) * (1.f / DM) + LN_EPS);
#pragma unroll
        for (int j = 0; j < 8; ++j) { const int col = 4 * lane + 256 * j;
            const f32x4 sh = *(const f32x4*)(MODF + (size_t)b * (6 * DM) + 3 * DM + col), sc = *(const f32x4*)(MODF + (size_t)b * (6 * DM) + 4 * DM + col);
            const f32x4 y = v[j] * rstd * (sc + 1.0f) + sh;
            v2u o; o.x = pk2(y.x, y.y); o.y = pk2(y.z, y.w);
            *(v2u*)(U2 + (size_t)row * DM + col) = o; }
    }
}

__device__ __forceinline__ unsigned f2key(float f) { const unsigned u = __builtin_bit_cast(unsigned, f); return u ^ ((unsigned)((int)u >> 31) | 0x80000000u); }
__device__ __forceinline__ float key2f(unsigned k) { const unsigned u = (k & 0x80000000u) ? (k ^ 0x80000000u) : ~k; return __builtin_bit_cast(float, u); }
#define INSK(k_, T) do { _Pragma("unroll") for (int q_ = 0; q_ < 16; ++q_) { const unsigned t_ = T[q_]; const unsigned mx_ = t_ > k_ ? t_ : k_; const unsigned mn_ = t_ > k_ ? k_ : t_; T[q_] = mx_; k_ = mn_; } } while (0)
__device__ __forceinline__ float wave_sum_u(float v) {
    v += __builtin_bit_cast(float, __builtin_amdgcn_mov_dpp(__builtin_bit_cast(int, v), 0xB1, 0xf, 0xf, true));
    v += __builtin_bit_cast(float, __builtin_amdgcn_mov_dpp(__builtin_bit_cast(int, v), 0x4E, 0xf, 0xf, true));
    v += __builtin_bit_cast(float, __builtin_amdgcn_mov_dpp(__builtin_bit_cast(int, v), 0x141, 0xf, 0xf, true));
    v += __builtin_bit_cast(float, __builtin_amdgcn_mov_dpp(__builtin_bit_cast(int, v), 0x140, 0xf, 0xf, true));
    const int iv = __builtin_bit_cast(int, v);
    return (__builtin_bit_cast(float, __builtin_amdgcn_readlane(iv, 0)) + __builtin_bit_cast(float, __builtin_amdgcn_readlane(iv, 16)))
         + (__builtin_bit_cast(float, __builtin_amdgcn_readlane(iv, 32)) + __builtin_bit_cast(float, __builtin_amdgcn_readlane(iv, 48)));
}
__device__ __forceinline__ float dot2bf(unsigned a, unsigned b, float c) {
    c = fmaf(bflo(a), bflo(b), c); return fmaf(bfhi(a), bfhi(b), c);
}
__device__ __forceinline__ void p9_peer(const Ctx& c, const Args& a) {
    const int lane = c.lane, wave = c.wave, fr = lane & 15, fq = lane >> 4;
    const bf16* QP = (const bf16*)(c.ws + WS_QP); const bf16* SUBK = (const bf16*)(c.ws + WS_SUBK); const bf16* U2 = (const bf16*)(c.ws + WS_U2);
    const unsigned char* PU8 = c.ws + WS_PU; const unsigned char* PV8 = c.ws + WS_PV; const float* PUS = (const float*)(c.ws + WS_PUS); const float* PVS = (const float*)(c.ws + WS_PVS); const float* X1 = (const float*)(c.ws + WS_X1);
    const float* MODF = (const float*)(c.ws + WS_MODF); const float* g2 = (const float*)a.in[I_LN2G]; const float* b2 = (const float*)a.in[I_LN2B];
    int* EIDX = (int*)(c.ws + WS_U1); float* PGW = (float*)(c.ws + WS_U1 + 4 * MiB);
    for (int it = c.bid; it < NTOK / 32; it += c.G) {
        const int t0 = it * 32;
#ifndef P9_NOROUTE
        for (int rrep = 0; rrep < NREP(91); ++rrep)
        { LAS float* sb = (LAS float*)c.lds + wave * (32 * 129); const int h = wave;
#pragma unroll 1
          for (int m = 0; m < 2; ++m) {
              int fq8 = 8 * fq; asm volatile("" : "+v"(fq8));
              { f32x4 acc[2][8];
#pragma unroll
                for (int p = 0; p < 2; ++p)
#pragma unroll
                    for (int nt = 0; nt < 8; ++nt) acc[p][nt] = (f32x4){0.f, 0.f, 0.f, 0.f};
#pragma unroll
                for (int p = 0; p < 2; ++p)
#pragma unroll
                    for (int ks = 0; ks < 4; ++ks) { const bf16x8 av = *(const bf16x8*)(QP + (size_t)(t0 + 16 * m + fr) * DM + h * 256 + p * 128 + ks * 32 + fq8);
#pragma unroll
                        for (int nt = 0; nt < 8; ++nt) { const bf16x8 bv = *(const bf16x8*)(SUBK + ((size_t)(h * 2 + p) * 128 + 16 * nt + fr) * 128 + ks * 32 + fq8);
                            acc[p][nt] = mfma16(av, bv, acc[p][nt]); } }
#pragma unroll
                for (int p = 0; p < 2; ++p)
#pragma unroll
                    for (int nt = 0; nt < 8; ++nt)
#pragma unroll
                        for (int r = 0; r < 4; ++r) sb[(p * 16 + 4 * fq + r) * 129 + 16 * nt + fr] = acc[p][nt][r]; }
              LDS_WAIT(); asm volatile("" ::: "memory");
              unsigned T[16];
#pragma unroll
              for (int q = 0; q < 16; ++q) T[q] = 0u;
              { const int half = lane >> 5; const LAS float* row = sb + (lane & 31) * 129 + half * 64;
#pragma unroll 4
                for (int k = 0; k < 64; ++k) { unsigned key = (f2key(row[k]) & 0xFFFFFF80u) | (unsigned)(127 - (half * 64 + k)); INSK(key, T); } }
              { unsigned P[16];
#pragma unroll
                for (int q = 0; q < 16; ++q) P[q] = (unsigned)__shfl_xor((int)T[q], 32);
#pragma unroll
                for (int q = 0; q < 16; ++q) { unsigned key = P[q]; INSK(key, T); } }
              unsigned T2[16];
#pragma unroll
              for (int q = 0; q < 16; ++q) T2[q] = (unsigned)__shfl((int)T[q], (lane & 15) + 16);
              LDS_WAIT(); asm volatile("" ::: "memory");
              LAS int* ib = (LAS int*)sb;
              if (lane < 16) {
#pragma unroll
                  for (int q = 0; q < 16; ++q) { ib[lane * 33 + q] = 127 - (int)(T[q] & 0x7Fu); ib[lane * 33 + 16 + q] = 127 - (int)(T2[q] & 0x7Fu); } }
              float f1[16], f2[16];
#pragma unroll
              for (int q = 0; q < 16; ++q) { f1[q] = key2f(T[q] & 0xFFFFFF80u); f2[q] = key2f(T2[q] & 0xFFFFFF80u); }
              unsigned C[16];
#pragma unroll
              for (int q = 0; q < 16; ++q) C[q] = 0u;
#pragma unroll
              for (int a_ = 0; a_ < 16; ++a_)
#pragma unroll
                  for (int b_ = 0; b_ < 16; ++b_) if ((a_ + 1) * (b_ + 1) <= 16) { unsigned key = (f2key(f1[a_] + f2[b_]) & 0xFFFFFF00u) | (unsigned)(255 - (a_ * 16 + b_)); INSK(key, C); }
              LDS_WAIT(); asm volatile("" ::: "memory");
              if (lane < 16) {
                  const float mx = key2f(C[0] & 0xFFFFFF00u); float ev[16], sum = 0.f;
#pragma unroll
                  for (int q = 0; q < 16; ++q) { ev[q] = __expf(key2f(C[q] & 0xFFFFFF00u) - mx); sum += ev[q]; }
                  const float rs = 1.0f / sum;
#pragma unroll
                  for (int q = 0; q < 16; ++q) { const int code = 255 - (int)(C[q] & 0xFFu);
                      const int eid = ib[lane * 33 + (code >> 4)] * 128 + ib[lane * 33 + 16 + (code & 15)];
                      EIDX[(size_t)(t0 + 16 * m + lane) * 128 + h * 16 + q] = eid; PGW[(size_t)(t0 + 16 * m + lane) * 128 + h * 16 + q] = ev[q] * rs; } }
              LDS_WAIT(); asm volatile("" ::: "memory");
          } }
#endif
        VM_WAIT(); __syncthreads();
#ifndef P9_NOGATHER
        for (int grep_ = 0; grep_ < NREP(92); ++grep_)
#pragma unroll 1
        for (int i4 = 0; i4 < 4; ++i4) { const int tok = t0 + wave * 4 + i4, b = tok / SEQ;
            int l16 = 16 * lane; asm volatile("" : "+v"(l16));
            f32x2 uu[2][8];
#pragma unroll
            for (int cc = 0; cc < 2; ++cc)
#pragma unroll
                for (int hq = 0; hq < 2; ++hq) { const v4u r = *(const v4u*)(U2 + (size_t)tok * DM + 1024 * cc + l16 + 8 * hq);
                    uu[cc][4 * hq + 0] = (f32x2){bflo(r.x), bfhi(r.x)}; uu[cc][4 * hq + 1] = (f32x2){bflo(r.y), bfhi(r.y)}; uu[cc][4 * hq + 2] = (f32x2){bflo(r.z), bfhi(r.z)}; uu[cc][4 * hq + 3] = (f32x2){bflo(r.w), bfhi(r.w)}; }
            f32x2 acc[2][8];
#pragma unroll
            for (int cc = 0; cc < 2; ++cc)
#pragma unroll
                for (int q = 0; q < 8; ++q) acc[cc][q] = (f32x2){0.f, 0.f};
#pragma unroll 1
            for (int hf = 0; hf < 2; ++hf) {
                const int myi = EIDX[(size_t)tok * 128 + hf * 64 + lane]; const float myg = PGW[(size_t)tok * 128 + hf * 64 + lane];
                const float mysu = PUS[myi], mysv = PVS[myi];
#pragma unroll 1
                for (int e4 = 0; e4 < 64; e4 += 4) {
                    int ex[4]; float gu[4], gv[4];
#pragma unroll
                    for (int q = 0; q < 4; ++q) { ex[q] = __builtin_amdgcn_readlane(myi, e4 + q);
                        gu[q] = __builtin_bit_cast(float, __builtin_amdgcn_readlane(__builtin_bit_cast(int, mysu), e4 + q));
                        gv[q] = __builtin_bit_cast(float, __builtin_amdgcn_readlane(__builtin_bit_cast(int, myg * mysv), e4 + q)); }
                    v4u ru[4][2];
#pragma unroll
                    for (int q = 0; q < 4; ++q)
#pragma unroll
                        for (int cc = 0; cc < 2; ++cc) ru[q][cc] = *(const v4u*)(PU8 + (size_t)ex[q] * DM + 1024 * cc + l16);
                    __builtin_amdgcn_sched_barrier(0);
                    v4u rv[4][2];
#pragma unroll
                    for (int q = 0; q < 4; ++q)
#pragma unroll
                        for (int cc = 0; cc < 2; ++cc) rv[q][cc] = *(const v4u*)(PV8 + (size_t)ex[q] * DM + 1024 * cc + l16);
                    __builtin_amdgcn_sched_barrier(0);
                    float hk[4];
#pragma unroll
                    for (int q = 0; q < 4; ++q) { f32x2 d = {0.f, 0.f};
#pragma unroll
                        for (int cc = 0; cc < 2; ++cc)
#pragma unroll
                            for (int w = 0; w < 4; ++w) { const int wd = (int)ru[q][cc][w];
                                d += __builtin_amdgcn_cvt_pk_f32_fp8(wd, false) * uu[cc][2 * w]; d += __builtin_amdgcn_cvt_pk_f32_fp8(wd, true) * uu[cc][2 * w + 1]; }
                        hk[q] = gv[q] * gelu_tanh(wave_sum_u(d.x + d.y) * gu[q]); }
                    __builtin_amdgcn_sched_barrier(0);
#pragma unroll
                    for (int q = 0; q < 4; ++q)
#pragma unroll
                        for (int cc = 0; cc < 2; ++cc)
#pragma unroll
                            for (int w = 0; w < 4; ++w) { const int wd = (int)rv[q][cc][w];
                                acc[cc][2 * w] += __builtin_amdgcn_cvt_pk_f32_fp8(wd, false) * hk[q]; acc[cc][2 * w + 1] += __builtin_amdgcn_cvt_pk_f32_fp8(wd, true) * hk[q]; }
                    __builtin_amdgcn_sched_barrier(0);
                } }
            float s = 0.f; f32x4 z[2][4];
#pragma unroll
            for (int cc = 0; cc < 2; ++cc)
#pragma unroll
                for (int w = 0; w < 4; ++w) { const int col = 1024 * cc + l16 + 4 * w;
                    const f32x4 xv = *(const f32x4*)(X1 + (size_t)tok * DM + col), gt = *(const f32x4*)(MODF + (size_t)b * (6 * DM) + 5 * DM + col);
                    const f32x4 yv = {acc[cc][2 * w].x, acc[cc][2 * w].y, acc[cc][2 * w + 1].x, acc[cc][2 * w + 1].y};
                    z[cc][w] = xv * DN_ALPHA + (gt + 1.0f) * yv;
                    s += (z[cc][w].x + z[cc][w].y) + (z[cc][w].z + z[cc][w].w); }
            const float mean = wave_sum_u(s) * (1.f / DM); float s2 = 0.f;
#pragma unroll
            for (int cc = 0; cc < 2; ++cc)
#pragma unroll
                for (int w = 0; w < 4; ++w) { z[cc][w] = z[cc][w] - mean; s2 += (z[cc][w].x * z[cc][w].x + z[cc][w].y * z[cc][w].y) + (z[cc][w].z * z[cc][w].z + z[cc][w].w * z[cc][w].w); }
            const float rstd = 1.f / sqrtf(wave_sum_u(s2) * (1.f / DM) + LN_EPS);
#pragma unroll
            for (int cc = 0; cc < 2; ++cc)
#pragma unroll
                for (int w = 0; w < 4; ++w) { const int col = 1024 * cc + l16 + 4 * w;
                    *(f32x4*)(a.out + (size_t)tok * DM + col) = z[cc][w] * rstd * *(const f32x4*)(g2 + col) + *(const f32x4*)(b2 + col); }
        }
#endif
        __syncthreads();
    }
}

#ifndef MK_SINGLE
#define MK_SINGLE 1
#endif
constexpr int NPHASE = 10;
constexpr int CW_BAR = 4096;

__global__ void __launch_bounds__(NWAVES * 64, 2) fwd_kernel(Args args) {
    extern __shared__ __attribute__((aligned(16))) unsigned char lds_raw[];
    Ctx c;
    c.lds = (LAS unsigned char*)lds_raw; c.ws = args.ws;
    c.tid = threadIdx.x; c.lane = c.tid & 63; c.wave = __builtin_amdgcn_readfirstlane(c.tid >> 6);
    c.bid = blockIdx.x; c.G = gridDim.x; c.gw = c.bid * NWAVES + c.wave; c.ngw = c.G * NWAVES;
    volatile LAS unsigned* MISC = (volatile LAS unsigned*)(c.lds + MISC_OFF);
    if (c.tid < 64) MISC[c.tid] = 0u;
    __syncthreads();
    const int lo = args.ph_lo, hi = args.ph_hi;
    XcdBarrier bar; bar.bar = (unsigned*)(c.ws + WS_CTL) + CW_BAR; bar.x = 0; bar.st = nullptr;
    if (hi - lo > 1) bar = xcd_barrier_post((unsigned*)(c.ws + WS_CTL) + CW_BAR, MISC + 8);
#ifdef ONLY
#define IN(k) ((k) == ONLY)
#else
#define IN(k) (lo <= (k) && (k) < hi)
#endif
#define SEAM(k) do { if (IN(k) && IN((k) + 1)) xcd_barrier(bar); } while (0)

    if (IN(0)) { for (int rep = 0; rep < NREP(0); ++rep) { p0_prologue(c, args); } } SEAM(0);
    if (IN(1)) { for (int rep = 0; rep < NREP(1); ++rep) { p1_u1(c, args); } } SEAM(1);
    if (IN(2)) {
        pg8::Gemm g{(const pg8::bf16_t*)(c.ws + WS_U1), (const pg8::bf16_t*)(c.ws + WS_WIN), NTOK, NMAIN, DM}; pg8::StaticOrder S; S.init(NTOK, NMAIN, c.G, c.bid);
        pg8::EpiProj E{(pg8::bf16_t*)(c.ws + WS_PROJ), NMAIN, (const float*)(c.ws + WS_ROPE)};
        for (int rep = 0; rep < NREP(2); ++rep) pg8::gemm_phase<pg8::EpiProj, pg8::StaticOrder, true, true>(c.lds, g, S, E);
    } SEAM(2);
    if (IN(3)) { p3_post(c, args); } SEAM(3);
    if (IN(4)) { p4_lru_scan(c); for (int rep = 0; rep < NREP(4); ++rep) { p4_indexer(c); } } SEAM(4);
    if (IN(5)) { for (int rep = 0; rep < NREP(50); ++rep) { p5_lru_apply(c); } for (int rep = 0; rep < NREP(5); ++rep) { p5_attention(c); } } SEAM(5);
    if (IN(6)) {
        pg8::Gemm g{(const pg8::bf16_t*)(c.ws + WS_YMIX), (const pg8::bf16_t*)(c.ws + WS_WOUT), NTOK, DM, DM}; pg8::StaticOrder S; S.init(NTOK, DM, c.G, c.bid);
        pg8::EpiResF32 E{(const float*)args.in[I_X], (float*)(c.ws + WS_X1), (const float*)(c.ws + WS_MODF) + 2 * DM, DM, SEQ, 6 * DM, DN_ALPHA};
        for (int rep = 0; rep < NREP(6); ++rep) pg8::gemm_phase<pg8::EpiResF32, pg8::StaticOrder, true, true>(c.lds, g, S, E);
    } SEAM(6);
    if (IN(7)) { p7_rows(c, args); } SEAM(7);
    if (IN(8)) {
        pg8::Gemm g{(const pg8::bf16_t*)(c.ws + WS_U2), (const pg8::bf16_t*)(c.ws + WS_WPQ), NTOK, DM, DM}; pg8::StaticOrder S; S.init(NTOK, DM, c.G, c.bid);
        pg8::EpiBf16<0> E{(pg8::bf16_t*)(c.ws + WS_QP), DM, nullptr, 0, 0, 1.f};
        for (int rep = 0; rep < NREP(8); ++rep) pg8::gemm_phase<pg8::EpiBf16<0>, pg8::StaticOrder, true, true>(c.lds, g, S, E);
    } SEAM(8);
    if (IN(9)) { for (int rep = 0; rep < NREP(9); ++rep) { p9_peer(c, args); } }
#undef IN
#undef SEAM
}

extern "C" void kernel_launch(void* const* d_in, const int* in_sizes, int n_in, void* d_out, int out_size, void* d_ws, size_t ws_size, hipStream_t stream) {
    static int grid = 0;
    if (grid == 0) {
        if (n_in != 23 || in_sizes[0] != NTOK * DM || out_size != NTOK * DM || ws_size < WS_END) {
            fprintf(stderr, "kernel_launch: unexpected shapes (n_in %d, in0 %d, out %d, ws %zu); nothing launched\n", n_in, n_in > 0 ? in_sizes[0] : -1, out_size, ws_size); grid = -1; return; }
        int dev = 0, cus = 0, per_cu = 0;
        if (hipGetDevice(&dev) != hipSuccess || hipDeviceGetAttribute(&cus, hipDeviceAttributeMultiprocessorCount, dev) != hipSuccess) { grid = -1; return; }
        if (hipFuncSetAttribute((const void*)fwd_kernel, hipFuncAttributeMaxDynamicSharedMemorySize, LDS_BYTES) != hipSuccess) { fprintf(stderr, "kernel_launch: hipFuncSetAttribute failed\n"); grid = -1; return; }
        if (hipOccupancyMaxActiveBlocksPerMultiprocessor(&per_cu, (const void*)fwd_kernel, NWAVES * 64, LDS_BYTES) != hipSuccess || per_cu < 1) { fprintf(stderr, "kernel_launch: occupancy query says %d\n", per_cu); }
        (void)hipGetLastError();
        grid = cus;
    }
    if (grid < 0) return;
    (void)hipMemsetAsync((char*)d_ws + WS_CTL, 0, CTL_ZERO_BYTES, stream);
    Args a{};
    for (int i = 0; i < 23; ++i) a.in[i] = d_in[i];
    a.out = (float*)d_out; a.ws = (unsigned char*)d_ws;
#if MK_SINGLE
    a.ph_lo = 0; a.ph_hi = NPHASE;
    hipLaunchKernelGGL(fwd_kernel, dim3(grid), dim3(NWAVES * 64), LDS_BYTES, stream, a);
#else
    for (int p = 0; p < NPHASE; ++p) { a.ph_lo = p; a.ph_hi = p + 1; hipLaunchKernelGGL(fwd_kernel, dim3(grid), dim3(NWAVES * 64), LDS_BYTES, stream, a); }
#endif
}
```

```cpp
#include <hip/hip_runtime.h>
#include <hip/hip_bf16.h>
#include <cstdio>
#include <cstdint>
#include <cmath>
#ifndef REP_PHASE
#define REP_PHASE -1
#endif
#define NREP(k) ((k) == REP_PHASE ? 2 : 1)

constexpr int NB = 2, SEQ = 4096, NTOK = NB * SEQ, DM = 2048;
constexpr int D_LRU = 1024, D_ATT = 1024, NHEAD = 8, HDIM = 128, NIH = 16, IDIM = 64;
constexpr int DIN = 6224, NMAIN = 6144;
constexpr int C_XL = 0, C_GL = 1024, C_Q = 2048, C_K = 3072, C_V = 4096, C_QI = 5120, C_KI = 6144, C_WI = 6208;
constexpr int NEXP = 16384, PKD = 256, PTOPK = 16, PHEADS = 8, NKEYS = 128;
constexpr float LN_EPS = 1e-5f;
constexpr float DN_ALPHA = 1.189207115002721f;

constexpr size_t MiB = 1u << 20;
constexpr size_t WS_CTL = 0, CTL_ZERO_BYTES = 1 * MiB;
constexpr size_t WS_MODP = 1 * MiB;
constexpr size_t WS_MODF = 4 * MiB;
constexpr size_t WS_PUS = 4 * MiB + 256 * 1024, WS_PVS = 4 * MiB + 512 * 1024;
constexpr size_t WS_WRG  = 5 * MiB;
constexpr size_t WS_SUBK = 6 * MiB;
constexpr size_t WS_KIDX = 7 * MiB;
constexpr size_t WS_WIDX = 8 * MiB;
constexpr size_t WS_AGG  = 9 * MiB;
constexpr size_t WS_MASK = 10 * MiB;
constexpr size_t WS_WIN  = 14 * MiB;
constexpr size_t WS_WOUT = 40 * MiB;
constexpr size_t WS_WPQ  = 48 * MiB;
constexpr size_t WS_PU   = 56 * MiB;
constexpr size_t WS_PV   = 120 * MiB;
constexpr size_t WS_U1   = 184 * MiB;
constexpr size_t WS_PROJ = 216 * MiB;
constexpr size_t WS_AG   = 312 * MiB;
constexpr size_t WS_BG   = 344 * MiB;
constexpr size_t WS_ROPE = 376 * MiB;
constexpr size_t WS_END  = 378 * MiB;
constexpr size_t WS_MODA = 512 * 1024;
constexpr size_t WS_YMIX = WS_U1, WS_X1 = WS_PROJ, WS_U2 = WS_PROJ + 64 * MiB, WS_QP = WS_AG;

#define GAS __attribute__((address_space(1)))
#define LAS __attribute__((address_space(3)))
typedef unsigned short bf16;
typedef unsigned v4u __attribute__((ext_vector_type(4)));
typedef unsigned v2u __attribute__((ext_vector_type(2)));
typedef float f32x4 __attribute__((ext_vector_type(4)));
typedef float f32x2 __attribute__((ext_vector_type(2)));
typedef float f32x16 __attribute__((ext_vector_type(16)));
typedef short bf16x8 __attribute__((ext_vector_type(8)));
typedef short s16x4 __attribute__((ext_vector_type(4)));
typedef float v32f __attribute__((ext_vector_type(32)));
typedef unsigned v6u __attribute__((ext_vector_type(6)));
#define RLX_AGENT __ATOMIC_RELAXED, __HIP_MEMORY_SCOPE_AGENT
#define LDS_WAIT() asm volatile("s_waitcnt lgkmcnt(0)" ::: "memory")
#define VM_WAIT() asm volatile("s_waitcnt vmcnt(0)" ::: "memory")
__device__ __forceinline__ unsigned f2bf(float f) { unsigned u = __builtin_bit_cast(unsigned, f); return (u + 0x7fffu + ((u >> 16) & 1u)) >> 16; }
__device__ __forceinline__ unsigned pk2(float lo, float hi) { return f2bf(lo) | (f2bf(hi) << 16); }
__device__ __forceinline__ float bflo(unsigned w) { return __builtin_bit_cast(float, w << 16); }
__device__ __forceinline__ float bfhi(unsigned w) { return __builtin_bit_cast(float, w & 0xffff0000u); }
__device__ __forceinline__ float bf2f(bf16 h) { return __builtin_bit_cast(float, (unsigned)h << 16); }
__device__ __forceinline__ float wave_sum(float v) {
#pragma unroll
    for (int o = 1; o < 64; o <<= 1) v += __shfl_xor(v, o);
    return v;
}
__device__ __forceinline__ float sigmoidf_(float x) { return 1.0f / (1.0f + __expf(-x)); }
__device__ __forceinline__ float gelu_tanh(float x) {
    const float u = 1.5957691216057308f * (x + 0.044715f * x * x * x);
    return x / (1.0f + __expf(-u));
}
namespace pg8 {
#define PG8_LAS __attribute__((address_space(3)))
typedef unsigned short bf16_t;
typedef short bf16x8 __attribute__((ext_vector_type(8)));
typedef float f32x4 __attribute__((ext_vector_type(4)));
typedef unsigned u32x4 __attribute__((ext_vector_type(4)));
constexpr int BM = 256, BK = 64, HALF = 128, HTB = HALF * BK * 2  , STAGE_BYTES = 8 * HTB, NXCD = 8, WGM = 8;

__host__ __device__ __forceinline__ int lds_byte(int r, int c) { const int st = (r >> 4) * 2 + (c >> 5), rr = r & 15, cc = c & 31, ob = rr * 64 + cc * 2; return st * 1024 + (ob ^ (((ob >> 9) & 1) << 5)); }
__host__ __device__ __forceinline__ void stage_rc(int b, int& R, int& C) { const int st = b / 1024, sb = b % 1024, swz = sb ^ (((sb >> 9) & 1) << 5); R = (st >> 1) * 16 + swz / 64; C = (st & 1) * 32 + (swz % 64) / 2; }
__host__ __device__ __forceinline__ int perm32(int rho) { const int n = rho >> 4, i = rho & 15; return 8 * (i >> 2) + 4 * n + (i & 3); }

struct Unit { int pm, pn; };
struct Gemm { const bf16_t* A; const bf16_t* Bt; int M, N, K; };

struct StaticOrder {
    int nM, nN, nwg, G, c;
    __host__ __device__ void init(int M, int N, int G_, int c_) { nM = M / BM; nN = N / BM; nwg = nM * nN; G = G_; c = c_; }
    __host__ __device__ bool next(int i, Unit& u) const {
        const long L = (long)i * G + c; if (L >= nwg) return false;
        int wgid = (int)L; { const int q = nwg / NXCD, r = nwg % NXCD, xcd = wgid % NXCD, off = wgid / NXCD; wgid = (xcd < r ? xcd * (q + 1) : r * (q + 1) + (xcd - r) * q) + off; }
        const int nig = WGM * nN, gid = wgid / nig, fm = gid * WGM, gsz = (nM - fm) < WGM ? (nM - fm) : WGM;
        u.pm = fm + ((wgid % nig) % gsz); u.pn = (wgid % nig) / gsz; return true;
    }
    __device__ __forceinline__ void a_ready(const Unit&) const {}
    __device__ __forceinline__ void done(const Unit&) const {}
};

__device__ __forceinline__ unsigned cvt_pk_bf16(float lo, float hi) { unsigned r; asm volatile("v_cvt_pk_bf16_f32 %0, %1, %2" : "=v"(r) : "v"(lo), "v"(hi)); return r; }
typedef float f32x2 __attribute__((ext_vector_type(2)));
__device__ __forceinline__ f32x2 gelu_pk(f32x2 v) {
    const f32x2 av = __builtin_elementwise_abs(v), d = av * 0.2316418882f + 1.0f;
    f32x2 t; t.x = __builtin_amdgcn_rcpf(d.x); t.y = __builtin_amdgcn_rcpf(d.y);
    f32x2 q = t * 0.5307027145f + (-0.7265760135f); q = q * t + 0.7107068705f; q = q * t + (-0.142248368f); q = q * t + 0.127414796f; q = q * t;
    const f32x2 s = (v * v) * (-0.72134752044f);
    f32x2 e; e.x = __builtin_amdgcn_exp2f(s.x); e.y = __builtin_amdgcn_exp2f(s.y);
    const f32x2 m = v * (q * e), r = v - m;
    f32x2 o; o.x = v.x < 0.f ? m.x : r.x; o.y = v.y < 0.f ? m.y : r.y; return o;
}

template <int ACT  > struct EpiBf16 {
    static constexpr bool PERM = true, AFTER_DRAIN = false; static_assert(ACT == 0 || ACT == 1, "EpiBf16: ACT is 0 (none) or 1 (gelu_pk)");
    bf16_t* O; int ldc; const float* bias; int split_cols; size_t split_stride; float scale0;
    __device__ __forceinline__ void operator()(const f32x4 (&acc)[2][2][4][2], const Unit& u, int wr, int wc, int fr, int fq) const {
        const int row0 = u.pm * BM + wr * 64 + fr; int colt = u.pn * BM; bf16_t* base = O;
        float sc = 1.f; if (split_cols) { const int t = colt / split_cols; base += (size_t)t * split_stride; colt -= t * split_cols; if (t == 0) sc = scale0; }
        const int col0 = colt + wc * 32 + 8 * fq, bcol0 = u.pn * BM + wc * 32 + 8 * fq;
        f32x4 bv[2][2];
#pragma unroll
        for (int bj = 0; bj < 2; ++bj)
#pragma unroll
            for (int n = 0; n < 2; ++n) bv[bj][n] = bias ? *(const f32x4*)(bias + bcol0 + bj * HALF + 4 * n) : (f32x4){0.f, 0.f, 0.f, 0.f};
#pragma unroll
        for (int ai = 0; ai < 2; ++ai)
#pragma unroll
            for (int m = 0; m < 4; ++m) { bf16_t* rowp = base + (size_t)(row0 + ai * HALF + m * 16) * ldc + col0;
#pragma unroll
                for (int bj = 0; bj < 2; ++bj) { f32x4 v0 = acc[ai][bj][m][0] + bv[bj][0], v1 = acc[ai][bj][m][1] + bv[bj][1];
                    if (ACT == 1) { f32x2 a = gelu_pk((f32x2){v0[0], v0[1]}), b = gelu_pk((f32x2){v0[2], v0[3]}), c = gelu_pk((f32x2){v1[0], v1[1]}), d = gelu_pk((f32x2){v1[2], v1[3]});
                        v0 = (f32x4){a.x, a.y, b.x, b.y}; v1 = (f32x4){c.x, c.y, d.x, d.y}; }
                    v0 = v0 * sc; v1 = v1 * sc; u32x4 w; w.x = cvt_pk_bf16(v0[0], v0[1]); w.y = cvt_pk_bf16(v0[2], v0[3]); w.z = cvt_pk_bf16(v1[0], v1[1]); w.w = cvt_pk_bf16(v1[2], v1[3]);
                    *(u32x4*)(rowp + bj * HALF) = w; } }
    }
};

struct EpiProj {
    static constexpr bool PERM = true, AFTER_DRAIN = false;
    bf16_t* O; int ldc; const float* CS;
    __device__ __forceinline__ void operator()(const f32x4 (&acc)[2][2][4][2], const Unit& u, int wr, int wc, int fr, int fq) const {
        const int row0 = u.pm * BM + wr * 64 + fr, col0 = u.pn * BM + wc * 32 + 8 * fq, region = (u.pn * BM) >> 10;
        const int mode = (region == 2 || region == 3) ? (wc == 0 ? 1 : 0) : (region == 5 ? ((wc & 1) == 0 ? 2 : 0) : 0);
#pragma unroll
        for (int ai = 0; ai < 2; ++ai)
#pragma unroll
            for (int m = 0; m < 4; ++m) { const int row = row0 + ai * HALF + m * 16; bf16_t* rowp = O + (size_t)row * ldc + col0;
                f32x4 c0 = {1.f, 1.f, 1.f, 1.f}, c1 = c0, s0 = {0.f, 0.f, 0.f, 0.f}, s1 = s0;
                if (mode == 1) { const float* cs = CS + (size_t)row * 48 + 8 * (fq & 1); c0 = *(const f32x4*)cs; c1 = *(const f32x4*)(cs + 4); s0 = *(const f32x4*)(cs + 16); s1 = *(const f32x4*)(cs + 20); if (fq < 2) { s0 = -s0; s1 = -s1; } }
                if (mode == 2) { const float* cs = CS + (size_t)row * 48 + 32; if (fq < 2) { c0 = *(const f32x4*)cs; c1 = *(const f32x4*)(cs + 4); s0 = *(const f32x4*)(cs + 8); s1 = *(const f32x4*)(cs + 12); if (fq == 0) { s0 = -s0; s1 = -s1; } } }
#pragma unroll
                for (int bj = 0; bj < 2; ++bj) { f32x4 v0 = acc[ai][bj][m][0], v1 = acc[ai][bj][m][1];
                    if (mode != 0) { const int xm = mode == 1 ? 32 : 16; f32x4 o0, o1;
#pragma unroll
                        for (int e = 0; e < 4; ++e) { o0[e] = __shfl_xor(v0[e], xm); o1[e] = __shfl_xor(v1[e], xm); }
                        v0 = v0 * c0 + o0 * s0; v1 = v1 * c1 + o1 * s1; }
                    u32x4 w; w.x = cvt_pk_bf16(v0[0], v0[1]); w.y = cvt_pk_bf16(v0[2], v0[3]); w.z = cvt_pk_bf16(v1[0], v1[1]); w.w = cvt_pk_bf16(v1[2], v1[3]);
                    *(u32x4*)(rowp + bj * HALF) = w; } }
    }
};

struct EpiResF32 {
    static constexpr bool PERM = false, AFTER_DRAIN = false;
    const float* X; float* Z; const float* gate; int ldc, rows_per_batch, gstride; float alpha;
    __device__ __forceinline__ void operator()(const f32x4 (&acc)[2][2][4][2], const Unit& u, int wr, int wc, int fr, int fq) const {
        const int row0 = u.pm * BM + wr * 64 + fr, col0 = u.pn * BM + wc * 32 + 4 * fq;
        const float* gb = gate + (size_t)((u.pm * BM) / rows_per_batch) * gstride;
        f32x4 gv[2][2];
#pragma unroll
        for (int bj = 0; bj < 2; ++bj)
#pragma unroll
            for (int n = 0; n < 2; ++n) gv[bj][n] = *(const f32x4*)(gb + col0 + bj * HALF + n * 16) + 1.0f;
#pragma unroll
        for (int ai = 0; ai < 2; ++ai)
#pragma unroll
            for (int m = 0; m < 4; ++m) { const size_t off = (size_t)(row0 + ai * HALF + m * 16) * ldc + col0;
#pragma unroll
                for (int bj = 0; bj < 2; ++bj)
#pragma unroll
                    for (int n = 0; n < 2; ++n) { const f32x4 xv = *(const f32x4*)(X + off + bj * HALF + n * 16);
                        *(f32x4*)(Z + off + bj * HALF + n * 16) = xv * alpha + gv[bj][n] * acc[ai][bj][m][n]; } }
    }
};

template <class Epi, class Sched, bool ALIGN_EPI = false, bool SP2 = false>
__device__ __forceinline__ void gemm_phase(PG8_LAS unsigned char* lds, const Gemm g, const Sched& S, const Epi& E) {
    const int tid = threadIdx.x, wid = __builtin_amdgcn_readfirstlane(tid >> 6), lane = tid & 63, wr = wid >> 2, wc = wid & 3, fr = lane & 15, fq = lane >> 4;
    const int K = g.K, nt = K / BK;
    unsigned voffA[2], voffB[2];
#pragma unroll
    for (int i = 0; i < 2; ++i) { int R, C; stage_rc(tid * 16 + i * 8192, R, C); const int Rb = Epi::PERM ? ((R & ~31) + perm32(R & 31)) : R;
        voffA[i] = (unsigned)(R * K + C) * 2u; voffB[i] = (unsigned)(Rb * K + C) * 2u; }
    const size_t kstep = (size_t)(BK * 2);
    const size_t hstep = (size_t)HALF * K * 2;
    const size_t tstep = 2 * hstep;
    const unsigned ldsw = (unsigned)wid * 1024u;
    const int aoff = lds_byte(wr * 64 + fr, fq * 8), boff = lds_byte(wc * 32 + fr, fq * 8);
#define PG8_SA(b, h) (((b) * 2 + (h)) * HTB)
#define PG8_SB(b, h) ((4 + (b) * 2 + (h)) * HTB)
#define PG8_STAGE(bufoff, gbase, voff) do { _Pragma("unroll") for (int _i = 0; _i < 2; ++_i) \
        __builtin_amdgcn_global_load_lds((const unsigned*)((const char*)(gbase) + (voff)[_i]), (PG8_LAS unsigned*)(lds + (bufoff) + ldsw + _i * 8192), 16, 0, 0); } while (0)
#define PG8_LDA(dst, b, h) do { _Pragma("unroll") for (int m = 0; m < 4; ++m) _Pragma("unroll") for (int k = 0; k < 2; ++k) dst[m][k] = *(const PG8_LAS bf16x8*)(lds + PG8_SA(b, h) + aoff + m * 2048 + k * 1024); } while (0)
#define PG8_LDB(dst, b, h) do { _Pragma("unroll") for (int n = 0; n < 2; ++n) _Pragma("unroll") for (int k = 0; k < 2; ++k) dst[n][k] = *(const PG8_LAS bf16x8*)(lds + PG8_SB(b, h) + boff + n * 2048 + k * 1024); } while (0)
#define PG8_MMA(ai, bj, At, Bt) do { __builtin_amdgcn_s_setprio(1); _Pragma("unroll") for (int m = 0; m < 4; ++m) _Pragma("unroll") for (int n = 0; n < 2; ++n) _Pragma("unroll") for (int k = 0; k < 2; ++k) \
        acc[ai][bj][m][n] = __builtin_amdgcn_mfma_f32_16x16x32_bf16(Bt[n][k], At[m][k], acc[ai][bj][m][n], 0, 0, 0); __builtin_amdgcn_s_setprio(0); } while (0)
#define PG8_WAIT_V(n) asm volatile("s_waitcnt vmcnt(" #n ")" ::: "memory")
#define PG8_WAIT_L(n) asm volatile("s_waitcnt lgkmcnt(" #n ")" ::: "memory")
#define PG8_BAR __builtin_amdgcn_s_barrier()
#define PG8_SCHED __builtin_amdgcn_sched_barrier(0)
    Unit cur, nxt; int ui = 0;
    if (!S.next(0, cur)) return;
    f32x4 acc[2][2][4][2];
#pragma unroll
    for (int a = 0; a < 2; ++a)
#pragma unroll
        for (int b = 0; b < 2; ++b)
#pragma unroll
            for (int m = 0; m < 4; ++m)
#pragma unroll
                for (int n = 0; n < 2; ++n) acc[a][b][m][n] = (f32x4){0.f, 0.f, 0.f, 0.f};
    bf16x8 At[4][2], B0[2][2], B1[2][2];
    const char* cA = (const char*)g.A + (size_t)cur.pm * tstep; const char* cB = (const char*)g.Bt + (size_t)cur.pn * tstep;
    S.a_ready(cur);
    if constexpr (SP2) {
        PG8_STAGE(PG8_SB(0, 0), cB, voffB); PG8_STAGE(PG8_SB(0, 1), cB + hstep, voffB); PG8_STAGE(PG8_SA(0, 0), cA, voffA); PG8_STAGE(PG8_SA(0, 1), cA + hstep, voffA);
        if (wr == 1) PG8_BAR;
        PG8_WAIT_V(2); PG8_BAR;
        PG8_STAGE(PG8_SB(1, 0), cB + kstep, voffB); PG8_STAGE(PG8_SA(1, 0), cA + kstep, voffA); PG8_STAGE(PG8_SB(1, 1), cB + hstep + kstep, voffB);
        PG8_WAIT_V(6); PG8_BAR;
    } else {
        PG8_STAGE(PG8_SB(0, 0), cB, voffB); PG8_STAGE(PG8_SA(0, 0), cA, voffA); PG8_STAGE(PG8_SB(0, 1), cB + hstep, voffB); PG8_STAGE(PG8_SA(0, 1), cA + hstep, voffA);
        if (wr == 1) PG8_BAR;
        PG8_WAIT_V(4); PG8_BAR;
        PG8_STAGE(PG8_SB(1, 0), cB + kstep, voffB); PG8_STAGE(PG8_SA(1, 0), cA + kstep, voffA); PG8_STAGE(PG8_SB(1, 1), cB + hstep + kstep, voffB);
        PG8_WAIT_V(6); PG8_BAR;
    }
    for (;;) {
        const bool has_next = S.next(ui + 1, nxt);
        const char* nA = has_next ? (const char*)g.A + (size_t)nxt.pm * tstep : cA; const char* nB = has_next ? (const char*)g.Bt + (size_t)nxt.pn * tstep : cB;
        for (int t = 0; t < nt; t += 2) {
            const bool last = (t == nt - 2);
            const char* a1 = cA + (size_t)(t + 1) * kstep;
            const char* a2 = last ? nA : cA + (size_t)(t + 2) * kstep; const char* b2 = last ? nB : cB + (size_t)(t + 2) * kstep;
            const char* a3 = a2 + kstep; const char* b3 = b2 + kstep;
            if (last && has_next) S.a_ready(nxt);
            if constexpr (SP2) {
            PG8_LDB(B0, 0, 0); PG8_LDB(B1, 0, 1); PG8_SCHED; PG8_LDA(At, 0, 0); PG8_STAGE(PG8_SA(1, 1), a1 + hstep, voffA);
            PG8_WAIT_V(8); PG8_WAIT_L(0); PG8_BAR; PG8_MMA(0, 0, At, B0); PG8_MMA(0, 1, At, B1); PG8_BAR; PG8_SCHED;
            PG8_LDA(At, 0, 1); PG8_STAGE(PG8_SB(0, 0), b2, voffB); PG8_STAGE(PG8_SB(0, 1), b2 + hstep, voffB); PG8_STAGE(PG8_SA(0, 0), a2, voffA);
            PG8_WAIT_V(8); PG8_WAIT_L(0); PG8_BAR; PG8_MMA(1, 0, At, B0); PG8_MMA(1, 1, At, B1); PG8_BAR; PG8_SCHED;
            PG8_LDB(B0, 1, 0); PG8_LDB(B1, 1, 1); PG8_SCHED; PG8_LDA(At, 1, 0); PG8_STAGE(PG8_SA(0, 1), a2 + hstep, voffA);
            PG8_WAIT_V(8); PG8_WAIT_L(0); PG8_BAR; PG8_MMA(0, 0, At, B0); PG8_MMA(0, 1, At, B1); PG8_BAR; PG8_SCHED;
            PG8_LDA(At, 1, 1); PG8_STAGE(PG8_SB(1, 0), b3, voffB); PG8_STAGE(PG8_SB(1, 1), b3 + hstep, voffB); PG8_STAGE(PG8_SA(1, 0), a3, voffA);
            PG8_WAIT_V(8); PG8_WAIT_L(0); PG8_BAR; PG8_MMA(1, 0, At, B0); PG8_MMA(1, 1, At, B1); PG8_BAR; PG8_SCHED;
            } else {
            PG8_LDB(B0, 0, 0); PG8_SCHED; PG8_LDA(At, 0, 0); PG8_STAGE(PG8_SA(1, 1), a1 + hstep, voffA);
            PG8_WAIT_L(8); PG8_BAR; PG8_WAIT_L(0); PG8_MMA(0, 0, At, B0); PG8_BAR; PG8_SCHED;
            PG8_LDB(B1, 0, 1); PG8_STAGE(PG8_SB(0, 0), b2, voffB);
            PG8_BAR; PG8_WAIT_L(0); PG8_MMA(0, 1, At, B1); PG8_BAR;
            PG8_LDA(At, 0, 1); PG8_STAGE(PG8_SA(0, 0), a2, voffA);
            PG8_BAR; PG8_WAIT_L(0); PG8_MMA(1, 0, At, B0); PG8_BAR; PG8_SCHED;
            PG8_STAGE(PG8_SB(0, 1), b2 + hstep, voffB);
            PG8_WAIT_V(6); PG8_BAR; PG8_MMA(1, 1, At, B1); PG8_BAR;
            PG8_LDB(B0, 1, 0); PG8_SCHED; PG8_LDA(At, 1, 0); PG8_STAGE(PG8_SA(0, 1), a2 + hstep, voffA);
            PG8_WAIT_L(8); PG8_BAR; PG8_WAIT_L(0); PG8_MMA(0, 0, At, B0); PG8_BAR; PG8_SCHED;
            PG8_LDB(B1, 1, 1); PG8_STAGE(PG8_SB(1, 0), b3, voffB);
            PG8_BAR; PG8_WAIT_L(0); PG8_MMA(0, 1, At, B1); PG8_BAR;
            PG8_LDA(At, 1, 1); PG8_STAGE(PG8_SA(1, 0), a3, voffA);
            PG8_BAR; PG8_WAIT_L(0); PG8_MMA(1, 0, At, B0); PG8_BAR; PG8_SCHED;
            PG8_STAGE(PG8_SB(1, 1), b3 + hstep, voffB);
            PG8_WAIT_V(6); PG8_BAR; PG8_MMA(1, 1, At, B1); PG8_BAR;
            }
        }
        if constexpr (ALIGN_EPI) { if (wr == 0) PG8_BAR; }
        if constexpr (!Epi::AFTER_DRAIN) { E(acc, cur, wr, wc, fr, fq); S.done(cur); }
        if (!has_next) break;
#pragma unroll
        for (int a = 0; a < 2; ++a)
#pragma unroll
            for (int b = 0; b < 2; ++b)
#pragma unroll
                for (int m = 0; m < 4; ++m)
#pragma unroll
                    for (int n = 0; n < 2; ++n) acc[a][b][m][n] = (f32x4){0.f, 0.f, 0.f, 0.f};
        cur = nxt; cA = nA; cB = nB; ++ui;
        if constexpr (ALIGN_EPI) { if (wr == 1) PG8_BAR; }
    }
    PG8_WAIT_V(0);
    if constexpr (!ALIGN_EPI) { if (wr == 0) PG8_BAR; }
    PG8_BAR;
    if constexpr (Epi::AFTER_DRAIN) { E.fused(acc, cur, wr, wc, fr, fq, lds, wid, lane); S.done(cur); }
#undef PG8_SA
#undef PG8_SB
#undef PG8_STAGE
#undef PG8_LDA
#undef PG8_LDB
#undef PG8_MMA
#undef PG8_WAIT_V
#undef PG8_WAIT_L
#undef PG8_BAR
#undef PG8_SCHED
}
}
namespace att {
using bf16 = __hip_bfloat16;
typedef short bf16x8 __attribute__((ext_vector_type(8)));
typedef short s16x4 __attribute__((ext_vector_type(4)));
typedef float f32x16 __attribute__((ext_vector_type(16)));
typedef float f32x4 __attribute__((ext_vector_type(4)));
typedef unsigned u32x4 __attribute__((ext_vector_type(4)));
template <class A, class Bt> struct same_t { static constexpr bool v = false; };
template <class A> struct same_t<A, A> { static constexpr bool v = true; };
constexpr int D = 128, PIN = 6144, POUT = 2048;
constexpr float THR = 8.f;
constexpr bool WSKIP = false;
constexpr float SCALE = 0.08838834764831845f;
constexpr int NW = 8, QBLK = 32, KVBLK = 64, QB = NW * QBLK;
constexpr int SHM_V = KVBLK * D * 2, SHM_K = KVBLK * D * 2;
constexpr int LDS_BYTES = 2 * SHM_V + 2 * SHM_K + NW * 64 * 4;
#define KSWZ(row, colB) ((row) * 256 + ((colB) ^ (((row) & 7) << 4)))
#define SBAR() __builtin_amdgcn_sched_barrier(0)
__device__ __forceinline__ int v_st(int k, int c) { const int kk = (k & ~0xC) | ((k & 4) << 1) | ((k & 8) >> 1); return ((kk >> 3) * 4 + (c >> 5)) * 512 + ((kk & 7) * 32 + (c & 31)) * 2; }
__device__ __forceinline__ int v_rd_base(int lane) { return ((lane & 3) << 3) | (((lane >> 2) & 3) << 6) | (((lane >> 4) & 1) << 5) | (((lane >> 5) & 1) << 8); }
constexpr int v_rd_off(int d0, int ks, int half) { return d0 * 512 + ks * 4096 + half * 2048; }
__device__ __forceinline__ int crow(int r, int hi) { return (r & 3) + 8 * (r >> 2) + 4 * hi; }
__device__ __forceinline__ unsigned cvtpk(float lo, float hi) {
    unsigned r; asm volatile("v_cvt_pk_bf16_f32 %0, %1, %2" : "=v"(r) : "v"(lo), "v"(hi)); return r;
}
__device__ __forceinline__ bf16x8 pack8(f32x4 a, f32x4 b) {
    u32x4 w = {cvtpk(a[0], a[1]), cvtpk(a[2], a[3]), cvtpk(b[0], b[1]), cvtpk(b[2], b[3])};
    return *reinterpret_cast<bf16x8*>(&w);
}
template <class T> __device__ __forceinline__ bf16x8 load8(const T* p) {
    if constexpr (same_t<T, float>::v) { return pack8(*(const f32x4*)p, *(const f32x4*)(p + 4)); }
    else { return *reinterpret_cast<const bf16x8*>(p); }
}
__device__ __forceinline__ void mask_tile(f32x16& p0, f32x16& p1, int dq, unsigned W) {
    const float NEG = -__builtin_inff();
#pragma unroll
    for (int r = 0; r < 16; ++r) {
        const int c = (r & 3) + 8 * (r >> 2);
        if ((unsigned)(dq - c) >= W) p0[r] = NEG;
        if ((unsigned)(dq - c - 32) >= W) p1[r] = NEG;
    }
}
__device__ __forceinline__ void bitmask_tile(f32x16& p0, f32x16& p1, unsigned mw) {
    const float NEG = -__builtin_inff();
#pragma unroll
    for (int r = 0; r < 16; ++r) {
        if (!((mw >> r) & 1u)) p0[r] = NEG;
        if (!((mw >> (16 + r)) & 1u)) p1[r] = NEG;
    }
}
__device__ __forceinline__ void partialSM(f32x16& p0, f32x16& p1, float& m_reg, float& mn, float& alpha) {
    float pmax = p0[0]; for (int r = 1; r < 16; ++r) pmax = fmaxf(pmax, p0[r]); for (int r = 0; r < 16; ++r) pmax = fmaxf(pmax, p1[r]);
    { auto rr = __builtin_amdgcn_permlane32_swap(__float_as_uint(pmax), __float_as_uint(pmax), false, false);
      pmax = fmaxf(__uint_as_float(rr[0]), __uint_as_float(rr[1])); }
    constexpr float C2 = 1.4426950408889634f * SCALE;
    if (__builtin_expect(__all((pmax - m_reg) * SCALE <= THR), 1)) { mn = m_reg; alpha = 1.f; }
    else { mn = fmaxf(m_reg, pmax); alpha = __builtin_amdgcn_exp2f((m_reg - mn) * C2); m_reg = mn; }
    const float mnL = -mn * C2;
    for (int r = 0; r < 16; ++r) p0[r] = fmaf(p0[r], C2, mnL); for (int r = 0; r < 16; ++r) p1[r] = fmaf(p1[r], C2, mnL);
    for (int r = 0; r < 16; ++r) p0[r] = __builtin_amdgcn_exp2f(p0[r]);
}
__device__ __forceinline__ void finishSM(f32x16& p0, f32x16& p1, float alpha, float& l_reg, bf16x8& pa0, bf16x8& pa1, bf16x8& pa2, bf16x8& pa3) {
    for (int r = 0; r < 16; ++r) p1[r] = __builtin_amdgcn_exp2f(p1[r]);
    float ps = 0; for (int r = 0; r < 16; ++r) ps += p0[r]; for (int r = 0; r < 16; ++r) ps += p1[r];
    { auto rr = __builtin_amdgcn_permlane32_swap(__float_as_uint(ps), __float_as_uint(ps), false, false);
      ps = __uint_as_float(rr[0]) + __uint_as_float(rr[1]); }
    l_reg = l_reg * alpha + ps;
#define PK4(P, B_, OUT) do { unsigned a0 = cvtpk(P[B_+0], P[B_+1]), a1 = cvtpk(P[B_+2], P[B_+3]);                          \
        unsigned b0 = cvtpk(P[B_+4], P[B_+5]), b1 = cvtpk(P[B_+6], P[B_+7]);                                             \
        auto r0 = __builtin_amdgcn_permlane32_swap(a0, b0, false, false); auto r1 = __builtin_amdgcn_permlane32_swap(a1, b1, false, false); \
        u32x4 w = {r0[0], r1[0], r0[1], r1[1]}; OUT = *reinterpret_cast<bf16x8*>(&w); } while (0)
    PK4(p0, 0, pa0); PK4(p0, 8, pa1); PK4(p1, 0, pa2); PK4(p1, 8, pa3);
#undef PK4
}
template <int KB, bool SK>
__device__ __forceinline__ void qkt(f32x16& p0, f32x16& p1, const char* K_lds, int r32, int hi, const bf16x8* qr, bool act) {
    if (SK && !act) { const float NEG = -__builtin_inff();
#pragma unroll
        for (int r = 0; r < 16; ++r) { p0[r] = NEG; p1[r] = NEG; } return; }
    p0 = f32x16{}; p1 = f32x16{};
    const char* kb[4];
#pragma unroll
    for (int dd = 0; dd < 4; ++dd) kb[dd] = K_lds + KB * SHM_K + KSWZ(r32, (dd * 16 + hi * 8) * 2);
#pragma unroll
    for (int d0 = 0; d0 < 8; ++d0) { const char* a = kb[d0 & 3] + (d0 >> 2) * 128;
        bf16x8 b0 = *reinterpret_cast<const bf16x8*>(a);
        bf16x8 b1 = *reinterpret_cast<const bf16x8*>(a + 32 * 256);
        p0 = __builtin_amdgcn_mfma_f32_32x32x16_bf16(b0, qr[d0], p0, 0, 0, 0);
        p1 = __builtin_amdgcn_mfma_f32_32x32x16_bf16(b1, qr[d0], p1, 0, 0, 0); }
}
template <int VB, bool SK>
__device__ __forceinline__ void pv_tile(f32x16* o, int vb0, bf16x8 pa0, bf16x8 pa1, bf16x8 pa2, bf16x8 pa3, bool act) {
    if (SK && !act) return;
#define TRRD(dst, off) asm volatile("ds_read_b64_tr_b16 %0, %1 offset:%2" : "=&v"(dst) : "v"(vb0), "i"(off) : "memory")
#define PV_D0(d0) do { s16x4 l0, l1, l2, l3, h0, h1, h2, h3; constexpr int b_ = VB * SHM_V + v_rd_off(d0, 0, 0);     \
        TRRD(l0, b_); TRRD(h0, b_ + 2048); TRRD(l1, b_ + 4096); TRRD(h1, b_ + 6144); TRRD(l2, b_ + 8192); TRRD(h2, b_ + 10240); TRRD(l3, b_ + 12288); TRRD(h3, b_ + 14336); \
        asm volatile("s_waitcnt lgkmcnt(0)" ::: "memory"); SBAR();                 \
        o[d0] = __builtin_amdgcn_mfma_f32_32x32x16_bf16(pa0, (bf16x8){l0[0], l0[1], l0[2], l0[3], h0[0], h0[1], h0[2], h0[3]}, o[d0], 0, 0, 0);   \
        o[d0] = __builtin_amdgcn_mfma_f32_32x32x16_bf16(pa1, (bf16x8){l1[0], l1[1], l1[2], l1[3], h1[0], h1[1], h1[2], h1[3]}, o[d0], 0, 0, 0);   \
        o[d0] = __builtin_amdgcn_mfma_f32_32x32x16_bf16(pa2, (bf16x8){l2[0], l2[1], l2[2], l2[3], h2[0], h2[1], h2[2], h2[3]}, o[d0], 0, 0, 0);   \
        o[d0] = __builtin_amdgcn_mfma_f32_32x32x16_bf16(pa3, (bf16x8){l3[0], l3[1], l3[2], l3[3], h3[0], h3[1], h3[2], h3[3]}, o[d0], 0, 0, 0); } while (0)
    PV_D0(0); PV_D0(1); PV_D0(2); PV_D0(3);
#undef PV_D0
#undef TRRD
}

template <class TIn, class TOut> struct BlockRef { const TIn* Q; const TIn* K; const TIn* V; TOut* O; const unsigned long long* M; int P0; };
template <class TIn> struct Seam {
    bf16x8 qr[8];
    bf16x8 st_v0, st_v1, st_k0, st_k1; f32x4 sf0, sf1, sf2, sf3;
    f32x4 tq[16];
};
__device__ __forceinline__ int swa_jlo(int P0, int W) { const int lowk = P0 - W + 1; return lowk > 0 ? lowk / KVBLK : 0; }
#define ROW(p, k0, rr) ((p) + (size_t)((k0) + (rr)) * PIN + sc)
#define VMW() asm volatile("s_waitcnt vmcnt(0)" ::: "memory")
#define VMWN(n) asm volatile("s_waitcnt vmcnt(%0)" :: "i"(n) : "memory")
#define SLOAD_H(Kp, Vp, k0) do { S.st_v0 = load8<TIn>(ROW(Vp, k0, sr)); S.st_v1 = load8<TIn>(ROW(Vp, k0, 32 + sr));              \
                         S.st_k0 = load8<TIn>(ROW(Kp, k0, sr)); S.st_k1 = load8<TIn>(ROW(Kp, k0, 32 + sr)); } while (0)
#define SWRITE_HK(bf) do { *(bf16x8*)(K_lds + (bf) * SHM_K + kws) = S.st_k0; *(bf16x8*)(K_lds + (bf) * SHM_K + kws + 32 * 256) = S.st_k1; } while (0)
#define SWRITE_HV(bf) do { *(bf16x8*)(V_lds + (bf) * SHM_V + vst0) = S.st_v0; *(bf16x8*)(V_lds + (bf) * SHM_V + vst1) = S.st_v1; } while (0)
#define SWRITE_H(bf) do { SWRITE_HV(bf); SWRITE_HK(bf); } while (0)
#define SLOAD_F(p, k0) do { S.sf0 = *(const f32x4*)ROW(p, k0, sr); S.sf1 = *(const f32x4*)(ROW(p, k0, sr) + 4);                \
                            S.sf2 = *(const f32x4*)ROW(p, k0, 32 + sr); S.sf3 = *(const f32x4*)(ROW(p, k0, 32 + sr) + 4); } while (0)
#define SWRITE_KF(bf) do { *(bf16x8*)(K_lds + (bf) * SHM_K + kws) = pack8(S.sf0, S.sf1); *(bf16x8*)(K_lds + (bf) * SHM_K + kws + 32 * 256) = pack8(S.sf2, S.sf3); } while (0)
#define SWRITE_VF(bf) do { *(bf16x8*)(V_lds + (bf) * SHM_V + vst0) = pack8(S.sf0, S.sf1); *(bf16x8*)(V_lds + (bf) * SHM_V + vst1) = pack8(S.sf2, S.sf3); } while (0)
template <class TIn, class TOut>
__device__ __forceinline__ void causal_swa_prime(const BlockRef<TIn, TOut>& cur, int W, char* lds, Seam<TIn>& S) {
    constexpr bool F32 = same_t<TIn, float>::v;
    const int tid = threadIdx.x, wid = __builtin_amdgcn_readfirstlane(tid >> 6), lane = tid & 63, r32 = lane & 31, hi = lane >> 5;
    const int sr = tid >> 4, sc = (tid & 15) * 8, kws = KSWZ(sr, sc * 2); char* K_lds = lds + 2 * SHM_V;
    const int kb0 = swa_jlo(cur.P0, W) * KVBLK;
    for (int d0 = 0; d0 < 8; ++d0) S.qr[d0] = load8<TIn>(cur.Q + (size_t)(wid * QBLK + r32) * PIN + d0 * 16 + hi * 8);
    if constexpr (F32) { SLOAD_F((const float*)cur.K, kb0); VMW(); SWRITE_KF(0); SBAR(); SLOAD_F((const float*)cur.V, kb0); }
    else { SLOAD_H(cur.K, cur.V, kb0); VMW(); SWRITE_HK(0); }
    __syncthreads();
}
template <class TIn, class TOut>
__device__ __forceinline__ void causal_swa_block(const BlockRef<TIn, TOut>& cur, const BlockRef<TIn, TOut>& nxt, int skv, int W, char* lds, Seam<TIn>& S) {
    constexpr bool F32 = same_t<TIn, float>::v;
    const int tid = threadIdx.x, wid = __builtin_amdgcn_readfirstlane(tid >> 6), lane = tid & 63, r32 = lane & 31, hi = lane >> 5;
    const int j_lo = swa_jlo(cur.P0, W);
    int j_hi = (cur.P0 + QB - 1) / KVBLK + 1; if (j_hi > skv / KVBLK) j_hi = skv / KVBLK;
    const int NT = j_hi - j_lo;
    const int kbn = swa_jlo(nxt.P0, W) * KVBLK;
    const unsigned* M32 = (const unsigned*)cur.M; const unsigned moff = (unsigned)((wid * QBLK + r32) * 128 + hi);
    const int qlo = cur.P0 + wid * QBLK;
    char* V_lds = lds; char* K_lds = lds + 2 * SHM_V;
    float* ws = (float*)(lds + 2 * SHM_V + 2 * SHM_K) + wid * 64; float* li_l = ws, * al_l = ws + 32;
    float m_reg = -1e30f, l_reg = 0; f32x16 o[4] = {};
    const int sr = tid >> 4, sc = (tid & 15) * 8, vst0 = v_st(sr, sc), vst1 = v_st(32 + sr, sc), kws = KSWZ(sr, sc * 2);
    const int vb0 = (int)(uintptr_t)V_lds + v_rd_base(lane);
    const TIn* Kh = cur.K; const TIn* Vh = cur.V;
#define RESC(a) do { if (__any((a) < 1.f)) { if (hi == 0) al_l[r32] = (a); asm volatile("s_waitcnt lgkmcnt(0)" ::: "memory");              \
                     for (int d_ = 0; d_ < 4; ++d_) for (int r = 0; r < 16; ++r) o[d_][r] *= al_l[crow(r, hi)]; } } while (0)
#define KBASE(t) ((j_lo + (t)) * KVBLK)
#define ACT(t) (KBASE(t) <= qlo + QBLK - 1 && KBASE(t) + KVBLK - 1 >= qlo - W + 1)
#define MASKT(P0_, P1_, t) do { bitmask_tile(P0_, P1_, mwn); } while (0)
    constexpr int NQL = F32 ? 16 : 8;
    constexpr bool SK = WSKIP && !F32;
#define SEAM_K0() do { VMWN(NQL); if constexpr (F32) { SWRITE_KF(0); SBAR(); SLOAD_F((const float*)nxt.V, kbn); } else { SWRITE_HK(0); } SBAR(); } while (0)
    f32x16 pA0, pA1, pB0, pB1; float mnA, mnB, alA, alB; bf16x8 pa0, pa1, pa2, pa3;
    if constexpr (F32) { VMW(); SWRITE_VF(0); SBAR(); } else { SWRITE_HV(0); SBAR(); }
    if (NT > 1) { if constexpr (F32) SLOAD_F((const float*)Kh, KBASE(1)); else SLOAD_H(Kh, Vh, KBASE(1)); }
    unsigned mwn = M32[moff + 2 * j_lo]; SBAR(); qkt<0, SK>(pA0, pA1, K_lds, r32, hi, S.qr, ACT(0));
    if constexpr (F32) { if (NT > 1) { VMW(); SWRITE_KF(1); SBAR(); SLOAD_F((const float*)Vh, KBASE(1)); } }
    MASKT(pA0, pA1, 0); partialSM(pA0, pA1, m_reg, mnA, alA);
    if (NT > 1) { VMW(); if constexpr (F32) { SWRITE_VF(1); SBAR(); if (NT > 2) SLOAD_F((const float*)Kh, KBASE(2)); } else SWRITE_H(1); }
    __syncthreads();
#define HALF_STEP(PX0, PX1, mnX, alX, PY0, PY1, alY, t, KB, VB, SB) do {                                                      \
        mwn = M32[moff + 2 * (j_lo + (t))]; SBAR(); qkt<KB, SK>(PX0, PX1, K_lds, r32, hi, S.qr, ACT(t));             \
        finishSM(PY0, PY1, alY, l_reg, pa0, pa1, pa2, pa3); SBAR();                                                           \
        if ((t) + 1 < NT) { if constexpr (F32) { VMW(); SWRITE_KF(SB); SBAR(); SLOAD_F((const float*)Vh, KBASE((t) + 1)); }  \
                            else { SLOAD_H(Kh, Vh, KBASE((t) + 1)); } SBAR(); }                                               \
        pv_tile<VB, SK>(o, vb0, pa0, pa1, pa2, pa3, ACT((t) - 1)); MASKT(PX0, PX1, (t)); partialSM(PX0, PX1, m_reg, mnX, alX);                                        \
        __syncthreads();                                                                                                      \
        if ((t) + 1 < NT) { VMW(); if constexpr (F32) { SWRITE_VF(SB); SBAR(); if ((t) + 2 < NT) SLOAD_F((const float*)Kh, KBASE((t) + 2)); } \
                            else { SWRITE_H(SB); } }                                                                          \
        RESC(alX); __syncthreads(); } while (0)
    for (int t = 1; t + 1 < NT; t += 2) {
        HALF_STEP(pB0, pB1, mnB, alB, pA0, pA1, alA, t, 1, 0, 0);
        HALF_STEP(pA0, pA1, mnA, alA, pB0, pB1, alB, t + 1, 0, 1, 1);
    }
    const bool even = (NT & 1) == 0;
    if (even) { mwn = M32[moff + 2 * (j_lo + NT - 1)]; SBAR(); qkt<1, SK>(pB0, pB1, K_lds, r32, hi, S.qr, ACT(NT - 1)); SBAR(); }
#define QROW(e) (nxt.Q + (size_t)(wid * QBLK + r32) * PIN + ((e) >> 1) * 16 + hi * 8 + ((e) & 1) * 4)
    if constexpr (F32) { SLOAD_F((const float*)nxt.K, kbn); SBAR();
#pragma unroll
        for (int e = 0; e < 8; ++e) S.tq[e] = *(const f32x4*)QROW(e); }
    else { SLOAD_H(nxt.K, nxt.V, kbn); SBAR();
#pragma unroll
        for (int d0 = 0; d0 < 8; ++d0) S.qr[d0] = load8<TIn>(nxt.Q + (size_t)(wid * QBLK + r32) * PIN + d0 * 16 + hi * 8); }
    SBAR();
    finishSM(pA0, pA1, alA, l_reg, pa0, pa1, pa2, pa3); SBAR();
    if constexpr (F32) {
#pragma unroll
        for (int e = 8; e < 16; ++e) S.tq[e] = *(const f32x4*)QROW(e); SBAR(); }
#undef QROW
    pv_tile<0, SK>(o, vb0, pa0, pa1, pa2, pa3, ACT(even ? NT - 2 : NT - 1));
    if (even) { MASKT(pB0, pB1, NT - 1); partialSM(pB0, pB1, m_reg, mnB, alB); __syncthreads(); RESC(alB);
        finishSM(pB0, pB1, alB, l_reg, pa0, pa1, pa2, pa3); SBAR(); pv_tile<1, SK>(o, vb0, pa0, pa1, pa2, pa3, ACT(NT - 1)); }
    SBAR(); SEAM_K0();
    if (hi == 0) li_l[r32] = l_reg; asm volatile("s_waitcnt lgkmcnt(0)" ::: "memory");
    float rli[16];
#pragma unroll
    for (int r = 0; r < 16; ++r) rli[r] = __builtin_amdgcn_rcpf(li_l[crow(r, hi)]);
    TOut* Ow = cur.O + (size_t)(wid * QBLK) * POUT;
#pragma unroll
    for (int r = 0; r < 16; ++r) { const int orow = crow(r, hi);
#pragma unroll
        for (int d0 = 0; d0 < 4; ++d0) { const float v = o[d0][r] * rli[r];
            if constexpr (same_t<TOut, float>::v) { Ow[(size_t)orow * POUT + d0 * 32 + r32] = v; }
            else { const float vn = __shfl_xor(v, 1);
                   if ((r32 & 1) == 0) *(unsigned*)(Ow + (size_t)orow * POUT + d0 * 32 + r32) = cvtpk(v, vn); } } }
    if constexpr (F32) {
#pragma unroll
        for (int d0 = 0; d0 < 8; ++d0) S.qr[d0] = pack8(S.tq[2 * d0], S.tq[2 * d0 + 1]); }
    __syncthreads();
#undef RESC
#undef KBASE
#undef ACT
#undef MASKT
#undef SEAM_K0
#undef HALF_STEP
}
#undef ROW
#undef VMW
#undef VMWN
#undef SLOAD_H
#undef SWRITE_HK
#undef SWRITE_HV
#undef SWRITE_H
#undef SLOAD_F
#undef SWRITE_KF
#undef SWRITE_VF

}
typedef GAS unsigned gu32;
#define XB_TMO      128
#define XB_XCNT(j)  (256  + 64 * (j))
#define XB_XSUB(j)  (1280 + 64 * (j))
#define XB_XGEN(j)  (2304 + 64 * (j))
#define XB_TOP      3328
#define XB_TOPGEN   3392
#define XCD_BAR_WORDS 3456
#define XB_SPIN_CAP (1u << 18)

__device__ __forceinline__ unsigned xb_ld(unsigned* p)              { return __hip_atomic_load(p, __ATOMIC_RELAXED, __HIP_MEMORY_SCOPE_AGENT); }
__device__ __forceinline__ unsigned xb_add(unsigned* p, unsigned v) { return __hip_atomic_fetch_add(p, v, __ATOMIC_RELAXED, __HIP_MEMORY_SCOPE_AGENT); }
__device__ __forceinline__ unsigned xb_xcc_id() { return (unsigned)__builtin_amdgcn_s_getreg((3 << 11) | 20) & 0xFu; }
#define XB_SPIN(cond, bar) do { unsigned _sp = 0; while (cond) { __builtin_amdgcn_s_sleep(1); \
    if ((++_sp & 255u) == 0u) { if (xb_ld(&(bar)[XB_TMO])) break; if (_sp > XB_SPIN_CAP) { atomicAdd(&(bar)[XB_TMO], 1u); break; } } } } while (0)

struct XcdBarrier {
    unsigned* bar; unsigned x;
    volatile LAS unsigned* st;
};

__device__ __forceinline__ XcdBarrier xcd_barrier_post(unsigned* bar, volatile LAS unsigned* st) {
    XcdBarrier b; b.bar = bar; b.x = xb_xcc_id(); b.st = st;
    if (threadIdx.x == 0) (void)xb_add(&bar[XB_XCNT(b.x)], 1u);
    return b;
}
__device__ __forceinline__ void xcd_barrier_complete(unsigned* bar, unsigned x, unsigned& nloc, unsigned& nx) {
    const unsigned G = gridDim.x * gridDim.y * gridDim.z;
    unsigned sum, cnt, mine, sp = 0u;
    for (;;) {
        sum = 0u; cnt = 0u; mine = 0u;
#pragma unroll
        for (unsigned j = 0; j < 16; ++j) { const unsigned c = xb_ld(&bar[XB_XCNT(j)]); sum += c; cnt += (c > 0u) ? 1u : 0u; mine = (j == x) ? c : mine; }
        if (sum == G) break;
        __builtin_amdgcn_s_sleep(1);
        if ((++sp & 255u) == 0u) { if (xb_ld(&bar[XB_TMO])) break; if (sp > XB_SPIN_CAP) { atomicAdd(&bar[XB_TMO], 1u); break; } }
    }
    nloc = mine > 0u ? mine : 1u; nx = cnt > 0u ? cnt : 1u;
}

__device__ __forceinline__ void xcd_barrier(const XcdBarrier& b) {
    asm volatile("s_waitcnt vmcnt(0)" ::: "memory");
    __syncthreads();
    if (threadIdx.x == 0) {
        unsigned* bar = b.bar;
        __builtin_amdgcn_s_waitcnt(0);
        unsigned nloc = b.st[0], nx = b.st[1];
        if (nloc == 0u) { xcd_barrier_complete(bar, b.x, nloc, nx); b.st[0] = nloc; b.st[1] = nx; }
        const unsigned old = xb_add(&bar[XB_XSUB(b.x)], 1u);
        const unsigned gen = old / nloc;
        if (old + 1u == (gen + 1u) * nloc) {
            __builtin_amdgcn_fence(__ATOMIC_RELEASE, "agent");
            asm volatile("s_waitcnt vmcnt(0)" ::: "memory");
            const unsigned og = xb_add(&bar[XB_TOP], 1u);
            const unsigned tg = og / nx;
            if (og + 1u == (tg + 1u) * nx) xb_add(&bar[XB_TOPGEN], 1u);
            else XB_SPIN(xb_ld(&bar[XB_TOPGEN]) == tg, bar);
            __builtin_amdgcn_fence(__ATOMIC_ACQUIRE, "agent");
            xb_add(&bar[XB_XGEN(b.x)], 1u);
            asm volatile("s_waitcnt vmcnt(0)" ::: "memory");
        } else {
            XB_SPIN(xb_ld(&bar[XB_XGEN(b.x)]) == gen, bar);
            __builtin_amdgcn_fence(__ATOMIC_ACQUIRE, "agent");
            asm volatile("s_waitcnt vmcnt(0)" ::: "memory");
        }
    }
    __syncthreads();
}

constexpr int LDS_BYTES = 147456;
constexpr int MISC_OFF = LDS_BYTES - 256;
constexpr int NWAVES = 8;

struct Args { const void* in[23]; float* out; unsigned char* ws; int ph_lo, ph_hi; };
enum { I_X = 0, I_C, I_POS, I_WADA, I_BADA, I_WIN, I_CONVW, I_CONVB, I_WRGA, I_BRGA, I_WRGX, I_BRGX, I_LAM, I_KIDXG, I_WOUT, I_LN1G, I_LN1B, I_WPQ, I_SUBK, I_PU, I_PV, I_LN2G, I_LN2B };

struct Ctx { LAS unsigned char* lds; unsigned char* ws; int tid, lane, wave, bid, G, gw, ngw; };

__device__ __forceinline__ f32x4 mfma16(bf16x8 a, bf16x8 b, f32x4 c) { return __builtin_amdgcn_mfma_f32_16x16x32_bf16(a, b, c, 0, 0, 0); }
__device__ __forceinline__ f32x16 mfma32(bf16x8 a, bf16x8 b, f32x16 c) { return __builtin_amdgcn_mfma_f32_32x32x16_bf16(a, b, c, 0, 0, 0); }

__device__ __forceinline__ void transpose_item(const float* W, int K, int N, bf16* WT, LAS float* scr, int item, int lane) {
    const int nblk = (N + 31) / 32, kb = item / nblk, nb = item % nblk, k0 = 64 * kb, n0 = 32 * nb;
    const int nc = n0 + (lane & 31); const bool okc = nc < N;
#pragma unroll 8
    for (int i = 0; i < 32; ++i) { const int kk = 2 * i + (lane >> 5); scr[kk * 33 + (lane & 31)] = okc ? W[(size_t)(k0 + kk) * N + nc] : 0.f; }
    LDS_WAIT(); asm volatile("" ::: "memory");
    const int c = lane & 7;
#pragma unroll
    for (int j = 0; j < 4; ++j) { const int n = (lane >> 3) + 8 * j; const LAS float* s = scr + (8 * c) * 33 + n;
        v4u o; o.x = pk2(s[0 * 33], s[1 * 33]); o.y = pk2(s[2 * 33], s[3 * 33]); o.z = pk2(s[4 * 33], s[5 * 33]); o.w = pk2(s[6 * 33], s[7 * 33]);
        if (n0 + n < N) *(v4u*)(WT + (size_t)(n0 + n) * K + k0 + 8 * c) = o; }
    LDS_WAIT(); asm volatile("" ::: "memory");
}
__device__ __forceinline__ void convert_stream(const float* src, bf16* dst, size_t n, int gw, int ngw, int lane) {
    const size_t niter = n / 512;
#pragma unroll 4
    for (size_t i = gw; i < niter; i += ngw) { const size_t e = i * 512 + (size_t)lane * 8;
        const f32x4 a = *(const f32x4*)(src + e), b = *(const f32x4*)(src + e + 4);
        v4u o; o.x = pk2(a.x, a.y); o.y = pk2(a.z, a.w); o.z = pk2(b.x, b.y); o.w = pk2(b.z, b.w);
        *(v4u*)(dst + e) = o; }
}
__device__ __forceinline__ unsigned fp6_code(float v) {
    const float a = fabsf(v);
    const float q = a < 2.0f ? 8.0f * a : (a < 4.0f ? 4.0f * a + 8.0f : 2.0f * a + 16.0f);
    unsigned cde = (unsigned)(int)rintf(q); cde = cde > 31u ? 31u : cde;
    return cde | ((__builtin_bit_cast(unsigned, v) >> 31) << 5);
}
constexpr int FP6_ROWB = 1536;
__device__ __forceinline__ void convert_rows_fp6(const float* src, unsigned char* dst, float* inv_scale, int gw, int ngw, int lane) {
    for (int row = gw; row < NEXP; row += ngw) {
        f32x4 v[2][4]; float mx = 0.f;
#pragma unroll
        for (int cc = 0; cc < 2; ++cc)
#pragma unroll
            for (int w = 0; w < 4; ++w) { v[cc][w] = *(const f32x4*)(src + (size_t)row * DM + 1024 * cc + 16 * lane + 4 * w);
                mx = fmaxf(mx, fmaxf(fmaxf(fabsf(v[cc][w].x), fabsf(v[cc][w].y)), fmaxf(fabsf(v[cc][w].z), fabsf(v[cc][w].w)))); }
#pragma unroll
        for (int o = 1; o < 64; o <<= 1) mx = fmaxf(mx, __shfl_xor(mx, o));
        const float sc = mx > 0.f ? 7.5f / mx : 1.0f;
        if (lane == 0) inv_scale[row] = mx > 0.f ? mx * (1.0f / 7.5f) : 1.0f;
        unsigned long long lo = 0ull, mid = 0ull, hi = 0ull;
#pragma unroll
        for (int i = 0; i < 32; ++i) { const unsigned long long cde = fp6_code(v[i >> 4][(i >> 2) & 3][i & 3] * sc); const int bit = 6 * i;
            if (bit < 64) { lo |= cde << bit; if (bit + 6 > 64) mid |= cde >> (64 - bit); }
            else if (bit < 128) { mid |= cde << (bit - 64); if (bit + 6 > 128) hi |= cde >> (128 - bit); }
            else hi |= cde << (bit - 128); }
        v4u pa; pa.x = (unsigned)lo; pa.y = (unsigned)(lo >> 32); pa.z = (unsigned)mid; pa.w = (unsigned)(mid >> 32);
        v2u pb; pb.x = (unsigned)hi; pb.y = (unsigned)(hi >> 32);
        *(v4u*)(dst + (size_t)row * FP6_ROWB + 16 * lane) = pa; *(v2u*)(dst + (size_t)row * FP6_ROWB + 1024 + 8 * lane) = pb;
    }
}
__device__ __forceinline__ void p0_prologue(const Ctx& c, const Args& a) {
    const int tid = c.tid, lane = c.lane, gw = c.gw, ngw = c.ngw;
    LAS float* sl = (LAS float*)(c.lds + 8 * 8448);
    { const float* cc = (const float*)a.in[I_C];
      for (int i = tid; i < 2 * DM; i += 512) { const float v = cc[i]; sl[i] = v / (1.0f + __expf(-v)); } }
    __syncthreads();
    { const float* W = (const float*)a.in[I_WADA]; float* MODP = (float*)(c.ws + WS_MODP); LAS float* red = (LAS float*)(c.lds + 8 * 8448 + 16384);
      for (int it = c.bid; it < 48 * 4; it += c.G) { const int cg = it % 48, kq = it / 48, col = cg * 256 + lane * 4, k0 = kq * 512 + c.wave * 64;
          f32x4 a0 = {0.f, 0.f, 0.f, 0.f}, a1 = {0.f, 0.f, 0.f, 0.f};
#pragma unroll 16
          for (int kk = 0; kk < 64; ++kk) { const f32x4 w = *(const f32x4*)(W + (size_t)(k0 + kk) * (6 * DM) + col); const float s0 = sl[k0 + kk], s1 = sl[DM + k0 + kk]; a0 += w * s0; a1 += w * s1; }
          *(LAS f32x4*)(red + (c.wave * 2 + 0) * 256 + lane * 4) = a0; *(LAS f32x4*)(red + (c.wave * 2 + 1) * 256 + lane * 4) = a1;
          __syncthreads();
          { const int b = tid >> 8, cc = tid & 255; float s = 0.f;
#pragma unroll
            for (int w = 0; w < 8; ++w) s += red[(w * 2 + b) * 256 + cc];
            MODP[((size_t)kq * 2 + b) * (6 * DM) + cg * 256 + cc] = s; }
          __syncthreads(); } }
    LAS float* scr = (LAS float*)(c.lds + c.wave * 8448);
    { constexpr int I_IN = (DM / 64) * ((DIN + 31) / 32), I_SQ = (DM / 64) * (DM / 32), I_G = 8 * 2 * 4;
      for (int it = gw; it < I_IN + 2 * I_SQ + 2 * I_G; it += ngw) { int r = it;
          if (r < I_IN) { transpose_item((const float*)a.in[I_WIN], DM, DIN, (bf16*)(c.ws + WS_WIN), scr, r, lane); continue; } r -= I_IN;
          if (r < I_SQ) { transpose_item((const float*)a.in[I_WOUT], DM, DM, (bf16*)(c.ws + WS_WOUT), scr, r, lane); continue; } r -= I_SQ;
          if (r < I_SQ) { transpose_item((const float*)a.in[I_WPQ], DM, DM, (bf16*)(c.ws + WS_WPQ), scr, r, lane); continue; } r -= I_SQ;
          if (r < I_G) { const int n = r / 8; transpose_item((const float*)a.in[I_WRGA] + n * 16384, 128, 128, (bf16*)(c.ws + WS_WRG) + n * 16384, scr, r % 8, lane); continue; } r -= I_G;
          { const int n = r / 8; transpose_item((const float*)a.in[I_WRGX] + n * 16384, 128, 128, (bf16*)(c.ws + WS_WRG) + (8 + n) * 16384, scr, r % 8, lane); } } }
    convert_stream((const float*)a.in[I_SUBK], (bf16*)(c.ws + WS_SUBK), (size_t)8 * 2 * 128 * 128, gw, ngw, lane);
    convert_rows_fp6((const float*)a.in[I_PU], c.ws + WS_PU, (float*)(c.ws + WS_PUS), gw, ngw, lane);
    convert_rows_fp6((const float*)a.in[I_PV], c.ws + WS_PV, (float*)(c.ws + WS_PVS), gw, ngw, lane);
    __syncthreads();
}

__device__ __forceinline__ void p1_u1(const Ctx& c, const Args& a) {
    const int tid = c.tid, lane = c.lane;
    const float* MODP = (const float*)(c.ws + WS_MODP); const float* bada = (const float*)a.in[I_BADA]; float* MODF = (float*)(c.ws + WS_MODF);
    { const int g = c.bid * 512 + tid;
      for (int e = g; e < 2 * 6 * DM; e += c.G * 512) { const int b = e / (6 * DM), j = e % (6 * DM); MODF[e] = bada[j] + ((MODP[((size_t)0 * 2 + b) * (6 * DM) + j] + MODP[((size_t)1 * 2 + b) * (6 * DM) + j]) + (MODP[((size_t)2 * 2 + b) * (6 * DM) + j] + MODP[((size_t)3 * 2 + b) * (6 * DM) + j])); }
      const int* pos = (const int*)a.in[I_POS]; float* CS = (float*)(c.ws + WS_ROPE);
      for (int i = g; i < NTOK * 24; i += c.G * 512) { const int tk = i / 24, j = i % 24;
          const float ex = j < 16 ? -(float)j / 16.0f : -(float)(j - 16) / 8.0f;
          const float inv = exp2f(ex * 18.931568569324174f);
          const float ang = (float)pos[tk] * inv;
          double rev = (double)ang * 0.15915494309189535; rev -= floor(rev);
          if (rev > 0.5) rev -= 1.0;
          const float rr = (float)(rev * 6.283185307179586);
          float sn, cs; sincosf(rr, &sn, &cs);
          if (j < 16) { CS[tk * 48 + j] = cs; CS[tk * 48 + 16 + j] = sn; } else { CS[tk * 48 + 32 + (j - 16)] = cs; CS[tk * 48 + 40 + (j - 16)] = sn; } } }
    LAS float* ms = (LAS float*)c.lds;
    for (int i = tid; i < 2 * 2 * DM; i += 512) { const int b = i / (2 * DM), j = i % (2 * DM); ms[i] = bada[j] + ((MODP[((size_t)0 * 2 + b) * (6 * DM) + j] + MODP[((size_t)1 * 2 + b) * (6 * DM) + j]) + (MODP[((size_t)2 * 2 + b) * (6 * DM) + j] + MODP[((size_t)3 * 2 + b) * (6 * DM) + j])); }
    __syncthreads();
    const float* x = (const float*)a.in[I_X]; bf16* U1 = (bf16*)(c.ws + WS_U1);
    for (int row = c.gw; row < NTOK; row += c.ngw) { const int b = row / SEQ;
        const f32x4* xr = (const f32x4*)(x + (size_t)row * DM) + lane;
        f32x4 v[8]; float s = 0.f;
#pragma unroll
        for (int j = 0; j < 8; ++j) { v[j] = xr[64 * j]; s += (v[j].x + v[j].y) + (v[j].z + v[j].w); }
        const float mean = wave_sum(s) * (1.f / DM); float s2 = 0.f;
#pragma unroll
        for (int j = 0; j < 8; ++j) { v[j] = v[j] - mean; s2 += (v[j].x * v[j].x + v[j].y * v[j].y) + (v[j].z * v[j].z + v[j].w * v[j].w); }
        const float rstd = 1.f / sqrtf(wave_sum(s2) * (1.f / DM) + LN_EPS);
#pragma unroll
        for (int j = 0; j < 8; ++j) { const int col = 4 * lane + 256 * j;
            const f32x4 sh = *(const LAS f32x4*)(ms + b * 4096 + col), sc = *(const LAS f32x4*)(ms + b * 4096 + DM + col);
            const f32x4 y = v[j] * rstd * (sc + 1.0f) + sh;
            v2u o; o.x = pk2(y.x, y.y); o.y = pk2(y.z, y.w);
            *(v2u*)(U1 + (size_t)row * DM + col) = o; }
    }
    __syncthreads();
}

__device__ __forceinline__ void p3_post(const Ctx& c, const Args& a) {
    const int tid = c.tid, lane = c.lane, wave = c.wave, fr = lane & 15, fq = lane >> 4;
    bf16* PROJ = (bf16*)(c.ws + WS_PROJ); const bf16* U1 = (const bf16*)(c.ws + WS_U1); const bf16* WinT = (const bf16*)(c.ws + WS_WIN);
    for (int it = c.bid; it < NTOK / 32; it += c.G) {
        const int t0 = it * 32, b = t0 / SEQ;
        LAS float* red = (LAS float*)c.lds;
        LAS float* kw = red + 8 * 32 * 80;
        { f32x4 acc[2][5];
#pragma unroll
          for (int m = 0; m < 2; ++m)
#pragma unroll
              for (int n = 0; n < 5; ++n) acc[m][n] = (f32x4){0.f, 0.f, 0.f, 0.f};
          for (int ks = 0; ks < 8; ++ks) { const int kb = wave * 256 + ks * 32 + 8 * fq;
              const bf16x8 a0 = *(const bf16x8*)(U1 + (size_t)(t0 + fr) * DM + kb), a1 = *(const bf16x8*)(U1 + (size_t)(t0 + 16 + fr) * DM + kb);
#pragma unroll
              for (int n = 0; n < 5; ++n) { const bf16x8 bb = *(const bf16x8*)(WinT + (size_t)(NMAIN + 16 * n + fr) * DM + kb);
                  acc[0][n] = mfma16(a0, bb, acc[0][n]); acc[1][n] = mfma16(a1, bb, acc[1][n]); } }
#pragma unroll
          for (int m = 0; m < 2; ++m)
#pragma unroll
              for (int n = 0; n < 5; ++n)
#pragma unroll
                  for (int r = 0; r < 4; ++r) red[(wave * 32 + 16 * m + 4 * fq + r) * 80 + 16 * n + fr] = acc[m][n][r]; }
        __syncthreads();
        for (int i = tid; i < 32 * 80; i += 512) { float s = 0.f;
#pragma unroll
            for (int w = 0; w < 8; ++w) s += red[w * 2560 + i];
            kw[i] = s; }
        __syncthreads();
        { const float* kg = (const float*)a.in[I_KIDXG]; const float* CS = (const float*)(c.ws + WS_ROPE);
#pragma unroll
          for (int i4 = 0; i4 < 4; ++i4) { const int tk = wave * 4 + i4, tok = t0 + tk;
              const float v = kw[tk * 80 + lane]; const float mean = wave_sum(v) * (1.f / 64.f); const float dv = v - mean;
              const float rstd = 1.f / sqrtf(wave_sum(dv * dv) * (1.f / 64.f) + LN_EPS);
              float y = dv * rstd * kg[lane]; const float py = __shfl_xor(y, 8);
              if (lane < 16) { const float cs = CS[(size_t)tok * 48 + 32 + (lane & 7)], sn = CS[(size_t)tok * 48 + 40 + (lane & 7)]; y = lane < 8 ? y * cs - py * sn : y * cs + py * sn; }
              ((bf16*)(c.ws + WS_KIDX))[(size_t)tok * 64 + lane] = (bf16)f2bf(y);
              if (lane < 16) ((float*)(c.ws + WS_WIDX))[(size_t)tok * 16 + lane] = kw[tk * 80 + 64 + lane] * (0.25f * 0.125f); } }
        __syncthreads();
        { const int n = wave; LAS float* xcs = (LAS float*)c.lds + wave * (32 * 132);
          const float* convw = (const float*)a.in[I_CONVW]; const float* convb = (const float*)a.in[I_CONVB]; const bf16* WRG = (const bf16*)(c.ws + WS_WRG);
          const float* brga = (const float*)a.in[I_BRGA]; const float* brgx = (const float*)a.in[I_BRGX]; const float* lam = (const float*)a.in[I_LAM];
          float* AG = (float*)(c.ws + WS_AG); float* BG = (float*)(c.ws + WS_BG);
#pragma unroll 1
          for (int m = 0; m < 2; ++m) { const int tk = 16 * m + fr, tok = t0 + tk;
              f32x4 accA[8], accX[8];
#pragma unroll
              for (int nt = 0; nt < 8; ++nt) { accA[nt] = (f32x4){0.f, 0.f, 0.f, 0.f}; accX[nt] = (f32x4){0.f, 0.f, 0.f, 0.f}; }
#pragma unroll 1
              for (int ks = 0; ks < 4; ++ks) { int fq8 = 8 * fq; asm volatile("" : "+v"(fq8));
                  const int chl = ks * 32 + fq8, ch = n * 128 + chl;
                  f32x4 x0 = *(const f32x4*)(convb + ch), x1 = *(const f32x4*)(convb + ch + 4);
#pragma unroll
                  for (int j = 0; j < 4; ++j) { const int tt = tok - 3 + j;
                      if (tt >= b * SEQ) { const v4u raw = *(const v4u*)(PROJ + (size_t)tt * NMAIN + C_XL + ch);
                          const f32x4 w0 = *(const f32x4*)(convw + j * D_LRU + ch), w1 = *(const f32x4*)(convw + j * D_LRU + ch + 4);
                          x0.x += w0.x * bflo(raw.x); x0.y += w0.y * bfhi(raw.x); x0.z += w0.z * bflo(raw.y); x0.w += w0.w * bfhi(raw.y);
                          x1.x += w1.x * bflo(raw.z); x1.y += w1.y * bfhi(raw.z); x1.z += w1.z * bflo(raw.w); x1.w += w1.w * bfhi(raw.w); } }
                  *(LAS f32x4*)(xcs + tk * 132 + chl) = x0; *(LAS f32x4*)(xcs + tk * 132 + chl + 4) = x1;
                  v4u o; o.x = pk2(x0.x, x0.y); o.y = pk2(x0.z, x0.w); o.z = pk2(x1.x, x1.y); o.w = pk2(x1.z, x1.w);
                  const bf16x8 af = __builtin_bit_cast(bf16x8, o);
#pragma unroll
                  for (int nt = 0; nt < 8; ++nt) { const size_t wo = ((size_t)n * 128 + 16 * nt + fr) * 128 + ks * 32 + fq8;
                      const bf16x8 ba = *(const bf16x8*)(WRG + wo), bx = *(const bf16x8*)(WRG + (size_t)8 * 16384 + wo);
                      accA[nt] = mfma16(af, ba, accA[nt]); accX[nt] = mfma16(af, bx, accX[nt]); } }
              LDS_WAIT(); asm volatile("" ::: "memory");
#pragma unroll
              for (int nt = 0; nt < 8; ++nt) { const int chl = 16 * nt + fr, ch = n * 128 + chl;
                  const float ba_ = brga[ch], bx_ = brgx[ch], sp = log1pf(__expf(-lam[ch]));
#pragma unroll
                  for (int r = 0; r < 4; ++r) { const int tk2 = 16 * m + 4 * fq + r;
                      const float ra = sigmoidf_(accA[nt][r] + ba_), ix = sigmoidf_(accX[nt][r] + bx_);
                      const float la = -8.0f * ra * sp, av = __expf(la), bc = sqrtf(-expm1f(2.0f * la)), xv = xcs[tk2 * 132 + chl];
                      AG[(size_t)(t0 + tk2) * D_LRU + ch] = av; BG[(size_t)(t0 + tk2) * D_LRU + ch] = bc * ix * xv; } } } }
        __syncthreads();
    }
}

__device__ __forceinline__ void p4_lru_scan(const Ctx& c) {
    float* AG = (float*)(c.ws + WS_AG); float* BG = (float*)(c.ws + WS_BG); float* AGG = (float*)(c.ws + WS_AGG);
    for (int li = c.gw; li < 2048; li += c.ngw) { const int b = li >> 10, ck = (li >> 4) & 63, ch = (li & 15) * 64 + c.lane; const size_t base = ((size_t)b * SEQ + ck * 64) * D_LRU + ch;
        float h = 0.f, P = 1.f;
        for (int t8 = 0; t8 < 64; t8 += 8) { float av[8], bv[8];
#pragma unroll
            for (int t = 0; t < 8; ++t) { av[t] = AG[base + (size_t)(t8 + t) * D_LRU]; bv[t] = BG[base + (size_t)(t8 + t) * D_LRU]; }
#pragma unroll
            for (int t = 0; t < 8; ++t) { h = av[t] * h + bv[t]; P *= av[t]; av[t] = P; bv[t] = h; }
#pragma unroll
            for (int t = 0; t < 8; ++t) { AG[base + (size_t)(t8 + t) * D_LRU] = av[t]; BG[base + (size_t)(t8 + t) * D_LRU] = bv[t]; } }
        AGG[((size_t)(0 * 2 + b) * 64 + ck) * D_LRU + ch] = P; AGG[((size_t)(1 * 2 + b) * 64 + ck) * D_LRU + ch] = h; }
}

constexpr int IDX_ROWB = 144;
constexpr int IDX_TILE = 256, IDX_BUFB = IDX_TILE * IDX_ROWB;
__device__ __forceinline__ void p4_indexer_item(const Ctx& c, int b, int q0) {
    const int tid = c.tid, lane = c.lane, wave = c.wave, r32 = lane & 31, hh = lane >> 5;
    const bf16* PROJ = (const bf16*)(c.ws + WS_PROJ); const bf16* KIDX = (const bf16*)(c.ws + WS_KIDX); const float* WIDX = (const float*)(c.ws + WS_WIDX);
    const int n = 64 * (q0 / 64 + 1), ntile = (n + IDX_TILE - 1) / IDX_TILE, nj = n / 32;
    const int tokA = b * SEQ + q0 + 2 * wave, myq = tokA + ((r32 >> 2) & 1), myh = (r32 & 3) + 4 * (r32 >> 3);
    bf16x8 af[4];
#pragma unroll
    for (int s = 0; s < 4; ++s) af[s] = *(const bf16x8*)(PROJ + (size_t)myq * NMAIN + C_QI + myh * 64 + 16 * s + 8 * hh);
    float wv[16];
#pragma unroll
    for (int r = 0; r < 16; ++r) wv[r] = WIDX[(size_t)(tokA + hh) * 16 + r];
    const int skey = tid >> 1, shalf = tid & 1;
    const bf16* kbase = KIDX + (size_t)b * SEQ * 64;
    v4u st[4];
    auto stage_load = [&](int tile) { int key = tile * IDX_TILE + skey; key = key < SEQ ? key : SEQ - 1;
#pragma unroll
        for (int q = 0; q < 4; ++q) st[q] = *(const v4u*)(kbase + (size_t)key * 64 + shalf * 32 + 8 * q); };
    auto stage_write = [&](int buf) {
#pragma unroll
        for (int q = 0; q < 4; ++q) *(LAS v4u*)(c.lds + buf * IDX_BUFB + skey * IDX_ROWB + shalf * 64 + 16 * q) = st[q]; };
    unsigned key_[128];
    for (int srep = 0; srep < NREP(42); ++srep) {
    stage_load(0); stage_write(0); __syncthreads();
#pragma unroll
    for (int tile = 0; tile < 16; ++tile) {
        if (tile < ntile) {
            if (tile + 1 < ntile) stage_load(tile + 1);
            const LAS unsigned char* kb = c.lds + (tile & 1) * IDX_BUFB + r32 * IDX_ROWB + hh * 16;
#pragma unroll
            for (int jj = 0; jj < 8; ++jj) { const int j = tile * 8 + jj;
                if (j < nj) {
                    f32x16 acc = {};
#pragma unroll
                    for (int s = 0; s < 4; ++s) { const bf16x8 bb = *(const LAS bf16x8*)(kb + jj * 32 * IDX_ROWB + s * 32); acc = mfma32(af[s], bb, acc); }
                    float sc = 0.f;
#pragma unroll
                    for (int r = 0; r < 16; ++r) sc += wv[r] * fmaxf(acc[r], 0.f);
                    const unsigned u = __builtin_bit_cast(unsigned, sc);
                    key_[j] = (u & 0x80000000u) ? ~u : (u | 0x80000000u);
                } else key_[j] = 0u; }
            if (tile + 1 < ntile) stage_write((tile + 1) & 1);
            __syncthreads();
        } else {
#pragma unroll
            for (int jj = 0; jj < 8; ++jj) key_[tile * 8 + jj] = 0u;
        }
    } }
    unsigned prefix = 0u;
    for (int brep = 0; brep < NREP(41); ++brep) { prefix = 0u;
    for (int bit = 31; bit >= 0; --bit) { const unsigned cand = prefix | (1u << bit); int cnt = 0;
#pragma unroll
        for (int g = 0; g < 8; ++g) if (g * 16 < nj) {
#pragma unroll
            for (int jj = 0; jj < 16; ++jj) cnt += (key_[g * 16 + jj] >= cand) ? 1 : 0; }
#pragma unroll
        for (int o = 1; o < 32; o <<= 1) cnt += __shfl_xor(cnt, o);
        if (cnt >= 256) prefix = cand; } }
    unsigned wA0 = 0u, wA1 = 0u, wB0 = 0u, wB1 = 0u;
#define CMP16(x_) (((x_) & 0xFu) | (((x_) >> 4) & 0xF0u) | (((x_) >> 8) & 0xF00u) | (((x_) >> 12) & 0xF000u))
    const unsigned thr = prefix > 1u ? prefix : 1u;
#pragma unroll
    for (int g = 0; g < 8; ++g) if (g * 16 < nj) {
#pragma unroll
    for (int jj = 0; jj < 16; ++jj) { const int j = g * 16 + jj; const unsigned long long m = __ballot(key_[j] >= thr);
        const unsigned ma = (unsigned)m, mb = (unsigned)(m >> 32);
        const unsigned a0 = CMP16(ma) << (16 * (j & 1)), a1 = CMP16(ma >> 4) << (16 * (j & 1)), b0 = CMP16(mb) << (16 * (j & 1)), b1 = CMP16(mb >> 4) << (16 * (j & 1));
        const int idx = 2 * (j >> 1);
        if (idx < 64) { if (lane == idx) { wA0 |= a0; wB0 |= b0; } if (lane == idx + 1) { wA0 |= a1; wB0 |= b1; } }
        else { if (lane == idx - 64) { wA1 |= a0; wB1 |= b0; } if (lane == idx - 63) { wA1 |= a1; wB1 |= b1; } } } }
#undef CMP16
    unsigned* MASK = (unsigned*)(c.ws + WS_MASK);
    MASK[(size_t)tokA * 128 + lane] = wA0; MASK[(size_t)tokA * 128 + 64 + lane] = wA1;
    MASK[(size_t)(tokA + 1) * 128 + lane] = wB0; MASK[(size_t)(tokA + 1) * 128 + 64 + lane] = wB1;
    __syncthreads();
}
__device__ __forceinline__ void p4_indexer(const Ctx& c) {
    for (int w = c.bid; w < 256; w += c.G) { const int b = w & 1, p = w >> 1;
        p4_indexer_item(c, b, 16 * p); p4_indexer_item(c, b, 16 * (255 - p)); }
}

__device__ __forceinline__ void p5_lru_apply(const Ctx& c) {
    const float* AG = (const float*)(c.ws + WS_AG); const float* BG = (const float*)(c.ws + WS_BG); const float* AGG = (const float*)(c.ws + WS_AGG);
    const bf16* PROJ = (const bf16*)(c.ws + WS_PROJ); bf16* YMIX = (bf16*)(c.ws + WS_YMIX);
    for (int li = c.gw; li < 2048; li += c.ngw) { const int b = li >> 10, ck = (li >> 4) & 63, ch = (li & 15) * 64 + c.lane; const size_t tok0 = (size_t)b * SEQ + ck * 64;
        float hc = 0.f;
        for (int cc = 0; cc < ck; ++cc) hc = AGG[((size_t)(0 * 2 + b) * 64 + cc) * D_LRU + ch] * hc + AGG[((size_t)(1 * 2 + b) * 64 + cc) * D_LRU + ch];
#pragma unroll 8
        for (int t = 0; t < 64; ++t) { const size_t tok = tok0 + t; const float h = BG[tok * D_LRU + ch] + AG[tok * D_LRU + ch] * hc;
            const float gl = bf2f(PROJ[tok * NMAIN + C_GL + ch]);
            YMIX[tok * DM + ch] = (bf16)f2bf(h * gelu_tanh(gl)); } }
}
__device__ __forceinline__ void p5_attention(const Ctx& c) {
    typedef att::bf16 abf;
    const abf* PROJ = (const abf*)(c.ws + WS_PROJ); abf* YMIX = (abf*)(c.ws + WS_YMIX); const unsigned long long* MASK = (const unsigned long long*)(c.ws + WS_MASK);
    for (int w = c.bid; w < 256; w += c.G) {
        const int xcd = w & 7, slot = w >> 3, bh = xcd * 2 + (slot >> 4), x = 15 - (slot & 15), b = bh >> 3, h = bh & 7;
        att::BlockRef<abf, abf> cur;
        const size_t tokb = (size_t)b * SEQ, tok0 = tokb + (size_t)x * 256;
        cur.Q = PROJ + tok0 * NMAIN + C_Q + h * 128; cur.K = PROJ + tokb * NMAIN + C_K + h * 128; cur.V = PROJ + tokb * NMAIN + C_V + h * 128;
        cur.O = YMIX + tok0 * DM + D_LRU + h * 128; cur.M = MASK + tok0 * 64; cur.P0 = x * 256;
        att::Seam<abf> S;
        att::causal_swa_prime<abf, abf>(cur, 1 << 30, (char*)c.lds, S);
        att::causal_swa_block<abf, abf>(cur, cur, SEQ, 1 << 30, (char*)c.lds, S);
        VM_WAIT(); __syncthreads();
    }
}

__device__ __forceinline__ void p7_rows(const Ctx& c, const Args& a) {
    const int lane = c.lane;
    float* X1 = (float*)(c.ws + WS_X1); bf16* U2 = (bf16*)(c.ws + WS_U2); const float* MODF = (const float*)(c.ws + WS_MODF);
    const float* g1 = (const float*)a.in[I_LN1G]; const float* b1 = (const float*)a.in[I_LN1B];
    for (int row = c.gw; row < NTOK; row += c.ngw) { const int b = row / SEQ;
        f32x4* xr = (f32x4*)(X1 + (size_t)row * DM) + lane;
        f32x4 v[8]; float s = 0.f;
#pragma unroll
        for (int j = 0; j < 8; ++j) { v[j] = xr[64 * j]; s += (v[j].x + v[j].y) + (v[j].z + v[j].w); }
        float mean = wave_sum(s) * (1.f / DM), s2 = 0.f;
#pragma unroll
        for (int j = 0; j < 8; ++j) { v[j] = v[j] - mean; s2 += (v[j].x * v[j].x + v[j].y * v[j].y) + (v[j].z * v[j].z + v[j].w * v[j].w); }
        float rstd = 1.f / sqrtf(wave_sum(s2) * (1.f / DM) + LN_EPS);
        s = 0.f;
#pragma unroll
        for (int j = 0; j < 8; ++j) { const int col = 4 * lane + 256 * j;
            v[j] = v[j] * rstd * *(const f32x4*)(g1 + col) + *(const f32x4*)(b1 + col);
            xr[64 * j] = v[j]; s += (v[j].x + v[j].y) + (v[j].z + v[j].w); }
        mean = wave_sum(s) * (1.f / DM); s2 = 0.f;
#pragma unroll
        for (int j = 0; j < 8; ++j) { v[j] = v[j] - mean; s2 += (v[j].x * v[j].x + v[j].y * v[j].y) + (v[j].z * v[j].z + v[j].w * v[j].w); }
        rstd = 1.f / sqrtf(wave_sum(s2) * (1.f / DM) + LN_EPS);
#pragma unroll
        for (int j = 0; j < 8; ++j) { const int col = 4 * lane + 256 * j;
            const f32x4 sh = *(const f32x4*)(MODF + (size_t)b * (6 * DM) + 3 * DM + col), sc = *(const f32x4*)(MODF + (size_t)b * (6 * DM) + 4 * DM + col);
            const f32x4 y = v[j] * rstd * (sc + 1.0f) + sh;
            v2u o; o.x = pk2(y.x, y.y); o.y = pk2(y.z, y.w);
            *(v2u*)(U2 + (size_t)row * DM + col) = o; }
    }
}

__device__ __forceinline__ unsigned f2key(float f) { const unsigned u = __builtin_bit_cast(unsigned, f); return u ^ ((unsigned)((int)u >> 31) | 0x80000000u); }
__device__ __forceinline__ float key2f(unsigned k) { const unsigned u = (k & 0x80000000u) ? (k ^ 0x80000000u) : ~k; return __builtin_bit_cast(float, u); }
#define INSK(k_, T) do { _Pragma("unroll") for (int q_ = 0; q_ < 16; ++q_) { const unsigned t_ = T[q_]; const unsigned mx_ = t_ > k_ ? t_ : k_; const unsigned mn_ = t_ > k_ ? k_ : t_; T[q_] = mx_; k_ = mn_; } } while (0)
__device__ __forceinline__ float wave_sum_u(float v) {
    v += __builtin_bit_cast(float, __builtin_amdgcn_mov_dpp(__builtin_bit_cast(int, v), 0xB1, 0xf, 0xf, true));
    v += __builtin_bit_cast(float, __builtin_amdgcn_mov_dpp(__builtin_bit_cast(int, v), 0x4E, 0xf, 0xf, true));
    v += __builtin_bit_cast(float, __builtin_amdgcn_mov_dpp(__builtin_bit_cast(int, v), 0x141, 0xf, 0xf, true));
    v += __builtin_bit_cast(float, __builtin_amdgcn_mov_dpp(__builtin_bit_cast(int, v), 0x140, 0xf, 0xf, true));
    const int iv = __builtin_bit_cast(int, v);
    return (__builtin_bit_cast(float, __builtin_amdgcn_readlane(iv, 0)) + __builtin_bit_cast(float, __builtin_amdgcn_readlane(iv, 16)))
         + (__builtin_bit_cast(float, __builtin_amdgcn_readlane(iv, 32)) + __builtin_bit_cast(float, __builtin_amdgcn_readlane(iv, 48)));
}
__device__ __forceinline__ float dot2bf(unsigned a, unsigned b, float c) {
    c = fmaf(bflo(a), bflo(b), c); return fmaf(bfhi(a), bfhi(b), c);
}
__device__ __forceinline__ void p9_peer(const Ctx& c, const Args& a) {
    const int lane = c.lane, wave = c.wave, fr = lane & 15, fq = lane >> 4;
    const bf16* QP = (const bf16*)(c.ws + WS_QP); const bf16* SUBK = (const bf16*)(c.ws + WS_SUBK); const bf16* U2 = (const bf16*)(c.ws + WS_U2);
    const unsigned char* PU8 = c.ws + WS_PU; const unsigned char* PV8 = c.ws + WS_PV; const float* PUS = (const float*)(c.ws + WS_PUS); const float* PVS = (const float*)(c.ws + WS_PVS); const float* X1 = (const float*)(c.ws + WS_X1);
    const float* MODF = (const float*)(c.ws + WS_MODF); const float* g2 = (const float*)a.in[I_LN2G]; const float* b2 = (const float*)a.in[I_LN2B];
    int* EIDX = (int*)(c.ws + WS_U1); float* PGW = (float*)(c.ws + WS_U1 + 4 * MiB);
    for (int it = c.bid; it < NTOK / 32; it += c.G) {
        const int t0 = it * 32;
#ifndef P9_NOROUTE
        for (int rrep = 0; rrep < NREP(91); ++rrep)
        { LAS float* sb = (LAS float*)c.lds + wave * (32 * 129); const int h = wave;
#pragma unroll 1
          for (int m = 0; m < 2; ++m) {
              int fq8 = 8 * fq, frl = fr; asm volatile("" : "+v"(fq8), "+v"(frl));
              { f32x4 acc[2][8];
#pragma unroll
                for (int p = 0; p < 2; ++p)
#pragma unroll
                    for (int nt = 0; nt < 8; ++nt) acc[p][nt] = (f32x4){0.f, 0.f, 0.f, 0.f};
#pragma unroll
                for (int p = 0; p < 2; ++p)
#pragma unroll
                    for (int ks = 0; ks < 4; ++ks) { const bf16x8 av = *(const bf16x8*)(QP + (size_t)(t0 + 16 * m + frl) * DM + h * 256 + p * 128 + ks * 32 + fq8);
#pragma unroll
                        for (int nt = 0; nt < 8; ++nt) { const bf16x8 bv = *(const bf16x8*)(SUBK + ((size_t)(h * 2 + p) * 128 + 16 * nt + frl) * 128 + ks * 32 + fq8);
                            acc[p][nt] = mfma16(av, bv, acc[p][nt]); } }
#pragma unroll
                for (int p = 0; p < 2; ++p)
#pragma unroll
                    for (int nt = 0; nt < 8; ++nt)
#pragma unroll
                        for (int r = 0; r < 4; ++r) sb[(p * 16 + 4 * fq + r) * 129 + 16 * nt + fr] = acc[p][nt][r]; }
              LDS_WAIT(); asm volatile("" ::: "memory");
              unsigned T[16];
#pragma unroll
              for (int q = 0; q < 16; ++q) T[q] = 0u;
              { const int half = lane >> 5; const LAS float* row = sb + (lane & 31) * 129 + half * 64;
#pragma unroll 4
                for (int k = 0; k < 64; ++k) { unsigned key = (f2key(row[k]) & 0xFFFFFF80u) | (unsigned)(127 - (half * 64 + k)); INSK(key, T); } }
              { unsigned P[16];
#pragma unroll
                for (int q = 0; q < 16; ++q) P[q] = (unsigned)__shfl_xor((int)T[q], 32);
#pragma unroll
                for (int q = 0; q < 16; ++q) { unsigned key = P[q]; INSK(key, T); } }
              unsigned T2[16];
#pragma unroll
              for (int q = 0; q < 16; ++q) T2[q] = (unsigned)__shfl((int)T[q], (lane & 15) + 16);
              LDS_WAIT(); asm volatile("" ::: "memory");
              LAS int* ib = (LAS int*)sb;
              if (lane < 16) {
#pragma unroll
                  for (int q = 0; q < 16; ++q) { ib[lane * 33 + q] = 127 - (int)(T[q] & 0x7Fu); ib[lane * 33 + 16 + q] = 127 - (int)(T2[q] & 0x7Fu); } }
              float f1[16], f2[16];
#pragma unroll
              for (int q = 0; q < 16; ++q) { f1[q] = key2f(T[q] & 0xFFFFFF80u); f2[q] = key2f(T2[q] & 0xFFFFFF80u); }
              unsigned C[16];
#pragma unroll
              for (int q = 0; q < 16; ++q) C[q] = 0u;
#pragma unroll
              for (int a_ = 0; a_ < 16; ++a_)
#pragma unroll
                  for (int b_ = 0; b_ < 16; ++b_) if ((a_ + 1) * (b_ + 1) <= 16) { unsigned key = (f2key(f1[a_] + f2[b_]) & 0xFFFFFF00u) | (unsigned)(255 - (a_ * 16 + b_)); INSK(key, C); }
              LDS_WAIT(); asm volatile("" ::: "memory");
              if (lane < 16) {
                  const float mx = key2f(C[0] & 0xFFFFFF00u); float ev[16], sum = 0.f;
#pragma unroll
                  for (int q = 0; q < 16; ++q) { ev[q] = __expf(key2f(C[q] & 0xFFFFFF00u) - mx); sum += ev[q]; }
                  const float rs = 1.0f / sum;
#pragma unroll
                  for (int q = 0; q < 16; ++q) { const int code = 255 - (int)(C[q] & 0xFFu);
                      const int eid = ib[lane * 33 + (code >> 4)] * 128 + ib[lane * 33 + 16 + (code & 15)];
                      EIDX[(size_t)(t0 + 16 * m + lane) * 128 + h * 16 + q] = eid; PGW[(size_t)(t0 + 16 * m + lane) * 128 + h * 16 + q] = ev[q] * rs; } }
              LDS_WAIT(); asm volatile("" ::: "memory");
          } }
#endif
        VM_WAIT(); __syncthreads();
#ifndef P9_NOGATHER
        for (int grep_ = 0; grep_ < NREP(92); ++grep_)
#pragma unroll 1
        for (int i4 = 0; i4 < 4; ++i4) { const int tok = t0 + wave * 4 + i4, b = tok / SEQ;
            int l16 = 16 * lane; asm volatile("" : "+v"(l16));
            v32f uu;
#pragma unroll
            for (int cc = 0; cc < 2; ++cc)
#pragma unroll
                for (int hq = 0; hq < 2; ++hq) { const v4u r = *(const v4u*)(U2 + (size_t)tok * DM + 1024 * cc + l16 + 8 * hq); const int o = 16 * cc + 8 * hq;
                    uu[o + 0] = bflo(r.x); uu[o + 1] = bfhi(r.x); uu[o + 2] = bflo(r.y); uu[o + 3] = bfhi(r.y); uu[o + 4] = bflo(r.z); uu[o + 5] = bfhi(r.z); uu[o + 6] = bflo(r.w); uu[o + 7] = bfhi(r.w); }
            v32f acc;
#pragma unroll
            for (int i = 0; i < 32; ++i) acc[i] = 0.f;
            int l8 = l16 >> 1;
#pragma unroll 1
            for (int hf = 0; hf < 2; ++hf) {
                const int myi = EIDX[(size_t)tok * 128 + hf * 64 + lane]; const float myg = PGW[(size_t)tok * 128 + hf * 64 + lane];
                const float mysu = PUS[myi], mysv = PVS[myi];
#pragma unroll 1
                for (int e4 = 0; e4 < 64; e4 += 4) {
                    int ex[4]; float gu[4], gv[4];
#pragma unroll
                    for (int q = 0; q < 4; ++q) { ex[q] = __builtin_amdgcn_readlane(myi, e4 + q);
                        gu[q] = __builtin_bit_cast(float, __builtin_amdgcn_readlane(__builtin_bit_cast(int, mysu), e4 + q));
                        gv[q] = __builtin_bit_cast(float, __builtin_amdgcn_readlane(__builtin_bit_cast(int, myg * mysv), e4 + q)); }
                    v4u rua[4], rva[4]; v2u rub[4], rvb[4];
#pragma unroll
                    for (int q = 0; q < 4; ++q) { rua[q] = *(const v4u*)(PU8 + (size_t)ex[q] * FP6_ROWB + l16); rub[q] = *(const v2u*)(PU8 + (size_t)ex[q] * FP6_ROWB + 1024 + l8); }
                    __builtin_amdgcn_sched_barrier(0);
#pragma unroll
                    for (int q = 0; q < 4; ++q) { rva[q] = *(const v4u*)(PV8 + (size_t)ex[q] * FP6_ROWB + l16); rvb[q] = *(const v2u*)(PV8 + (size_t)ex[q] * FP6_ROWB + 1024 + l8); }
                    __builtin_amdgcn_sched_barrier(0);
                    float hk[4];
#pragma unroll
                    for (int q = 0; q < 4; ++q) { const v6u pk = {rua[q].x, rua[q].y, rua[q].z, rua[q].w, rub[q].x, rub[q].y};
                        const v32f d = __builtin_amdgcn_cvt_scalef32_pk32_f32_fp6(pk, 1.0f);
                        float s0 = 0.f, s1 = 0.f;
#pragma unroll
                        for (int i = 0; i < 32; i += 2) { s0 = fmaf(d[i], uu[i], s0); s1 = fmaf(d[i + 1], uu[i + 1], s1); }
                        hk[q] = gv[q] * gelu_tanh(wave_sum_u(s0 + s1) * gu[q]); __builtin_amdgcn_sched_barrier(0); }
                    __builtin_amdgcn_sched_barrier(0);
#pragma unroll
                    for (int q = 0; q < 4; ++q) { const v6u pk = {rva[q].x, rva[q].y, rva[q].z, rva[q].w, rvb[q].x, rvb[q].y};
                        const v32f d = __builtin_amdgcn_cvt_scalef32_pk32_f32_fp6(pk, 1.0f);
#pragma unroll
                        for (int i = 0; i < 32; ++i) acc[i] = fmaf(d[i], hk[q], acc[i]); __builtin_amdgcn_sched_barrier(0); }
                    __builtin_amdgcn_sched_barrier(0);
                } }
            float s = 0.f; f32x4 z[2][4];
#pragma unroll
            for (int cc = 0; cc < 2; ++cc)
#pragma unroll
                for (int w = 0; w < 4; ++w) { const int col = 1024 * cc + l16 + 4 * w;
                    const f32x4 xv = *(const f32x4*)(X1 + (size_t)tok * DM + col), gt = *(const f32x4*)(MODF + (size_t)b * (6 * DM) + 5 * DM + col);
                    const f32x4 yv = {acc[16 * cc + 4 * w], acc[16 * cc + 4 * w + 1], acc[16 * cc + 4 * w + 2], acc[16 * cc + 4 * w + 3]};
                    z[cc][w] = xv * DN_ALPHA + (gt + 1.0f) * yv;
                    s += (z[cc][w].x + z[cc][w].y) + (z[cc][w].z + z[cc][w].w); }
            const float mean = wave_sum_u(s) * (1.f / DM); float s2 = 0.f;
#pragma unroll
            for (int cc = 0; cc < 2; ++cc)
#pragma unroll
                for (int w = 0; w < 4; ++w) { z[cc][w] = z[cc][w] - mean; s2 += (z[cc][w].x * z[cc][w].x + z[cc][w].y * z[cc][w].y) + (z[cc][w].z * z[cc][w].z + z[cc][w].w * z[cc][w].w); }
            const float rstd = 1.f / sqrtf(wave_sum_u(s2) * (1.f / DM) + LN_EPS);
#pragma unroll
            for (int cc = 0; cc < 2; ++cc)
#pragma unroll
                for (int w = 0; w < 4; ++w) { const int col = 1024 * cc + l16 + 4 * w;
                    *(f32x4*)(a.out + (size_t)tok * DM + col) = z[cc][w] * rstd * *(const f32x4*)(g2 + col) + *(const f32x4*)(b2 + col); }
        }
#endif
        __syncthreads();
    }
}

#ifndef MK_SINGLE
#define MK_SINGLE 1
#endif
constexpr int NPHASE = 10;
constexpr int CW_BAR = 4096;

__global__ void __launch_bounds__(NWAVES * 64, 2) fwd_kernel(Args args) {
    extern __shared__ __attribute__((aligned(16))) unsigned char lds_raw[];
    Ctx c;
    c.lds = (LAS unsigned char*)lds_raw; c.ws = args.ws;
    c.tid = threadIdx.x; c.lane = c.tid & 63; c.wave = __builtin_amdgcn_readfirstlane(c.tid >> 6);
    c.bid = blockIdx.x; c.G = gridDim.x; c.gw = c.bid * NWAVES + c.wave; c.ngw = c.G * NWAVES;
    volatile LAS unsigned* MISC = (volatile LAS unsigned*)(c.lds + MISC_OFF);
    if (c.tid < 64) MISC[c.tid] = 0u;
    __syncthreads();
    const int lo = args.ph_lo, hi = args.ph_hi;
    XcdBarrier bar; bar.bar = (unsigned*)(c.ws + WS_CTL) + CW_BAR; bar.x = 0; bar.st = nullptr;
    if (hi - lo > 1) bar = xcd_barrier_post((unsigned*)(c.ws + WS_CTL) + CW_BAR, MISC + 8);
#ifdef ONLY
#define IN(k) ((k) == ONLY)
#else
#define IN(k) (lo <= (k) && (k) < hi)
#endif
#define SEAM(k) do { if (IN(k) && IN((k) + 1)) xcd_barrier(bar); } while (0)

    if (IN(0)) { for (int rep = 0; rep < NREP(0); ++rep) { p0_prologue(c, args); } } SEAM(0);
    if (IN(1)) { for (int rep = 0; rep < NREP(1); ++rep) { p1_u1(c, args); } } SEAM(1);
    if (IN(2)) {
        pg8::Gemm g{(const pg8::bf16_t*)(c.ws + WS_U1), (const pg8::bf16_t*)(c.ws + WS_WIN), NTOK, NMAIN, DM}; pg8::StaticOrder S; S.init(NTOK, NMAIN, c.G, c.bid);
        pg8::EpiProj E{(pg8::bf16_t*)(c.ws + WS_PROJ), NMAIN, (const float*)(c.ws + WS_ROPE)};
        for (int rep = 0; rep < NREP(2); ++rep) pg8::gemm_phase<pg8::EpiProj, pg8::StaticOrder, true, true>(c.lds, g, S, E);
    } SEAM(2);
    if (IN(3)) { for (int rep = 0; rep < NREP(3); ++rep) { p3_post(c, args); } } SEAM(3);
    if (IN(4)) { p4_lru_scan(c); for (int rep = 0; rep < NREP(4); ++rep) { p4_indexer(c); } } SEAM(4);
    if (IN(5)) { for (int rep = 0; rep < NREP(50); ++rep) { p5_lru_apply(c); } for (int rep = 0; rep < NREP(5); ++rep) { p5_attention(c); } } SEAM(5);
    if (IN(6)) {
        pg8::Gemm g{(const pg8::bf16_t*)(c.ws + WS_YMIX), (const pg8::bf16_t*)(c.ws + WS_WOUT), NTOK, DM, DM}; pg8::StaticOrder S; S.init(NTOK, DM, c.G, c.bid);
        pg8::EpiResF32 E{(const float*)args.in[I_X], (float*)(c.ws + WS_X1), (const float*)(c.ws + WS_MODF) + 2 * DM, DM, SEQ, 6 * DM, DN_ALPHA};
        for (int rep = 0; rep < NREP(6); ++rep) pg8::gemm_phase<pg8::EpiResF32, pg8::StaticOrder, true, true>(c.lds, g, S, E);
    } SEAM(6);
    if (IN(7)) { p7_rows(c, args); } SEAM(7);
    if (IN(8)) {
        pg8::Gemm g{(const pg8::bf16_t*)(c.ws + WS_U2), (const pg8::bf16_t*)(c.ws + WS_WPQ), NTOK, DM, DM}; pg8::StaticOrder S; S.init(NTOK, DM, c.G, c.bid);
        pg8::EpiBf16<0> E{(pg8::bf16_t*)(c.ws + WS_QP), DM, nullptr, 0, 0, 1.f};
        for (int rep = 0; rep < NREP(8); ++rep) pg8::gemm_phase<pg8::EpiBf16<0>, pg8::StaticOrder, true, true>(c.lds, g, S, E);
    } SEAM(8);
    if (IN(9)) { for (int rep = 0; rep < NREP(9); ++rep) { p9_peer(c, args); } }
#undef IN
#undef SEAM
}

extern "C" void kernel_launch(void* const* d_in, const int* in_sizes, int n_in, void* d_out, int out_size, void* d_ws, size_t ws_size, hipStream_t stream) {
    static int grid = 0;
    if (grid == 0) {
        if (n_in != 23 || in_sizes[0] != NTOK * DM || out_size != NTOK * DM || ws_size < WS_END) {
            fprintf(stderr, "kernel_launch: unexpected shapes (n_in %d, in0 %d, out %d, ws %zu); nothing launched\n", n_in, n_in > 0 ? in_sizes[0] : -1, out_size, ws_size); grid = -1; return; }
        int dev = 0, cus = 0, per_cu = 0;
        if (hipGetDevice(&dev) != hipSuccess || hipDeviceGetAttribute(&cus, hipDeviceAttributeMultiprocessorCount, dev) != hipSuccess) { grid = -1; return; }
        if (hipFuncSetAttribute((const void*)fwd_kernel, hipFuncAttributeMaxDynamicSharedMemorySize, LDS_BYTES) != hipSuccess) { fprintf(stderr, "kernel_launch: hipFuncSetAttribute failed\n"); grid = -1; return; }
        if (hipOccupancyMaxActiveBlocksPerMultiprocessor(&per_cu, (const void*)fwd_kernel, NWAVES * 64, LDS_BYTES) != hipSuccess || per_cu < 1) { fprintf(stderr, "kernel_launch: occupancy query says %d\n", per_cu); }
        (void)hipGetLastError();
        grid = cus;
    }
    if (grid < 0) return;
    (void)hipMemsetAsync((char*)d_ws + WS_CTL, 0, CTL_ZERO_BYTES, stream);
    Args a{};
    for (int i = 0; i < 23; ++i) a.in[i] = d_in[i];
    a.out = (float*)d_out; a.ws = (unsigned char*)d_ws;
#if MK_SINGLE
    a.ph_lo = 0; a.ph_hi = NPHASE;
    hipLaunchKernelGGL(fwd_kernel, dim3(grid), dim3(NWAVES * 64), LDS_BYTES, stream, a);
#else
    for (int p = 0; p < NPHASE; ++p) { a.ph_lo = p; a.ph_hi = p + 1; hipLaunchKernelGGL(fwd_kernel, dim3(grid), dim3(NWAVES * 64), LDS_BYTES, stream, a); }
#endif
}
```

```cpp
#include <hip/hip_runtime.h>
#include <hip/hip_bf16.h>
#include <cstdio>
#include <cstdint>
#include <cmath>
#ifndef REP_PHASE
#define REP_PHASE -1
#endif
#define NREP(k) ((k) == REP_PHASE ? 2 : 1)

constexpr int NB = 2, SEQ = 4096, NTOK = NB * SEQ, DM = 2048;
constexpr int D_LRU = 1024, D_ATT = 1024, NHEAD = 8, HDIM = 128, NIH = 16, IDIM = 64;
constexpr int DIN = 6224, NMAIN = 6144;
constexpr int C_XL = 0, C_GL = 1024, C_Q = 2048, C_K = 3072, C_V = 4096, C_QI = 5120, C_KI = 6144, C_WI = 6208;
constexpr int NEXP = 16384, PKD = 256, PTOPK = 16, PHEADS = 8, NKEYS = 128;
constexpr float LN_EPS = 1e-5f;
constexpr float DN_ALPHA = 1.189207115002721f;

constexpr size_t MiB = 1u << 20;
constexpr size_t WS_CTL = 0, CTL_ZERO_BYTES = 1 * MiB;
constexpr size_t WS_MODP = 1 * MiB;
constexpr size_t WS_MODF = 4 * MiB;
constexpr size_t WS_PUS = 88 * MiB, WS_PVS = 152 * MiB;
constexpr size_t WS_WRG  = 5 * MiB;
constexpr size_t WS_SUBK = 6 * MiB;
constexpr size_t WS_KIDX = 7 * MiB;
constexpr size_t WS_WIDX = 8 * MiB;
constexpr size_t WS_AGG  = 9 * MiB;
constexpr size_t WS_MASK = 10 * MiB;
constexpr size_t WS_WIN  = 14 * MiB;
constexpr size_t WS_WOUT = 40 * MiB;
constexpr size_t WS_WPQ  = 48 * MiB;
constexpr size_t WS_PU   = 56 * MiB;
constexpr size_t WS_PV   = 120 * MiB;
constexpr size_t WS_U1   = 184 * MiB;
constexpr size_t WS_PROJ = 216 * MiB;
constexpr size_t WS_AG   = 312 * MiB;
constexpr size_t WS_BG   = 344 * MiB;
constexpr size_t WS_ROPE = 376 * MiB;
constexpr size_t WS_END  = 378 * MiB;
constexpr size_t WS_MODA = 512 * 1024;
constexpr size_t WS_YMIX = WS_U1, WS_X1 = WS_PROJ, WS_U2 = WS_PROJ + 64 * MiB, WS_QP = WS_AG;

#define GAS __attribute__((address_space(1)))
#define LAS __attribute__((address_space(3)))
typedef unsigned short bf16;
typedef unsigned v4u __attribute__((ext_vector_type(4)));
typedef unsigned v2u __attribute__((ext_vector_type(2)));
typedef float f32x4 __attribute__((ext_vector_type(4)));
typedef float f32x2 __attribute__((ext_vector_type(2)));
typedef float f32x16 __attribute__((ext_vector_type(16)));
typedef short bf16x8 __attribute__((ext_vector_type(8)));
typedef short s16x4 __attribute__((ext_vector_type(4)));
typedef float v32f __attribute__((ext_vector_type(32)));
typedef unsigned v6u __attribute__((ext_vector_type(6)));
#define RLX_AGENT __ATOMIC_RELAXED, __HIP_MEMORY_SCOPE_AGENT
#define LDS_WAIT() asm volatile("s_waitcnt lgkmcnt(0)" ::: "memory")
#define VM_WAIT() asm volatile("s_waitcnt vmcnt(0)" ::: "memory")
__device__ __forceinline__ unsigned f2bf(float f) { unsigned u = __builtin_bit_cast(unsigned, f); return (u + 0x7fffu + ((u >> 16) & 1u)) >> 16; }
__device__ __forceinline__ unsigned pk2(float lo, float hi) { return f2bf(lo) | (f2bf(hi) << 16); }
__device__ __forceinline__ float bflo(unsigned w) { return __builtin_bit_cast(float, w << 16); }
__device__ __forceinline__ float bfhi(unsigned w) { return __builtin_bit_cast(float, w & 0xffff0000u); }
__device__ __forceinline__ float bf2f(bf16 h) { return __builtin_bit_cast(float, (unsigned)h << 16); }
__device__ __forceinline__ float wave_sum(float v) {
#pragma unroll
    for (int o = 1; o < 64; o <<= 1) v += __shfl_xor(v, o);
    return v;
}
__device__ __forceinline__ float sigmoidf_(float x) { return 1.0f / (1.0f + __expf(-x)); }
__device__ __forceinline__ float gelu_tanh(float x) {
    const float u = 1.5957691216057308f * (x + 0.044715f * x * x * x);
    return x / (1.0f + __expf(-u));
}
namespace pg8 {
#define PG8_LAS __attribute__((address_space(3)))
typedef unsigned short bf16_t;
typedef short bf16x8 __attribute__((ext_vector_type(8)));
typedef float f32x4 __attribute__((ext_vector_type(4)));
typedef unsigned u32x4 __attribute__((ext_vector_type(4)));
constexpr int BM = 256, BK = 64, HALF = 128, HTB = HALF * BK * 2  , STAGE_BYTES = 8 * HTB, NXCD = 8, WGM = 8;

__host__ __device__ __forceinline__ int lds_byte(int r, int c) { const int st = (r >> 4) * 2 + (c >> 5), rr = r & 15, cc = c & 31, ob = rr * 64 + cc * 2; return st * 1024 + (ob ^ (((ob >> 9) & 1) << 5)); }
__host__ __device__ __forceinline__ void stage_rc(int b, int& R, int& C) { const int st = b / 1024, sb = b % 1024, swz = sb ^ (((sb >> 9) & 1) << 5); R = (st >> 1) * 16 + swz / 64; C = (st & 1) * 32 + (swz % 64) / 2; }
__host__ __device__ __forceinline__ int perm32(int rho) { const int n = rho >> 4, i = rho & 15; return 8 * (i >> 2) + 4 * n + (i & 3); }

struct Unit { int pm, pn; };
struct Gemm { const bf16_t* A; const bf16_t* Bt; int M, N, K; };

struct StaticOrder {
    int nM, nN, nwg, G, c;
    __host__ __device__ void init(int M, int N, int G_, int c_) { nM = M / BM; nN = N / BM; nwg = nM * nN; G = G_; c = c_; }
    __host__ __device__ bool next(int i, Unit& u) const {
        const long L = (long)i * G + c; if (L >= nwg) return false;
        int wgid = (int)L; { const int q = nwg / NXCD, r = nwg % NXCD, xcd = wgid % NXCD, off = wgid / NXCD; wgid = (xcd < r ? xcd * (q + 1) : r * (q + 1) + (xcd - r) * q) + off; }
        const int nig = WGM * nN, gid = wgid / nig, fm = gid * WGM, gsz = (nM - fm) < WGM ? (nM - fm) : WGM;
        u.pm = fm + ((wgid % nig) % gsz); u.pn = (wgid % nig) / gsz; return true;
    }
    __device__ __forceinline__ void a_ready(const Unit&) const {}
    __device__ __forceinline__ void done(const Unit&) const {}
};

__device__ __forceinline__ unsigned cvt_pk_bf16(float lo, float hi) { unsigned r; asm volatile("v_cvt_pk_bf16_f32 %0, %1, %2" : "=v"(r) : "v"(lo), "v"(hi)); return r; }
typedef float f32x2 __attribute__((ext_vector_type(2)));
__device__ __forceinline__ f32x2 gelu_pk(f32x2 v) {
    const f32x2 av = __builtin_elementwise_abs(v), d = av * 0.2316418882f + 1.0f;
    f32x2 t; t.x = __builtin_amdgcn_rcpf(d.x); t.y = __builtin_amdgcn_rcpf(d.y);
    f32x2 q = t * 0.5307027145f + (-0.7265760135f); q = q * t + 0.7107068705f; q = q * t + (-0.142248368f); q = q * t + 0.127414796f; q = q * t;
    const f32x2 s = (v * v) * (-0.72134752044f);
    f32x2 e; e.x = __builtin_amdgcn_exp2f(s.x); e.y = __builtin_amdgcn_exp2f(s.y);
    const f32x2 m = v * (q * e), r = v - m;
    f32x2 o; o.x = v.x < 0.f ? m.x : r.x; o.y = v.y < 0.f ? m.y : r.y; return o;
}

template <int ACT  > struct EpiBf16 {
    static constexpr bool PERM = true, AFTER_DRAIN = false; static_assert(ACT == 0 || ACT == 1, "EpiBf16: ACT is 0 (none) or 1 (gelu_pk)");
    bf16_t* O; int ldc; const float* bias; int split_cols; size_t split_stride; float scale0;
    __device__ __forceinline__ void operator()(const f32x4 (&acc)[2][2][4][2], const Unit& u, int wr, int wc, int fr, int fq) const {
        const int row0 = u.pm * BM + wr * 64 + fr; int colt = u.pn * BM; bf16_t* base = O;
        float sc = 1.f; if (split_cols) { const int t = colt / split_cols; base += (size_t)t * split_stride; colt -= t * split_cols; if (t == 0) sc = scale0; }
        const int col0 = colt + wc * 32 + 8 * fq, bcol0 = u.pn * BM + wc * 32 + 8 * fq;
        f32x4 bv[2][2];
#pragma unroll
        for (int bj = 0; bj < 2; ++bj)
#pragma unroll
            for (int n = 0; n < 2; ++n) bv[bj][n] = bias ? *(const f32x4*)(bias + bcol0 + bj * HALF + 4 * n) : (f32x4){0.f, 0.f, 0.f, 0.f};
#pragma unroll
        for (int ai = 0; ai < 2; ++ai)
#pragma unroll
            for (int m = 0; m < 4; ++m) { bf16_t* rowp = base + (size_t)(row0 + ai * HALF + m * 16) * ldc + col0;
#pragma unroll
                for (int bj = 0; bj < 2; ++bj) { f32x4 v0 = acc[ai][bj][m][0] + bv[bj][0], v1 = acc[ai][bj][m][1] + bv[bj][1];
                    if (ACT == 1) { f32x2 a = gelu_pk((f32x2){v0[0], v0[1]}), b = gelu_pk((f32x2){v0[2], v0[3]}), c = gelu_pk((f32x2){v1[0], v1[1]}), d = gelu_pk((f32x2){v1[2], v1[3]});
                        v0 = (f32x4){a.x, a.y, b.x, b.y}; v1 = (f32x4){c.x, c.y, d.x, d.y}; }
                    v0 = v0 * sc; v1 = v1 * sc; u32x4 w; w.x = cvt_pk_bf16(v0[0], v0[1]); w.y = cvt_pk_bf16(v0[2], v0[3]); w.z = cvt_pk_bf16(v1[0], v1[1]); w.w = cvt_pk_bf16(v1[2], v1[3]);
                    *(u32x4*)(rowp + bj * HALF) = w; } }
    }
};

struct EpiProj {
    static constexpr bool PERM = true, AFTER_DRAIN = false;
    bf16_t* O; int ldc; const float* CS;
    __device__ __forceinline__ void operator()(const f32x4 (&acc)[2][2][4][2], const Unit& u, int wr, int wc, int fr, int fq) const {
        const int row0 = u.pm * BM + wr * 64 + fr, col0 = u.pn * BM + wc * 32 + 8 * fq, region = (u.pn * BM) >> 10;
        const int mode = (region == 2 || region == 3) ? (wc == 0 ? 1 : 0) : (region == 5 ? ((wc & 1) == 0 ? 2 : 0) : 0);
#pragma unroll
        for (int ai = 0; ai < 2; ++ai)
#pragma unroll
            for (int m = 0; m < 4; ++m) { const int row = row0 + ai * HALF + m * 16; bf16_t* rowp = O + (size_t)row * ldc + col0;
                f32x4 c0 = {1.f, 1.f, 1.f, 1.f}, c1 = c0, s0 = {0.f, 0.f, 0.f, 0.f}, s1 = s0;
                if (mode == 1) { const float* cs = CS + (size_t)row * 48 + 8 * (fq & 1); c0 = *(const f32x4*)cs; c1 = *(const f32x4*)(cs + 4); s0 = *(const f32x4*)(cs + 16); s1 = *(const f32x4*)(cs + 20); if (fq < 2) { s0 = -s0; s1 = -s1; } }
                if (mode == 2) { const float* cs = CS + (size_t)row * 48 + 32; if (fq < 2) { c0 = *(const f32x4*)cs; c1 = *(const f32x4*)(cs + 4); s0 = *(const f32x4*)(cs + 8); s1 = *(const f32x4*)(cs + 12); if (fq == 0) { s0 = -s0; s1 = -s1; } } }
#pragma unroll
                for (int bj = 0; bj < 2; ++bj) { f32x4 v0 = acc[ai][bj][m][0], v1 = acc[ai][bj][m][1];
                    if (mode != 0) { const int xm = mode == 1 ? 32 : 16; f32x4 o0, o1;
#pragma unroll
                        for (int e = 0; e < 4; ++e) { o0[e] = __shfl_xor(v0[e], xm); o1[e] = __shfl_xor(v1[e], xm); }
                        v0 = v0 * c0 + o0 * s0; v1 = v1 * c1 + o1 * s1; }
                    u32x4 w; w.x = cvt_pk_bf16(v0[0], v0[1]); w.y = cvt_pk_bf16(v0[2], v0[3]); w.z = cvt_pk_bf16(v1[0], v1[1]); w.w = cvt_pk_bf16(v1[2], v1[3]);
                    *(u32x4*)(rowp + bj * HALF) = w; } }
    }
};

struct EpiResF32 {
    static constexpr bool PERM = false, AFTER_DRAIN = false;
    const float* X; float* Z; const float* gate; int ldc, rows_per_batch, gstride; float alpha;
    __device__ __forceinline__ void operator()(const f32x4 (&acc)[2][2][4][2], const Unit& u, int wr, int wc, int fr, int fq) const {
        const int row0 = u.pm * BM + wr * 64 + fr, col0 = u.pn * BM + wc * 32 + 4 * fq;
        const float* gb = gate + (size_t)((u.pm * BM) / rows_per_batch) * gstride;
        f32x4 gv[2][2];
#pragma unroll
        for (int bj = 0; bj < 2; ++bj)
#pragma unroll
            for (int n = 0; n < 2; ++n) gv[bj][n] = *(const f32x4*)(gb + col0 + bj * HALF + n * 16) + 1.0f;
#pragma unroll
        for (int ai = 0; ai < 2; ++ai)
#pragma unroll
            for (int m = 0; m < 4; ++m) { const size_t off = (size_t)(row0 + ai * HALF + m * 16) * ldc + col0;
#pragma unroll
                for (int bj = 0; bj < 2; ++bj)
#pragma unroll
                    for (int n = 0; n < 2; ++n) { const f32x4 xv = *(const f32x4*)(X + off + bj * HALF + n * 16);
                        *(f32x4*)(Z + off + bj * HALF + n * 16) = xv * alpha + gv[bj][n] * acc[ai][bj][m][n]; } }
    }
};

template <class Epi, class Sched, bool ALIGN_EPI = false, bool SP2 = false>
__device__ __forceinline__ void gemm_phase(PG8_LAS unsigned char* lds, const Gemm g, const Sched& S, const Epi& E) {
    const int tid = threadIdx.x, wid = __builtin_amdgcn_readfirstlane(tid >> 6), lane = tid & 63, wr = wid >> 2, wc = wid & 3, fr = lane & 15, fq = lane >> 4;
    const int K = g.K, nt = K / BK;
    unsigned voffA[2], voffB[2];
#pragma unroll
    for (int i = 0; i < 2; ++i) { int R, C; stage_rc(tid * 16 + i * 8192, R, C); const int Rb = Epi::PERM ? ((R & ~31) + perm32(R & 31)) : R;
        voffA[i] = (unsigned)(R * K + C) * 2u; voffB[i] = (unsigned)(Rb * K + C) * 2u; }
    const size_t kstep = (size_t)(BK * 2);
    const size_t hstep = (size_t)HALF * K * 2;
    const size_t tstep = 2 * hstep;
    const unsigned ldsw = (unsigned)wid * 1024u;
    const int aoff = lds_byte(wr * 64 + fr, fq * 8), boff = lds_byte(wc * 32 + fr, fq * 8);
#define PG8_SA(b, h) (((b) * 2 + (h)) * HTB)
#define PG8_SB(b, h) ((4 + (b) * 2 + (h)) * HTB)
#define PG8_STAGE(bufoff, gbase, voff) do { _Pragma("unroll") for (int _i = 0; _i < 2; ++_i) \
        __builtin_amdgcn_global_load_lds((const unsigned*)((const char*)(gbase) + (voff)[_i]), (PG8_LAS unsigned*)(lds + (bufoff) + ldsw + _i * 8192), 16, 0, 0); } while (0)
#define PG8_LDA(dst, b, h) do { _Pragma("unroll") for (int m = 0; m < 4; ++m) _Pragma("unroll") for (int k = 0; k < 2; ++k) dst[m][k] = *(const PG8_LAS bf16x8*)(lds + PG8_SA(b, h) + aoff + m * 2048 + k * 1024); } while (0)
#define PG8_LDB(dst, b, h) do { _Pragma("unroll") for (int n = 0; n < 2; ++n) _Pragma("unroll") for (int k = 0; k < 2; ++k) dst[n][k] = *(const PG8_LAS bf16x8*)(lds + PG8_SB(b, h) + boff + n * 2048 + k * 1024); } while (0)
#define PG8_MMA(ai, bj, At, Bt) do { __builtin_amdgcn_s_setprio(1); _Pragma("unroll") for (int m = 0; m < 4; ++m) _Pragma("unroll") for (int n = 0; n < 2; ++n) _Pragma("unroll") for (int k = 0; k < 2; ++k) \
        acc[ai][bj][m][n] = __builtin_amdgcn_mfma_f32_16x16x32_bf16(Bt[n][k], At[m][k], acc[ai][bj][m][n], 0, 0, 0); __builtin_amdgcn_s_setprio(0); } while (0)
#define PG8_WAIT_V(n) asm volatile("s_waitcnt vmcnt(" #n ")" ::: "memory")
#define PG8_WAIT_L(n) asm volatile("s_waitcnt lgkmcnt(" #n ")" ::: "memory")
#define PG8_BAR __builtin_amdgcn_s_barrier()
#define PG8_SCHED __builtin_amdgcn_sched_barrier(0)
    Unit cur, nxt; int ui = 0;
    if (!S.next(0, cur)) return;
    f32x4 acc[2][2][4][2];
#pragma unroll
    for (int a = 0; a < 2; ++a)
#pragma unroll
        for (int b = 0; b < 2; ++b)
#pragma unroll
            for (int m = 0; m < 4; ++m)
#pragma unroll
                for (int n = 0; n < 2; ++n) acc[a][b][m][n] = (f32x4){0.f, 0.f, 0.f, 0.f};
    bf16x8 At[4][2], B0[2][2], B1[2][2];
    const char* cA = (const char*)g.A + (size_t)cur.pm * tstep; const char* cB = (const char*)g.Bt + (size_t)cur.pn * tstep;
    S.a_ready(cur);
    if constexpr (SP2) {
        PG8_STAGE(PG8_SB(0, 0), cB, voffB); PG8_STAGE(PG8_SB(0, 1), cB + hstep, voffB); PG8_STAGE(PG8_SA(0, 0), cA, voffA); PG8_STAGE(PG8_SA(0, 1), cA + hstep, voffA);
        if (wr == 1) PG8_BAR;
        PG8_WAIT_V(2); PG8_BAR;
        PG8_STAGE(PG8_SB(1, 0), cB + kstep, voffB); PG8_STAGE(PG8_SA(1, 0), cA + kstep, voffA); PG8_STAGE(PG8_SB(1, 1), cB + hstep + kstep, voffB);
        PG8_WAIT_V(6); PG8_BAR;
    } else {
        PG8_STAGE(PG8_SB(0, 0), cB, voffB); PG8_STAGE(PG8_SA(0, 0), cA, voffA); PG8_STAGE(PG8_SB(0, 1), cB + hstep, voffB); PG8_STAGE(PG8_SA(0, 1), cA + hstep, voffA);
        if (wr == 1) PG8_BAR;
        PG8_WAIT_V(4); PG8_BAR;
        PG8_STAGE(PG8_SB(1, 0), cB + kstep, voffB); PG8_STAGE(PG8_SA(1, 0), cA + kstep, voffA); PG8_STAGE(PG8_SB(1, 1), cB + hstep + kstep, voffB);
        PG8_WAIT_V(6); PG8_BAR;
    }
    for (;;) {
        const bool has_next = S.next(ui + 1, nxt);
        const char* nA = has_next ? (const char*)g.A + (size_t)nxt.pm * tstep : cA; const char* nB = has_next ? (const char*)g.Bt + (size_t)nxt.pn * tstep : cB;
        for (int t = 0; t < nt; t += 2) {
            const bool last = (t == nt - 2);
            const char* a1 = cA + (size_t)(t + 1) * kstep;
            const char* a2 = last ? nA : cA + (size_t)(t + 2) * kstep; const char* b2 = last ? nB : cB + (size_t)(t + 2) * kstep;
            const char* a3 = a2 + kstep; const char* b3 = b2 + kstep;
            if (last && has_next) S.a_ready(nxt);
            if constexpr (SP2) {
            PG8_LDB(B0, 0, 0); PG8_LDB(B1, 0, 1); PG8_SCHED; PG8_LDA(At, 0, 0); PG8_STAGE(PG8_SA(1, 1), a1 + hstep, voffA);
            PG8_WAIT_V(8); PG8_WAIT_L(0); PG8_BAR; PG8_MMA(0, 0, At, B0); PG8_MMA(0, 1, At, B1); PG8_BAR; PG8_SCHED;
            PG8_LDA(At, 0, 1); PG8_STAGE(PG8_SB(0, 0), b2, voffB); PG8_STAGE(PG8_SB(0, 1), b2 + hstep, voffB); PG8_STAGE(PG8_SA(0, 0), a2, voffA);
            PG8_WAIT_V(8); PG8_WAIT_L(0); PG8_BAR; PG8_MMA(1, 0, At, B0); PG8_MMA(1, 1, At, B1); PG8_BAR; PG8_SCHED;
            PG8_LDB(B0, 1, 0); PG8_LDB(B1, 1, 1); PG8_SCHED; PG8_LDA(At, 1, 0); PG8_STAGE(PG8_SA(0, 1), a2 + hstep, voffA);
            PG8_WAIT_V(8); PG8_WAIT_L(0); PG8_BAR; PG8_MMA(0, 0, At, B0); PG8_MMA(0, 1, At, B1); PG8_BAR; PG8_SCHED;
            PG8_LDA(At, 1, 1); PG8_STAGE(PG8_SB(1, 0), b3, voffB); PG8_STAGE(PG8_SB(1, 1), b3 + hstep, voffB); PG8_STAGE(PG8_SA(1, 0), a3, voffA);
            PG8_WAIT_V(8); PG8_WAIT_L(0); PG8_BAR; PG8_MMA(1, 0, At, B0); PG8_MMA(1, 1, At, B1); PG8_BAR; PG8_SCHED;
            } else {
            PG8_LDB(B0, 0, 0); PG8_SCHED; PG8_LDA(At, 0, 0); PG8_STAGE(PG8_SA(1, 1), a1 + hstep, voffA);
            PG8_WAIT_L(8); PG8_BAR; PG8_WAIT_L(0); PG8_MMA(0, 0, At, B0); PG8_BAR; PG8_SCHED;
            PG8_LDB(B1, 0, 1); PG8_STAGE(PG8_SB(0, 0), b2, voffB);
            PG8_BAR; PG8_WAIT_L(0); PG8_MMA(0, 1, At, B1); PG8_BAR;
            PG8_LDA(At, 0, 1); PG8_STAGE(PG8_SA(0, 0), a2, voffA);
            PG8_BAR; PG8_WAIT_L(0); PG8_MMA(1, 0, At, B0); PG8_BAR; PG8_SCHED;
            PG8_STAGE(PG8_SB(0, 1), b2 + hstep, voffB);
            PG8_WAIT_V(6); PG8_BAR; PG8_MMA(1, 1, At, B1); PG8_BAR;
            PG8_LDB(B0, 1, 0); PG8_SCHED; PG8_LDA(At, 1, 0); PG8_STAGE(PG8_SA(0, 1), a2 + hstep, voffA);
            PG8_WAIT_L(8); PG8_BAR; PG8_WAIT_L(0); PG8_MMA(0, 0, At, B0); PG8_BAR; PG8_SCHED;
            PG8_LDB(B1, 1, 1); PG8_STAGE(PG8_SB(1, 0), b3, voffB);
            PG8_BAR; PG8_WAIT_L(0); PG8_MMA(0, 1, At, B1); PG8_BAR;
            PG8_LDA(At, 1, 1); PG8_STAGE(PG8_SA(1, 0), a3, voffA);
            PG8_BAR; PG8_WAIT_L(0); PG8_MMA(1, 0, At, B0); PG8_BAR; PG8_SCHED;
            PG8_STAGE(PG8_SB(1, 1), b3 + hstep, voffB);
            PG8_WAIT_V(6); PG8_BAR; PG8_MMA(1, 1, At, B1); PG8_BAR;
            }
        }
        if constexpr (ALIGN_EPI) { if (wr == 0) PG8_BAR; }
        if constexpr (!Epi::AFTER_DRAIN) { E(acc, cur, wr, wc, fr, fq); S.done(cur); }
        if (!has_next) break;
#pragma unroll
        for (int a = 0; a < 2; ++a)
#pragma unroll
            for (int b = 0; b < 2; ++b)
#pragma unroll
                for (int m = 0; m < 4; ++m)
#pragma unroll
                    for (int n = 0; n < 2; ++n) acc[a][b][m][n] = (f32x4){0.f, 0.f, 0.f, 0.f};
        cur = nxt; cA = nA; cB = nB; ++ui;
        if constexpr (ALIGN_EPI) { if (wr == 1) PG8_BAR; }
    }
    PG8_WAIT_V(0);
    if constexpr (!ALIGN_EPI) { if (wr == 0) PG8_BAR; }
    PG8_BAR;
    if constexpr (Epi::AFTER_DRAIN) { E.fused(acc, cur, wr, wc, fr, fq, lds, wid, lane); S.done(cur); }
#undef PG8_SA
#undef PG8_SB
#undef PG8_STAGE
#undef PG8_LDA
#undef PG8_LDB
#undef PG8_MMA
#undef PG8_WAIT_V
#undef PG8_WAIT_L
#undef PG8_BAR
#undef PG8_SCHED
}
}
namespace att {
using bf16 = __hip_bfloat16;
typedef short bf16x8 __attribute__((ext_vector_type(8)));
typedef short s16x4 __attribute__((ext_vector_type(4)));
typedef float f32x16 __attribute__((ext_vector_type(16)));
typedef float f32x4 __attribute__((ext_vector_type(4)));
typedef unsigned u32x4 __attribute__((ext_vector_type(4)));
template <class A, class Bt> struct same_t { static constexpr bool v = false; };
template <class A> struct same_t<A, A> { static constexpr bool v = true; };
constexpr int D = 128, PIN = 6144, POUT = 2048;
constexpr float THR = 8.f;
constexpr bool WSKIP = false;
constexpr float SCALE = 0.08838834764831845f;
constexpr int NW = 8, QBLK = 32, KVBLK = 64, QB = NW * QBLK;
constexpr int SHM_V = KVBLK * D * 2, SHM_K = KVBLK * D * 2;
constexpr int LDS_BYTES = 2 * SHM_V + 2 * SHM_K + NW * 64 * 4;
#define KSWZ(row, colB) ((row) * 256 + ((colB) ^ (((row) & 7) << 4)))
#define SBAR() __builtin_amdgcn_sched_barrier(0)
__device__ __forceinline__ int v_st(int k, int c) { const int kk = (k & ~0xC) | ((k & 4) << 1) | ((k & 8) >> 1); return ((kk >> 3) * 4 + (c >> 5)) * 512 + ((kk & 7) * 32 + (c & 31)) * 2; }
__device__ __forceinline__ int v_rd_base(int lane) { return ((lane & 3) << 3) | (((lane >> 2) & 3) << 6) | (((lane >> 4) & 1) << 5) | (((lane >> 5) & 1) << 8); }
constexpr int v_rd_off(int d0, int ks, int half) { return d0 * 512 + ks * 4096 + half * 2048; }
__device__ __forceinline__ int crow(int r, int hi) { return (r & 3) + 8 * (r >> 2) + 4 * hi; }
__device__ __forceinline__ unsigned cvtpk(float lo, float hi) {
    unsigned r; asm volatile("v_cvt_pk_bf16_f32 %0, %1, %2" : "=v"(r) : "v"(lo), "v"(hi)); return r;
}
__device__ __forceinline__ bf16x8 pack8(f32x4 a, f32x4 b) {
    u32x4 w = {cvtpk(a[0], a[1]), cvtpk(a[2], a[3]), cvtpk(b[0], b[1]), cvtpk(b[2], b[3])};
    return *reinterpret_cast<bf16x8*>(&w);
}
template <class T> __device__ __forceinline__ bf16x8 load8(const T* p) {
    if constexpr (same_t<T, float>::v) { return pack8(*(const f32x4*)p, *(const f32x4*)(p + 4)); }
    else { return *reinterpret_cast<const bf16x8*>(p); }
}
__device__ __forceinline__ void mask_tile(f32x16& p0, f32x16& p1, int dq, unsigned W) {
    const float NEG = -__builtin_inff();
#pragma unroll
    for (int r = 0; r < 16; ++r) {
        const int c = (r & 3) + 8 * (r >> 2);
        if ((unsigned)(dq - c) >= W) p0[r] = NEG;
        if ((unsigned)(dq - c - 32) >= W) p1[r] = NEG;
    }
}
__device__ __forceinline__ void bitmask_tile(f32x16& p0, f32x16& p1, unsigned mw) {
    const float NEG = -__builtin_inff();
#pragma unroll
    for (int r = 0; r < 16; ++r) {
        if (!((mw >> r) & 1u)) p0[r] = NEG;
        if (!((mw >> (16 + r)) & 1u)) p1[r] = NEG;
    }
}
__device__ __forceinline__ void partialSM(f32x16& p0, f32x16& p1, float& m_reg, float& mn, float& alpha) {
    float pmax = p0[0]; for (int r = 1; r < 16; ++r) pmax = fmaxf(pmax, p0[r]); for (int r = 0; r < 16; ++r) pmax = fmaxf(pmax, p1[r]);
    { auto rr = __builtin_amdgcn_permlane32_swap(__float_as_uint(pmax), __float_as_uint(pmax), false, false);
      pmax = fmaxf(__uint_as_float(rr[0]), __uint_as_float(rr[1])); }
    constexpr float C2 = 1.4426950408889634f * SCALE;
    if (__builtin_expect(__all((pmax - m_reg) * SCALE <= THR), 1)) { mn = m_reg; alpha = 1.f; }
    else { mn = fmaxf(m_reg, pmax); alpha = __builtin_amdgcn_exp2f((m_reg - mn) * C2); m_reg = mn; }
    const float mnL = -mn * C2;
    for (int r = 0; r < 16; ++r) p0[r] = fmaf(p0[r], C2, mnL); for (int r = 0; r < 16; ++r) p1[r] = fmaf(p1[r], C2, mnL);
    for (int r = 0; r < 16; ++r) p0[r] = __builtin_amdgcn_exp2f(p0[r]);
}
__device__ __forceinline__ void finishSM(f32x16& p0, f32x16& p1, float alpha, float& l_reg, bf16x8& pa0, bf16x8& pa1, bf16x8& pa2, bf16x8& pa3) {
    for (int r = 0; r < 16; ++r) p1[r] = __builtin_amdgcn_exp2f(p1[r]);
    float ps = 0; for (int r = 0; r < 16; ++r) ps += p0[r]; for (int r = 0; r < 16; ++r) ps += p1[r];
    { auto rr = __builtin_amdgcn_permlane32_swap(__float_as_uint(ps), __float_as_uint(ps), false, false);
      ps = __uint_as_float(rr[0]) + __uint_as_float(rr[1]); }
    l_reg = l_reg * alpha + ps;
#define PK4(P, B_, OUT) do { unsigned a0 = cvtpk(P[B_+0], P[B_+1]), a1 = cvtpk(P[B_+2], P[B_+3]);                          \
        unsigned b0 = cvtpk(P[B_+4], P[B_+5]), b1 = cvtpk(P[B_+6], P[B_+7]);                                             \
        auto r0 = __builtin_amdgcn_permlane32_swap(a0, b0, false, false); auto r1 = __builtin_amdgcn_permlane32_swap(a1, b1, false, false); \
        u32x4 w = {r0[0], r1[0], r0[1], r1[1]}; OUT = *reinterpret_cast<bf16x8*>(&w); } while (0)
    PK4(p0, 0, pa0); PK4(p0, 8, pa1); PK4(p1, 0, pa2); PK4(p1, 8, pa3);
#undef PK4
}
template <int KB, bool SK>
__device__ __forceinline__ void qkt(f32x16& p0, f32x16& p1, const char* K_lds, int r32, int hi, const bf16x8* qr, bool act) {
    if (SK && !act) { const float NEG = -__builtin_inff();
#pragma unroll
        for (int r = 0; r < 16; ++r) { p0[r] = NEG; p1[r] = NEG; } return; }
    p0 = f32x16{}; p1 = f32x16{};
    const char* kb[4];
#pragma unroll
    for (int dd = 0; dd < 4; ++dd) kb[dd] = K_lds + KB * SHM_K + KSWZ(r32, (dd * 16 + hi * 8) * 2);
#pragma unroll
    for (int d0 = 0; d0 < 8; ++d0) { const char* a = kb[d0 & 3] + (d0 >> 2) * 128;
        bf16x8 b0 = *reinterpret_cast<const bf16x8*>(a);
        bf16x8 b1 = *reinterpret_cast<const bf16x8*>(a + 32 * 256);
        p0 = __builtin_amdgcn_mfma_f32_32x32x16_bf16(b0, qr[d0], p0, 0, 0, 0);
        p1 = __builtin_amdgcn_mfma_f32_32x32x16_bf16(b1, qr[d0], p1, 0, 0, 0); }
}
template <int VB, bool SK>
__device__ __forceinline__ void pv_tile(f32x16* o, int vb0, bf16x8 pa0, bf16x8 pa1, bf16x8 pa2, bf16x8 pa3, bool act) {
    if (SK && !act) return;
#define TRRD(dst, off) asm volatile("ds_read_b64_tr_b16 %0, %1 offset:%2" : "=&v"(dst) : "v"(vb0), "i"(off) : "memory")
#define PV_D0(d0) do { s16x4 l0, l1, l2, l3, h0, h1, h2, h3; constexpr int b_ = VB * SHM_V + v_rd_off(d0, 0, 0);     \
        TRRD(l0, b_); TRRD(h0, b_ + 2048); TRRD(l1, b_ + 4096); TRRD(h1, b_ + 6144); TRRD(l2, b_ + 8192); TRRD(h2, b_ + 10240); TRRD(l3, b_ + 12288); TRRD(h3, b_ + 14336); \
        asm volatile("s_waitcnt lgkmcnt(0)" ::: "memory"); SBAR();                 \
        o[d0] = __builtin_amdgcn_mfma_f32_32x32x16_bf16(pa0, (bf16x8){l0[0], l0[1], l0[2], l0[3], h0[0], h0[1], h0[2], h0[3]}, o[d0], 0, 0, 0);   \
        o[d0] = __builtin_amdgcn_mfma_f32_32x32x16_bf16(pa1, (bf16x8){l1[0], l1[1], l1[2], l1[3], h1[0], h1[1], h1[2], h1[3]}, o[d0], 0, 0, 0);   \
        o[d0] = __builtin_amdgcn_mfma_f32_32x32x16_bf16(pa2, (bf16x8){l2[0], l2[1], l2[2], l2[3], h2[0], h2[1], h2[2], h2[3]}, o[d0], 0, 0, 0);   \
        o[d0] = __builtin_amdgcn_mfma_f32_32x32x16_bf16(pa3, (bf16x8){l3[0], l3[1], l3[2], l3[3], h3[0], h3[1], h3[2], h3[3]}, o[d0], 0, 0, 0); } while (0)
    PV_D0(0); PV_D0(1); PV_D0(2); PV_D0(3);
#undef PV_D0
#undef TRRD
}

template <class TIn, class TOut> struct BlockRef { const TIn* Q; const TIn* K; const TIn* V; TOut* O; const unsigned long long* M; int P0; };
template <class TIn> struct Seam {
    bf16x8 qr[8];
    bf16x8 st_v0, st_v1, st_k0, st_k1; f32x4 sf0, sf1, sf2, sf3;
    f32x4 tq[16];
};
__device__ __forceinline__ int swa_jlo(int P0, int W) { const int lowk = P0 - W + 1; return lowk > 0 ? lowk / KVBLK : 0; }
#define ROW(p, k0, rr) ((p) + (size_t)((k0) + (rr)) * PIN + sc)
#define VMW() asm volatile("s_waitcnt vmcnt(0)" ::: "memory")
#define VMWN(n) asm volatile("s_waitcnt vmcnt(%0)" :: "i"(n) : "memory")
#define SLOAD_H(Kp, Vp, k0) do { S.st_v0 = load8<TIn>(ROW(Vp, k0, sr)); S.st_v1 = load8<TIn>(ROW(Vp, k0, 32 + sr));              \
                         S.st_k0 = load8<TIn>(ROW(Kp, k0, sr)); S.st_k1 = load8<TIn>(ROW(Kp, k0, 32 + sr)); } while (0)
#define SWRITE_HK(bf) do { *(bf16x8*)(K_lds + (bf) * SHM_K + kws) = S.st_k0; *(bf16x8*)(K_lds + (bf) * SHM_K + kws + 32 * 256) = S.st_k1; } while (0)
#define SWRITE_HV(bf) do { *(bf16x8*)(V_lds + (bf) * SHM_V + vst0) = S.st_v0; *(bf16x8*)(V_lds + (bf) * SHM_V + vst1) = S.st_v1; } while (0)
#define SWRITE_H(bf) do { SWRITE_HV(bf); SWRITE_HK(bf); } while (0)
#define SLOAD_F(p, k0) do { S.sf0 = *(const f32x4*)ROW(p, k0, sr); S.sf1 = *(const f32x4*)(ROW(p, k0, sr) + 4);                \
                            S.sf2 = *(const f32x4*)ROW(p, k0, 32 + sr); S.sf3 = *(const f32x4*)(ROW(p, k0, 32 + sr) + 4); } while (0)
#define SWRITE_KF(bf) do { *(bf16x8*)(K_lds + (bf) * SHM_K + kws) = pack8(S.sf0, S.sf1); *(bf16x8*)(K_lds + (bf) * SHM_K + kws + 32 * 256) = pack8(S.sf2, S.sf3); } while (0)
#define SWRITE_VF(bf) do { *(bf16x8*)(V_lds + (bf) * SHM_V + vst0) = pack8(S.sf0, S.sf1); *(bf16x8*)(V_lds + (bf) * SHM_V + vst1) = pack8(S.sf2, S.sf3); } while (0)
template <class TIn, class TOut>
__device__ __forceinline__ void causal_swa_prime(const BlockRef<TIn, TOut>& cur, int W, char* lds, Seam<TIn>& S) {
    constexpr bool F32 = same_t<TIn, float>::v;
    const int tid = threadIdx.x, wid = __builtin_amdgcn_readfirstlane(tid >> 6), lane = tid & 63, r32 = lane & 31, hi = lane >> 5;
    const int sr = tid >> 4, sc = (tid & 15) * 8, kws = KSWZ(sr, sc * 2); char* K_lds = lds + 2 * SHM_V;
    const int kb0 = swa_jlo(cur.P0, W) * KVBLK;
    for (int d0 = 0; d0 < 8; ++d0) S.qr[d0] = load8<TIn>(cur.Q + (size_t)(wid * QBLK + r32) * PIN + d0 * 16 + hi * 8);
    if constexpr (F32) { SLOAD_F((const float*)cur.K, kb0); VMW(); SWRITE_KF(0); SBAR(); SLOAD_F((const float*)cur.V, kb0); }
    else { SLOAD_H(cur.K, cur.V, kb0); VMW(); SWRITE_HK(0); }
    __syncthreads();
}
template <class TIn, class TOut>
__device__ __forceinline__ void causal_swa_block(const BlockRef<TIn, TOut>& cur, const BlockRef<TIn, TOut>& nxt, int skv, int W, char* lds, Seam<TIn>& S) {
    constexpr bool F32 = same_t<TIn, float>::v;
    const int tid = threadIdx.x, wid = __builtin_amdgcn_readfirstlane(tid >> 6), lane = tid & 63, r32 = lane & 31, hi = lane >> 5;
    const int j_lo = swa_jlo(cur.P0, W);
    int j_hi = (cur.P0 + QB - 1) / KVBLK + 1; if (j_hi > skv / KVBLK) j_hi = skv / KVBLK;
    const int NT = j_hi - j_lo;
    const int kbn = swa_jlo(nxt.P0, W) * KVBLK;
    const unsigned* M32 = (const unsigned*)cur.M; const unsigned moff = (unsigned)((wid * QBLK + r32) * 128 + hi);
    const int qlo = cur.P0 + wid * QBLK;
    char* V_lds = lds; char* K_lds = lds + 2 * SHM_V;
    float* ws = (float*)(lds + 2 * SHM_V + 2 * SHM_K) + wid * 64; float* li_l = ws, * al_l = ws + 32;
    float m_reg = -1e30f, l_reg = 0; f32x16 o[4] = {};
    const int sr = tid >> 4, sc = (tid & 15) * 8, vst0 = v_st(sr, sc), vst1 = v_st(32 + sr, sc), kws = KSWZ(sr, sc * 2);
    const int vb0 = (int)(uintptr_t)V_lds + v_rd_base(lane);
    const TIn* Kh = cur.K; const TIn* Vh = cur.V;
#define RESC(a) do { if (__any((a) < 1.f)) { if (hi == 0) al_l[r32] = (a); asm volatile("s_waitcnt lgkmcnt(0)" ::: "memory");              \
                     for (int d_ = 0; d_ < 4; ++d_) for (int r = 0; r < 16; ++r) o[d_][r] *= al_l[crow(r, hi)]; } } while (0)
#define KBASE(t) ((j_lo + (t)) * KVBLK)
#define ACT(t) (KBASE(t) <= qlo + QBLK - 1 && KBASE(t) + KVBLK - 1 >= qlo - W + 1)
#define MASKT(P0_, P1_, t) do { bitmask_tile(P0_, P1_, mwn); } while (0)
    constexpr int NQL = F32 ? 16 : 8;
    constexpr bool SK = WSKIP && !F32;
#define SEAM_K0() do { VMWN(NQL); if constexpr (F32) { SWRITE_KF(0); SBAR(); SLOAD_F((const float*)nxt.V, kbn); } else { SWRITE_HK(0); } SBAR(); } while (0)
    f32x16 pA0, pA1, pB0, pB1; float mnA, mnB, alA, alB; bf16x8 pa0, pa1, pa2, pa3;
    if constexpr (F32) { VMW(); SWRITE_VF(0); SBAR(); } else { SWRITE_HV(0); SBAR(); }
    if (NT > 1) { if constexpr (F32) SLOAD_F((const float*)Kh, KBASE(1)); else SLOAD_H(Kh, Vh, KBASE(1)); }
    unsigned mwn = M32[moff + 2 * j_lo]; SBAR(); qkt<0, SK>(pA0, pA1, K_lds, r32, hi, S.qr, ACT(0));
    if constexpr (F32) { if (NT > 1) { VMW(); SWRITE_KF(1); SBAR(); SLOAD_F((const float*)Vh, KBASE(1)); } }
    MASKT(pA0, pA1, 0); partialSM(pA0, pA1, m_reg, mnA, alA);
    if (NT > 1) { VMW(); if constexpr (F32) { SWRITE_VF(1); SBAR(); if (NT > 2) SLOAD_F((const float*)Kh, KBASE(2)); } else SWRITE_H(1); }
    __syncthreads();
#define HALF_STEP(PX0, PX1, mnX, alX, PY0, PY1, alY, t, KB, VB, SB) do {                                                      \
        mwn = M32[moff + 2 * (j_lo + (t))]; SBAR(); qkt<KB, SK>(PX0, PX1, K_lds, r32, hi, S.qr, ACT(t));             \
        finishSM(PY0, PY1, alY, l_reg, pa0, pa1, pa2, pa3); SBAR();                                                           \
        if ((t) + 1 < NT) { if constexpr (F32) { VMW(); SWRITE_KF(SB); SBAR(); SLOAD_F((const float*)Vh, KBASE((t) + 1)); }  \
                            else { SLOAD_H(Kh, Vh, KBASE((t) + 1)); } SBAR(); }                                               \
        pv_tile<VB, SK>(o, vb0, pa0, pa1, pa2, pa3, ACT((t) - 1)); MASKT(PX0, PX1, (t)); partialSM(PX0, PX1, m_reg, mnX, alX);                                        \
        __syncthreads();                                                                                                      \
        if ((t) + 1 < NT) { VMW(); if constexpr (F32) { SWRITE_VF(SB); SBAR(); if ((t) + 2 < NT) SLOAD_F((const float*)Kh, KBASE((t) + 2)); } \
                            else { SWRITE_H(SB); } }                                                                          \
        RESC(alX); __syncthreads(); } while (0)
    for (int t = 1; t + 1 < NT; t += 2) {
        HALF_STEP(pB0, pB1, mnB, alB, pA0, pA1, alA, t, 1, 0, 0);
        HALF_STEP(pA0, pA1, mnA, alA, pB0, pB1, alB, t + 1, 0, 1, 1);
    }
    const bool even = (NT & 1) == 0;
    if (even) { mwn = M32[moff + 2 * (j_lo + NT - 1)]; SBAR(); qkt<1, SK>(pB0, pB1, K_lds, r32, hi, S.qr, ACT(NT - 1)); SBAR(); }
#define QROW(e) (nxt.Q + (size_t)(wid * QBLK + r32) * PIN + ((e) >> 1) * 16 + hi * 8 + ((e) & 1) * 4)
    if constexpr (F32) { SLOAD_F((const float*)nxt.K, kbn); SBAR();
#pragma unroll
        for (int e = 0; e < 8; ++e) S.tq[e] = *(const f32x4*)QROW(e); }
    else { SLOAD_H(nxt.K, nxt.V, kbn); SBAR();
#pragma unroll
        for (int d0 = 0; d0 < 8; ++d0) S.qr[d0] = load8<TIn>(nxt.Q + (size_t)(wid * QBLK + r32) * PIN + d0 * 16 + hi * 8); }
    SBAR();
    finishSM(pA0, pA1, alA, l_reg, pa0, pa1, pa2, pa3); SBAR();
    if constexpr (F32) {
#pragma unroll
        for (int e = 8; e < 16; ++e) S.tq[e] = *(const f32x4*)QROW(e); SBAR(); }
#undef QROW
    pv_tile<0, SK>(o, vb0, pa0, pa1, pa2, pa3, ACT(even ? NT - 2 : NT - 1));
    if (even) { MASKT(pB0, pB1, NT - 1); partialSM(pB0, pB1, m_reg, mnB, alB); __syncthreads(); RESC(alB);
        finishSM(pB0, pB1, alB, l_reg, pa0, pa1, pa2, pa3); SBAR(); pv_tile<1, SK>(o, vb0, pa0, pa1, pa2, pa3, ACT(NT - 1)); }
    SBAR(); SEAM_K0();
    if (hi == 0) li_l[r32] = l_reg; asm volatile("s_waitcnt lgkmcnt(0)" ::: "memory");
    float rli[16];
#pragma unroll
    for (int r = 0; r < 16; ++r) rli[r] = __builtin_amdgcn_rcpf(li_l[crow(r, hi)]);
    TOut* Ow = cur.O + (size_t)(wid * QBLK) * POUT;
#pragma unroll
    for (int r = 0; r < 16; ++r) { const int orow = crow(r, hi);
#pragma unroll
        for (int d0 = 0; d0 < 4; ++d0) { const float v = o[d0][r] * rli[r];
            if constexpr (same_t<TOut, float>::v) { Ow[(size_t)orow * POUT + d0 * 32 + r32] = v; }
            else { const float vn = __shfl_xor(v, 1);
                   if ((r32 & 1) == 0) *(unsigned*)(Ow + (size_t)orow * POUT + d0 * 32 + r32) = cvtpk(v, vn); } } }
    if constexpr (F32) {
#pragma unroll
        for (int d0 = 0; d0 < 8; ++d0) S.qr[d0] = pack8(S.tq[2 * d0], S.tq[2 * d0 + 1]); }
    __syncthreads();
#undef RESC
#undef KBASE
#undef ACT
#undef MASKT
#undef SEAM_K0
#undef HALF_STEP
}
#undef ROW
#undef VMW
#undef VMWN
#undef SLOAD_H
#undef SWRITE_HK
#undef SWRITE_HV
#undef SWRITE_H
#undef SLOAD_F
#undef SWRITE_KF
#undef SWRITE_VF

}
typedef GAS unsigned gu32;
#define XB_TMO      128
#define XB_XCNT(j)  (256  + 64 * (j))
#define XB_XSUB(j)  (1280 + 64 * (j))
#define XB_XGEN(j)  (2304 + 64 * (j))
#define XB_TOP      3328
#define XB_TOPGEN   3392
#define XCD_BAR_WORDS 3456
#define XB_SPIN_CAP (1u << 18)

__device__ __forceinline__ unsigned xb_ld(unsigned* p)              { return __hip_atomic_load(p, __ATOMIC_RELAXED, __HIP_MEMORY_SCOPE_AGENT); }
__device__ __forceinline__ unsigned xb_add(unsigned* p, unsigned v) { return __hip_atomic_fetch_add(p, v, __ATOMIC_RELAXED, __HIP_MEMORY_SCOPE_AGENT); }
__device__ __forceinline__ unsigned xb_xcc_id() { return (unsigned)__builtin_amdgcn_s_getreg((3 << 11) | 20) & 0xFu; }
#define XB_SPIN(cond, bar) do { unsigned _sp = 0; while (cond) { __builtin_amdgcn_s_sleep(1); \
    if ((++_sp & 255u) == 0u) { if (xb_ld(&(bar)[XB_TMO])) break; if (_sp > XB_SPIN_CAP) { atomicAdd(&(bar)[XB_TMO], 1u); break; } } } } while (0)

struct XcdBarrier {
    unsigned* bar; unsigned x;
    volatile LAS unsigned* st;
};

__device__ __forceinline__ XcdBarrier xcd_barrier_post(unsigned* bar, volatile LAS unsigned* st) {
    XcdBarrier b; b.bar = bar; b.x = xb_xcc_id(); b.st = st;
    if (threadIdx.x == 0) (void)xb_add(&bar[XB_XCNT(b.x)], 1u);
    return b;
}
__device__ __forceinline__ void xcd_barrier_complete(unsigned* bar, unsigned x, unsigned& nloc, unsigned& nx) {
    const unsigned G = gridDim.x * gridDim.y * gridDim.z;
    unsigned sum, cnt, mine, sp = 0u;
    for (;;) {
        sum = 0u; cnt = 0u; mine = 0u;
#pragma unroll
        for (unsigned j = 0; j < 16; ++j) { const unsigned c = xb_ld(&bar[XB_XCNT(j)]); sum += c; cnt += (c > 0u) ? 1u : 0u; mine = (j == x) ? c : mine; }
        if (sum == G) break;
        __builtin_amdgcn_s_sleep(1);
        if ((++sp & 255u) == 0u) { if (xb_ld(&bar[XB_TMO])) break; if (sp > XB_SPIN_CAP) { atomicAdd(&bar[XB_TMO], 1u); break; } }
    }
    nloc = mine > 0u ? mine : 1u; nx = cnt > 0u ? cnt : 1u;
}

__device__ __forceinline__ void xcd_barrier(const XcdBarrier& b) {
    asm volatile("s_waitcnt vmcnt(0)" ::: "memory");
    __syncthreads();
    if (threadIdx.x == 0) {
        unsigned* bar = b.bar;
        __builtin_amdgcn_s_waitcnt(0);
        unsigned nloc = b.st[0], nx = b.st[1];
        if (nloc == 0u) { xcd_barrier_complete(bar, b.x, nloc, nx); b.st[0] = nloc; b.st[1] = nx; }
        const unsigned old = xb_add(&bar[XB_XSUB(b.x)], 1u);
        const unsigned gen = old / nloc;
        if (old + 1u == (gen + 1u) * nloc) {
            __builtin_amdgcn_fence(__ATOMIC_RELEASE, "agent");
            asm volatile("s_waitcnt vmcnt(0)" ::: "memory");
            const unsigned og = xb_add(&bar[XB_TOP], 1u);
            const unsigned tg = og / nx;
            if (og + 1u == (tg + 1u) * nx) xb_add(&bar[XB_TOPGEN], 1u);
            else XB_SPIN(xb_ld(&bar[XB_TOPGEN]) == tg, bar);
            __builtin_amdgcn_fence(__ATOMIC_ACQUIRE, "agent");
            xb_add(&bar[XB_XGEN(b.x)], 1u);
            asm volatile("s_waitcnt vmcnt(0)" ::: "memory");
        } else {
            XB_SPIN(xb_ld(&bar[XB_XGEN(b.x)]) == gen, bar);
            __builtin_amdgcn_fence(__ATOMIC_ACQUIRE, "agent");
            asm volatile("s_waitcnt vmcnt(0)" ::: "memory");
        }
    }
    __syncthreads();
}

constexpr int LDS_BYTES = 147456;
constexpr int MISC_OFF = LDS_BYTES - 256;
constexpr int NWAVES = 8;

struct Args { const void* in[23]; float* out; unsigned char* ws; int ph_lo, ph_hi; };
enum { I_X = 0, I_C, I_POS, I_WADA, I_BADA, I_WIN, I_CONVW, I_CONVB, I_WRGA, I_BRGA, I_WRGX, I_BRGX, I_LAM, I_KIDXG, I_WOUT, I_LN1G, I_LN1B, I_WPQ, I_SUBK, I_PU, I_PV, I_LN2G, I_LN2B };

struct Ctx { LAS unsigned char* lds; unsigned char* ws; int tid, lane, wave, bid, G, gw, ngw; };

__device__ __forceinline__ f32x4 mfma16(bf16x8 a, bf16x8 b, f32x4 c) { return __builtin_amdgcn_mfma_f32_16x16x32_bf16(a, b, c, 0, 0, 0); }
__device__ __forceinline__ f32x16 mfma32(bf16x8 a, bf16x8 b, f32x16 c) { return __builtin_amdgcn_mfma_f32_32x32x16_bf16(a, b, c, 0, 0, 0); }

__device__ __forceinline__ void transpose_item(const float* W, int K, int N, bf16* WT, LAS float* scr, int item, int lane) {
    const int nblk = (N + 31) / 32, kb = item / nblk, nb = item % nblk, k0 = 64 * kb, n0 = 32 * nb;
    const int nc = n0 + (lane & 31); const bool okc = nc < N;
#pragma unroll 8
    for (int i = 0; i < 32; ++i) { const int kk = 2 * i + (lane >> 5); scr[kk * 33 + (lane & 31)] = okc ? W[(size_t)(k0 + kk) * N + nc] : 0.f; }
    LDS_WAIT(); asm volatile("" ::: "memory");
    const int c = lane & 7;
#pragma unroll
    for (int j = 0; j < 4; ++j) { const int n = (lane >> 3) + 8 * j; const LAS float* s = scr + (8 * c) * 33 + n;
        v4u o; o.x = pk2(s[0 * 33], s[1 * 33]); o.y = pk2(s[2 * 33], s[3 * 33]); o.z = pk2(s[4 * 33], s[5 * 33]); o.w = pk2(s[6 * 33], s[7 * 33]);
        if (n0 + n < N) *(v4u*)(WT + (size_t)(n0 + n) * K + k0 + 8 * c) = o; }
    LDS_WAIT(); asm volatile("" ::: "memory");
}
__device__ __forceinline__ void convert_stream(const float* src, bf16* dst, size_t n, int gw, int ngw, int lane) {
    const size_t niter = n / 512;
#pragma unroll 4
    for (size_t i = gw; i < niter; i += ngw) { const size_t e = i * 512 + (size_t)lane * 8;
        const f32x4 a = *(const f32x4*)(src + e), b = *(const f32x4*)(src + e + 4);
        v4u o; o.x = pk2(a.x, a.y); o.y = pk2(a.z, a.w); o.z = pk2(b.x, b.y); o.w = pk2(b.z, b.w);
        *(v4u*)(dst + e) = o; }
}
__device__ __forceinline__ unsigned fp4_code(float v) {
    const float a = fabsf(v);
    const float q = a < 2.0f ? 2.0f * a : (a < 4.0f ? a + 2.0f : 0.5f * a + 4.0f);
    unsigned cde = (unsigned)(int)rintf(q); cde = cde > 7u ? 7u : cde;
    return cde | ((__builtin_bit_cast(unsigned, v) >> 31) << 3);
}
constexpr int FPQ_ROWB = 1024;
__device__ __forceinline__ void convert_rows_fpq(const float* src, unsigned char* dst, bf16* inv_scale, int gw, int ngw, int lane) {
    for (int row = gw; row < NEXP; row += ngw) {
        f32x4 v[2][4]; float mx = 0.f;
#pragma unroll
        for (int cc = 0; cc < 2; ++cc)
#pragma unroll
            for (int w = 0; w < 4; ++w) { v[cc][w] = *(const f32x4*)(src + (size_t)row * DM + 1024 * cc + 16 * lane + 4 * w);
                mx = fmaxf(mx, fmaxf(fmaxf(fabsf(v[cc][w].x), fabsf(v[cc][w].y)), fmaxf(fabsf(v[cc][w].z), fabsf(v[cc][w].w)))); }
        const unsigned sb = f2bf(mx > 0.f ? mx * (1.0f / 6.0f) : 1.0f);
        const float sc = 1.0f / bf2f((bf16)sb);
        inv_scale[(size_t)row * 64 + lane] = (bf16)sb;
        v4u pa = {0u, 0u, 0u, 0u};
#pragma unroll
        for (int i = 0; i < 32; ++i) pa[i >> 3] |= fp4_code(v[i >> 4][(i >> 2) & 3][i & 3] * sc) << (4 * (i & 7));
        *(v4u*)(dst + (size_t)row * FPQ_ROWB + 16 * lane) = pa;
    }
}
__device__ __forceinline__ void p0_prologue(const Ctx& c, const Args& a) {
    const int tid = c.tid, lane = c.lane, gw = c.gw, ngw = c.ngw;
    LAS float* sl = (LAS float*)(c.lds + 8 * 8448);
    { const float* cc = (const float*)a.in[I_C];
      for (int i = tid; i < 2 * DM; i += 512) { const float v = cc[i]; sl[i] = v / (1.0f + __expf(-v)); } }
    __syncthreads();
    { const float* W = (const float*)a.in[I_WADA]; float* MODP = (float*)(c.ws + WS_MODP); LAS float* red = (LAS float*)(c.lds + 8 * 8448 + 16384);
      for (int it = c.bid; it < 48 * 4; it += c.G) { const int cg = it % 48, kq = it / 48, col = cg * 256 + lane * 4, k0 = kq * 512 + c.wave * 64;
          f32x4 a0 = {0.f, 0.f, 0.f, 0.f}, a1 = {0.f, 0.f, 0.f, 0.f};
#pragma unroll 16
          for (int kk = 0; kk < 64; ++kk) { const f32x4 w = *(const f32x4*)(W + (size_t)(k0 + kk) * (6 * DM) + col); const float s0 = sl[k0 + kk], s1 = sl[DM + k0 + kk]; a0 += w * s0; a1 += w * s1; }
          *(LAS f32x4*)(red + (c.wave * 2 + 0) * 256 + lane * 4) = a0; *(LAS f32x4*)(red + (c.wave * 2 + 1) * 256 + lane * 4) = a1;
          __syncthreads();
          { const int b = tid >> 8, cc = tid & 255; float s = 0.f;
#pragma unroll
            for (int w = 0; w < 8; ++w) s += red[(w * 2 + b) * 256 + cc];
            MODP[((size_t)kq * 2 + b) * (6 * DM) + cg * 256 + cc] = s; }
          __syncthreads(); } }
    LAS float* scr = (LAS float*)(c.lds + c.wave * 8448);
    { constexpr int I_IN = (DM / 64) * ((DIN + 31) / 32), I_SQ = (DM / 64) * (DM / 32), I_G = 8 * 2 * 4;
      for (int it = gw; it < I_IN + 2 * I_SQ + 2 * I_G; it += ngw) { int r = it;
          if (r < I_IN) { transpose_item((const float*)a.in[I_WIN], DM, DIN, (bf16*)(c.ws + WS_WIN), scr, r, lane); continue; } r -= I_IN;
          if (r < I_SQ) { transpose_item((const float*)a.in[I_WOUT], DM, DM, (bf16*)(c.ws + WS_WOUT), scr, r, lane); continue; } r -= I_SQ;
          if (r < I_SQ) { transpose_item((const float*)a.in[I_WPQ], DM, DM, (bf16*)(c.ws + WS_WPQ), scr, r, lane); continue; } r -= I_SQ;
          if (r < I_G) { const int n = r / 8; transpose_item((const float*)a.in[I_WRGA] + n * 16384, 128, 128, (bf16*)(c.ws + WS_WRG) + n * 16384, scr, r % 8, lane); continue; } r -= I_G;
          { const int n = r / 8; transpose_item((const float*)a.in[I_WRGX] + n * 16384, 128, 128, (bf16*)(c.ws + WS_WRG) + (8 + n) * 16384, scr, r % 8, lane); } } }
    convert_stream((const float*)a.in[I_SUBK], (bf16*)(c.ws + WS_SUBK), (size_t)8 * 2 * 128 * 128, gw, ngw, lane);
    convert_rows_fpq((const float*)a.in[I_PU], c.ws + WS_PU, (bf16*)(c.ws + WS_PUS), gw, ngw, lane);
    convert_rows_fpq((const float*)a.in[I_PV], c.ws + WS_PV, (bf16*)(c.ws + WS_PVS), gw, ngw, lane);
    __syncthreads();
}

__device__ __forceinline__ void p1_u1(const Ctx& c, const Args& a) {
    const int tid = c.tid, lane = c.lane;
    const float* MODP = (const float*)(c.ws + WS_MODP); const float* bada = (const float*)a.in[I_BADA]; float* MODF = (float*)(c.ws + WS_MODF);
    { const int g = c.bid * 512 + tid;
      for (int e = g; e < 2 * 6 * DM; e += c.G * 512) { const int b = e / (6 * DM), j = e % (6 * DM); MODF[e] = bada[j] + ((MODP[((size_t)0 * 2 + b) * (6 * DM) + j] + MODP[((size_t)1 * 2 + b) * (6 * DM) + j]) + (MODP[((size_t)2 * 2 + b) * (6 * DM) + j] + MODP[((size_t)3 * 2 + b) * (6 * DM) + j])); }
      const int* pos = (const int*)a.in[I_POS]; float* CS = (float*)(c.ws + WS_ROPE);
      for (int i = g; i < NTOK * 24; i += c.G * 512) { const int tk = i / 24, j = i % 24;
          const float ex = j < 16 ? -(float)j / 16.0f : -(float)(j - 16) / 8.0f;
          const float inv = exp2f(ex * 18.931568569324174f);
          const float ang = (float)pos[tk] * inv;
          double rev = (double)ang * 0.15915494309189535; rev -= floor(rev);
          if (rev > 0.5) rev -= 1.0;
          const float rr = (float)(rev * 6.283185307179586);
          float sn, cs; sincosf(rr, &sn, &cs);
          if (j < 16) { CS[tk * 48 + j] = cs; CS[tk * 48 + 16 + j] = sn; } else { CS[tk * 48 + 32 + (j - 16)] = cs; CS[tk * 48 + 40 + (j - 16)] = sn; } } }
    LAS float* ms = (LAS float*)c.lds;
    for (int i = tid; i < 2 * 2 * DM; i += 512) { const int b = i / (2 * DM), j = i % (2 * DM); ms[i] = bada[j] + ((MODP[((size_t)0 * 2 + b) * (6 * DM) + j] + MODP[((size_t)1 * 2 + b) * (6 * DM) + j]) + (MODP[((size_t)2 * 2 + b) * (6 * DM) + j] + MODP[((size_t)3 * 2 + b) * (6 * DM) + j])); }
    __syncthreads();
    const float* x = (const float*)a.in[I_X]; bf16* U1 = (bf16*)(c.ws + WS_U1);
    for (int row = c.gw; row < NTOK; row += c.ngw) { const int b = row / SEQ;
        const f32x4* xr = (const f32x4*)(x + (size_t)row * DM) + lane;
        f32x4 v[8]; float s = 0.f;
#pragma unroll
        for (int j = 0; j < 8; ++j) { v[j] = xr[64 * j]; s += (v[j].x + v[j].y) + (v[j].z + v[j].w); }
        const float mean = wave_sum(s) * (1.f / DM); float s2 = 0.f;
#pragma unroll
        for (int j = 0; j < 8; ++j) { v[j] = v[j] - mean; s2 += (v[j].x * v[j].x + v[j].y * v[j].y) + (v[j].z * v[j].z + v[j].w * v[j].w); }
        const float rstd = 1.f / sqrtf(wave_sum(s2) * (1.f / DM) + LN_EPS);
#pragma unroll
        for (int j = 0; j < 8; ++j) { const int col = 4 * lane + 256 * j;
            const f32x4 sh = *(const LAS f32x4*)(ms + b * 4096 + col), sc = *(const LAS f32x4*)(ms + b * 4096 + DM + col);
            const f32x4 y = v[j] * rstd * (sc + 1.0f) + sh;
            v2u o; o.x = pk2(y.x, y.y); o.y = pk2(y.z, y.w);
            *(v2u*)(U1 + (size_t)row * DM + col) = o; }
    }
    __syncthreads();
}

__device__ __forceinline__ void p3_post(const Ctx& c, const Args& a) {
    const int tid = c.tid, lane = c.lane, wave = c.wave, fr = lane & 15, fq = lane >> 4;
    bf16* PROJ = (bf16*)(c.ws + WS_PROJ); const bf16* U1 = (const bf16*)(c.ws + WS_U1); const bf16* WinT = (const bf16*)(c.ws + WS_WIN);
    for (int it = c.bid; it < NTOK / 32; it += c.G) {
        const int t0 = it * 32, b = t0 / SEQ;
        LAS float* red = (LAS float*)c.lds;
        LAS float* kw = red + 8 * 32 * 80;
        { f32x4 acc[2][5];
#pragma unroll
          for (int m = 0; m < 2; ++m)
#pragma unroll
              for (int n = 0; n < 5; ++n) acc[m][n] = (f32x4){0.f, 0.f, 0.f, 0.f};
          for (int ks = 0; ks < 8; ++ks) { const int kb = wave * 256 + ks * 32 + 8 * fq;
              const bf16x8 a0 = *(const bf16x8*)(U1 + (size_t)(t0 + fr) * DM + kb), a1 = *(const bf16x8*)(U1 + (size_t)(t0 + 16 + fr) * DM + kb);
#pragma unroll
              for (int n = 0; n < 5; ++n) { const bf16x8 bb = *(const bf16x8*)(WinT + (size_t)(NMAIN + 16 * n + fr) * DM + kb);
                  acc[0][n] = mfma16(a0, bb, acc[0][n]); acc[1][n] = mfma16(a1, bb, acc[1][n]); } }
#pragma unroll
          for (int m = 0; m < 2; ++m)
#pragma unroll
              for (int n = 0; n < 5; ++n)
#pragma unroll
                  for (int r = 0; r < 4; ++r) red[(wave * 32 + 16 * m + 4 * fq + r) * 80 + 16 * n + fr] = acc[m][n][r]; }
        __syncthreads();
        for (int i = tid; i < 32 * 80; i += 512) { float s = 0.f;
#pragma unroll
            for (int w = 0; w < 8; ++w) s += red[w * 2560 + i];
            kw[i] = s; }
        __syncthreads();
        { const float* kg = (const float*)a.in[I_KIDXG]; const float* CS = (const float*)(c.ws + WS_ROPE);
#pragma unroll
          for (int i4 = 0; i4 < 4; ++i4) { const int tk = wave * 4 + i4, tok = t0 + tk;
              const float v = kw[tk * 80 + lane]; const float mean = wave_sum(v) * (1.f / 64.f); const float dv = v - mean;
              const float rstd = 1.f / sqrtf(wave_sum(dv * dv) * (1.f / 64.f) + LN_EPS);
              float y = dv * rstd * kg[lane]; const float py = __shfl_xor(y, 8);
              if (lane < 16) { const float cs = CS[(size_t)tok * 48 + 32 + (lane & 7)], sn = CS[(size_t)tok * 48 + 40 + (lane & 7)]; y = lane < 8 ? y * cs - py * sn : y * cs + py * sn; }
              ((bf16*)(c.ws + WS_KIDX))[(size_t)tok * 64 + lane] = (bf16)f2bf(y);
              if (lane < 16) ((float*)(c.ws + WS_WIDX))[(size_t)tok * 16 + lane] = kw[tk * 80 + 64 + lane] * (0.25f * 0.125f); } }
        __syncthreads();
        { const int n = wave; LAS float* xcs = (LAS float*)c.lds + wave * (32 * 132);
          const float* convw = (const float*)a.in[I_CONVW]; const float* convb = (const float*)a.in[I_CONVB]; const bf16* WRG = (const bf16*)(c.ws + WS_WRG);
          const float* brga = (const float*)a.in[I_BRGA]; const float* brgx = (const float*)a.in[I_BRGX]; const float* lam = (const float*)a.in[I_LAM];
          float* AG = (float*)(c.ws + WS_AG); float* BG = (float*)(c.ws + WS_BG);
#pragma unroll 1
          for (int m = 0; m < 2; ++m) { const int tk = 16 * m + fr, tok = t0 + tk;
              f32x4 accA[8], accX[8];
#pragma unroll
              for (int nt = 0; nt < 8; ++nt) { accA[nt] = (f32x4){0.f, 0.f, 0.f, 0.f}; accX[nt] = (f32x4){0.f, 0.f, 0.f, 0.f}; }
#pragma unroll 1
              for (int ks = 0; ks < 4; ++ks) { int fq8 = 8 * fq; asm volatile("" : "+v"(fq8));
                  const int chl = ks * 32 + fq8, ch = n * 128 + chl;
                  f32x4 x0 = *(const f32x4*)(convb + ch), x1 = *(const f32x4*)(convb + ch + 4);
#pragma unroll
                  for (int j = 0; j < 4; ++j) { const int tt = tok - 3 + j;
                      if (tt >= b * SEQ) { const v4u raw = *(const v4u*)(PROJ + (size_t)tt * NMAIN + C_XL + ch);
                          const f32x4 w0 = *(const f32x4*)(convw + j * D_LRU + ch), w1 = *(const f32x4*)(convw + j * D_LRU + ch + 4);
                          x0.x += w0.x * bflo(raw.x); x0.y += w0.y * bfhi(raw.x); x0.z += w0.z * bflo(raw.y); x0.w += w0.w * bfhi(raw.y);
                          x1.x += w1.x * bflo(raw.z); x1.y += w1.y * bfhi(raw.z); x1.z += w1.z * bflo(raw.w); x1.w += w1.w * bfhi(raw.w); } }
                  *(LAS f32x4*)(xcs + tk * 132 + chl) = x0; *(LAS f32x4*)(xcs + tk * 132 + chl + 4) = x1;
                  v4u o; o.x = pk2(x0.x, x0.y); o.y = pk2(x0.z, x0.w); o.z = pk2(x1.x, x1.y); o.w = pk2(x1.z, x1.w);
                  const bf16x8 af = __builtin_bit_cast(bf16x8, o);
#pragma unroll
                  for (int nt = 0; nt < 8; ++nt) { const size_t wo = ((size_t)n * 128 + 16 * nt + fr) * 128 + ks * 32 + fq8;
                      const bf16x8 ba = *(const bf16x8*)(WRG + wo), bx = *(const bf16x8*)(WRG + (size_t)8 * 16384 + wo);
                      accA[nt] = mfma16(af, ba, accA[nt]); accX[nt] = mfma16(af, bx, accX[nt]); } }
              LDS_WAIT(); asm volatile("" ::: "memory");
#pragma unroll
              for (int nt = 0; nt < 8; ++nt) { const int chl = 16 * nt + fr, ch = n * 128 + chl;
                  const float ba_ = brga[ch], bx_ = brgx[ch], sp = log1pf(__expf(-lam[ch]));
#pragma unroll
                  for (int r = 0; r < 4; ++r) { const int tk2 = 16 * m + 4 * fq + r;
                      const float ra = sigmoidf_(accA[nt][r] + ba_), ix = sigmoidf_(accX[nt][r] + bx_);
                      const float la = -8.0f * ra * sp, av = __expf(la), bc = sqrtf(-expm1f(2.0f * la)), xv = xcs[tk2 * 132 + chl];
                      AG[(size_t)(t0 + tk2) * D_LRU + ch] = av; BG[(size_t)(t0 + tk2) * D_LRU + ch] = bc * ix * xv; } } } }
        __syncthreads();
    }
}

__device__ __forceinline__ void p4_lru_scan(const Ctx& c) {
    float* AG = (float*)(c.ws + WS_AG); float* BG = (float*)(c.ws + WS_BG); float* AGG = (float*)(c.ws + WS_AGG);
    for (int li = c.gw; li < 2048; li += c.ngw) { const int b = li >> 10, ck = (li >> 4) & 63, ch = (li & 15) * 64 + c.lane; const size_t base = ((size_t)b * SEQ + ck * 64) * D_LRU + ch;
        float h = 0.f, P = 1.f;
        for (int t8 = 0; t8 < 64; t8 += 8) { float av[8], bv[8];
#pragma unroll
            for (int t = 0; t < 8; ++t) { av[t] = AG[base + (size_t)(t8 + t) * D_LRU]; bv[t] = BG[base + (size_t)(t8 + t) * D_LRU]; }
#pragma unroll
            for (int t = 0; t < 8; ++t) { h = av[t] * h + bv[t]; P *= av[t]; av[t] = P; bv[t] = h; }
#pragma unroll
            for (int t = 0; t < 8; ++t) { AG[base + (size_t)(t8 + t) * D_LRU] = av[t]; BG[base + (size_t)(t8 + t) * D_LRU] = bv[t]; } }
        AGG[((size_t)(0 * 2 + b) * 64 + ck) * D_LRU + ch] = P; AGG[((size_t)(1 * 2 + b) * 64 + ck) * D_LRU + ch] = h; }
}

constexpr int IDX_ROWB = 144;
constexpr int IDX_TILE = 256, IDX_BUFB = IDX_TILE * IDX_ROWB;
__device__ __forceinline__ void p4_indexer_item(const Ctx& c, int b, int q0) {
    const int tid = c.tid, lane = c.lane, wave = c.wave, r32 = lane & 31, hh = lane >> 5;
    const bf16* PROJ = (const bf16*)(c.ws + WS_PROJ); const bf16* KIDX = (const bf16*)(c.ws + WS_KIDX); const float* WIDX = (const float*)(c.ws + WS_WIDX);
    const int n = 64 * (q0 / 64 + 1), ntile = (n + IDX_TILE - 1) / IDX_TILE, nj = n / 32;
    const int tokA = b * SEQ + q0 + 2 * wave, myq = tokA + ((r32 >> 2) & 1), myh = (r32 & 3) + 4 * (r32 >> 3);
    bf16x8 af[4];
#pragma unroll
    for (int s = 0; s < 4; ++s) af[s] = *(const bf16x8*)(PROJ + (size_t)myq * NMAIN + C_QI + myh * 64 + 16 * s + 8 * hh);
    float wv[16];
#pragma unroll
    for (int r = 0; r < 16; ++r) wv[r] = WIDX[(size_t)(tokA + hh) * 16 + r];
    const int skey = tid >> 1, shalf = tid & 1;
    const bf16* kbase = KIDX + (size_t)b * SEQ * 64;
    v4u st[4];
    auto stage_load = [&](int tile) { int key = tile * IDX_TILE + skey; key = key < SEQ ? key : SEQ - 1;
#pragma unroll
        for (int q = 0; q < 4; ++q) st[q] = *(const v4u*)(kbase + (size_t)key * 64 + shalf * 32 + 8 * q); };
    auto stage_write = [&](int buf) {
#pragma unroll
        for (int q = 0; q < 4; ++q) *(LAS v4u*)(c.lds + buf * IDX_BUFB + skey * IDX_ROWB + shalf * 64 + 16 * q) = st[q]; };
    unsigned key_[128];
    for (int srep = 0; srep < NREP(42); ++srep) {
    stage_load(0); stage_write(0); __syncthreads();
#pragma unroll
    for (int tile = 0; tile < 16; ++tile) {
        if (tile < ntile) {
            if (tile + 1 < ntile) stage_load(tile + 1);
            const LAS unsigned char* kb = c.lds + (tile & 1) * IDX_BUFB + r32 * IDX_ROWB + hh * 16;
#pragma unroll
            for (int jj = 0; jj < 8; ++jj) { const int j = tile * 8 + jj;
                if (j < nj) {
                    f32x16 acc = {};
#pragma unroll
                    for (int s = 0; s < 4; ++s) { const bf16x8 bb = *(const LAS bf16x8*)(kb + jj * 32 * IDX_ROWB + s * 32); acc = mfma32(af[s], bb, acc); }
                    float sc = 0.f;
#pragma unroll
                    for (int r = 0; r < 16; ++r) sc += wv[r] * fmaxf(acc[r], 0.f);
                    const unsigned u = __builtin_bit_cast(unsigned, sc);
                    key_[j] = (u & 0x80000000u) ? ~u : (u | 0x80000000u);
                } else key_[j] = 0u; }
            if (tile + 1 < ntile) stage_write((tile + 1) & 1);
            __syncthreads();
        } else {
#pragma unroll
            for (int jj = 0; jj < 8; ++jj) key_[tile * 8 + jj] = 0u;
        }
    } }
    unsigned prefix = 0u;
    for (int brep = 0; brep < NREP(41); ++brep) { prefix = 0u;
    for (int bit = 31; bit >= 0; --bit) { const unsigned cand = prefix | (1u << bit); int cnt = 0;
#pragma unroll
        for (int g = 0; g < 8; ++g) if (g * 16 < nj) {
#pragma unroll
            for (int jj = 0; jj < 16; ++jj) cnt += (key_[g * 16 + jj] >= cand) ? 1 : 0; }
#pragma unroll
        for (int o = 1; o < 32; o <<= 1) cnt += __shfl_xor(cnt, o);
        if (cnt >= 256) prefix = cand; } }
    unsigned wA0 = 0u, wA1 = 0u, wB0 = 0u, wB1 = 0u;
#define CMP16(x_) (((x_) & 0xFu) | (((x_) >> 4) & 0xF0u) | (((x_) >> 8) & 0xF00u) | (((x_) >> 12) & 0xF000u))
    const unsigned thr = prefix > 1u ? prefix : 1u;
#pragma unroll
    for (int g = 0; g < 8; ++g) if (g * 16 < nj) {
#pragma unroll
    for (int jj = 0; jj < 16; ++jj) { const int j = g * 16 + jj; const unsigned long long m = __ballot(key_[j] >= thr);
        const unsigned ma = (unsigned)m, mb = (unsigned)(m >> 32);
        const unsigned a0 = CMP16(ma) << (16 * (j & 1)), a1 = CMP16(ma >> 4) << (16 * (j & 1)), b0 = CMP16(mb) << (16 * (j & 1)), b1 = CMP16(mb >> 4) << (16 * (j & 1));
        const int idx = 2 * (j >> 1);
        if (idx < 64) { if (lane == idx) { wA0 |= a0; wB0 |= b0; } if (lane == idx + 1) { wA0 |= a1; wB0 |= b1; } }
        else { if (lane == idx - 64) { wA1 |= a0; wB1 |= b0; } if (lane == idx - 63) { wA1 |= a1; wB1 |= b1; } } } }
#undef CMP16
    unsigned* MASK = (unsigned*)(c.ws + WS_MASK);
    MASK[(size_t)tokA * 128 + lane] = wA0; MASK[(size_t)tokA * 128 + 64 + lane] = wA1;
    MASK[(size_t)(tokA + 1) * 128 + lane] = wB0; MASK[(size_t)(tokA + 1) * 128 + 64 + lane] = wB1;
    __syncthreads();
}
__device__ __forceinline__ void p4_indexer(const Ctx& c) {
    for (int w = c.bid; w < 256; w += c.G) { const int b = w & 1, p = w >> 1;
        p4_indexer_item(c, b, 16 * p); p4_indexer_item(c, b, 16 * (255 - p)); }
}

__device__ __forceinline__ void p5_lru_apply(const Ctx& c) {
    const float* AG = (const float*)(c.ws + WS_AG); const float* BG = (const float*)(c.ws + WS_BG); const float* AGG = (const float*)(c.ws + WS_AGG);
    const bf16* PROJ = (const bf16*)(c.ws + WS_PROJ); bf16* YMIX = (bf16*)(c.ws + WS_YMIX);
    for (int li = c.gw; li < 2048; li += c.ngw) { const int b = li >> 10, ck = (li >> 4) & 63, ch = (li & 15) * 64 + c.lane; const size_t tok0 = (size_t)b * SEQ + ck * 64;
        float hc = 0.f;
        for (int cc = 0; cc < ck; ++cc) hc = AGG[((size_t)(0 * 2 + b) * 64 + cc) * D_LRU + ch] * hc + AGG[((size_t)(1 * 2 + b) * 64 + cc) * D_LRU + ch];
#pragma unroll 8
        for (int t = 0; t < 64; ++t) { const size_t tok = tok0 + t; const float h = BG[tok * D_LRU + ch] + AG[tok * D_LRU + ch] * hc;
            const float gl = bf2f(PROJ[tok * NMAIN + C_GL + ch]);
            YMIX[tok * DM + ch] = (bf16)f2bf(h * gelu_tanh(gl)); } }
}
__device__ __forceinline__ void p5_attention(const Ctx& c) {
    typedef att::bf16 abf;
    const abf* PROJ = (const abf*)(c.ws + WS_PROJ); abf* YMIX = (abf*)(c.ws + WS_YMIX); const unsigned long long* MASK = (const unsigned long long*)(c.ws + WS_MASK);
    for (int w = c.bid; w < 256; w += c.G) {
        const int xcd = w & 7, slot = w >> 3, bh = xcd * 2 + (slot >> 4), x = 15 - (slot & 15), b = bh >> 3, h = bh & 7;
        att::BlockRef<abf, abf> cur;
        const size_t tokb = (size_t)b * SEQ, tok0 = tokb + (size_t)x * 256;
        cur.Q = PROJ + tok0 * NMAIN + C_Q + h * 128; cur.K = PROJ + tokb * NMAIN + C_K + h * 128; cur.V = PROJ + tokb * NMAIN + C_V + h * 128;
        cur.O = YMIX + tok0 * DM + D_LRU + h * 128; cur.M = MASK + tok0 * 64; cur.P0 = x * 256;
        att::Seam<abf> S;
        att::causal_swa_prime<abf, abf>(cur, 1 << 30, (char*)c.lds, S);
        att::causal_swa_block<abf, abf>(cur, cur, SEQ, 1 << 30, (char*)c.lds, S);
        VM_WAIT(); __syncthreads();
    }
}

__device__ __forceinline__ void p7_rows(const Ctx& c, const Args& a) {
    const int lane = c.lane;
    float* X1 = (float*)(c.ws + WS_X1); bf16* U2 = (bf16*)(c.ws + WS_U2); const float* MODF = (const float*)(c.ws + WS_MODF);
    const float* g1 = (const float*)a.in[I_LN1G]; const float* b1 = (const float*)a.in[I_LN1B];
    for (int row = c.gw; row < NTOK; row += c.ngw) { const int b = row / SEQ;
        f32x4* xr = (f32x4*)(X1 + (size_t)row * DM) + lane;
        f32x4 v[8]; float s = 0.f;
#pragma unroll
        for (int j = 0; j < 8; ++j) { v[j] = xr[64 * j]; s += (v[j].x + v[j].y) + (v[j].z + v[j].w); }
        float mean = wave_sum(s) * (1.f / DM), s2 = 0.f;
#pragma unroll
        for (int j = 0; j < 8; ++j) { v[j] = v[j] - mean; s2 += (v[j].x * v[j].x + v[j].y * v[j].y) + (v[j].z * v[j].z + v[j].w * v[j].w); }
        float rstd = 1.f / sqrtf(wave_sum(s2) * (1.f / DM) + LN_EPS);
        s = 0.f;
#pragma unroll
        for (int j = 0; j < 8; ++j) { const int col = 4 * lane + 256 * j;
            v[j] = v[j] * rstd * *(const f32x4*)(g1 + col) + *(const f32x4*)(b1 + col);
            xr[64 * j] = v[j]; s += (v[j].x + v[j].y) + (v[j].z + v[j].w); }
        mean = wave_sum(s) * (1.f / DM); s2 = 0.f;
#pragma unroll
        for (int j = 0; j < 8; ++j) { v[j] = v[j] - mean; s2 += (v[j].x * v[j].x + v[j].y * v[j].y) + (v[j].z * v[j].z + v[j].w * v[j].w); }
        rstd = 1.f / sqrtf(wave_sum(s2) * (1.f / DM) + LN_EPS);
#pragma unroll
        for (int j = 0; j < 8; ++j) { const int col = 4 * lane + 256 * j;
            const f32x4 sh = *(const f32x4*)(MODF + (size_t)b * (6 * DM) + 3 * DM + col), sc = *(const f32x4*)(MODF + (size_t)b * (6 * DM) + 4 * DM + col);
            const f32x4 y = v[j] * rstd * (sc + 1.0f) + sh;
            v2u o; o.x = pk2(y.x, y.y); o.y = pk2(y.z, y.w);
            *(v2u*)(U2 + (size_t)row * DM + col) = o; }
    }
}

__device__ __forceinline__ unsigned f2key(float f) { const unsigned u = __builtin_bit_cast(unsigned, f); return u ^ ((unsigned)((int)u >> 31) | 0x80000000u); }
__device__ __forceinline__ float key2f(unsigned k) { const unsigned u = (k & 0x80000000u) ? (k ^ 0x80000000u) : ~k; return __builtin_bit_cast(float, u); }
#define INSK(k_, T) do { _Pragma("unroll") for (int q_ = 0; q_ < 16; ++q_) { const unsigned t_ = T[q_]; const unsigned mx_ = t_ > k_ ? t_ : k_; const unsigned mn_ = t_ > k_ ? k_ : t_; T[q_] = mx_; k_ = mn_; } } while (0)
__device__ __forceinline__ float wave_sum_u(float v) {
    v += __builtin_bit_cast(float, __builtin_amdgcn_mov_dpp(__builtin_bit_cast(int, v), 0xB1, 0xf, 0xf, true));
    v += __builtin_bit_cast(float, __builtin_amdgcn_mov_dpp(__builtin_bit_cast(int, v), 0x4E, 0xf, 0xf, true));
    v += __builtin_bit_cast(float, __builtin_amdgcn_mov_dpp(__builtin_bit_cast(int, v), 0x141, 0xf, 0xf, true));
    v += __builtin_bit_cast(float, __builtin_amdgcn_mov_dpp(__builtin_bit_cast(int, v), 0x140, 0xf, 0xf, true));
    const int iv = __builtin_bit_cast(int, v);
    return (__builtin_bit_cast(float, __builtin_amdgcn_readlane(iv, 0)) + __builtin_bit_cast(float, __builtin_amdgcn_readlane(iv, 16)))
         + (__builtin_bit_cast(float, __builtin_amdgcn_readlane(iv, 32)) + __builtin_bit_cast(float, __builtin_amdgcn_readlane(iv, 48)));
}
template <int B> __device__ __forceinline__ f32x2 dq4(unsigned w) { return __builtin_amdgcn_cvt_scalef32_pk_f32_fp4(w, 1.0f, B); }
__device__ __forceinline__ float dot2bf(unsigned a, unsigned b, float c) {
    c = fmaf(bflo(a), bflo(b), c); return fmaf(bfhi(a), bfhi(b), c);
}
__device__ __forceinline__ void p9_peer(const Ctx& c, const Args& a) {
    const int lane = c.lane, wave = c.wave, fr = lane & 15, fq = lane >> 4;
    const bf16* QP = (const bf16*)(c.ws + WS_QP); const bf16* SUBK = (const bf16*)(c.ws + WS_SUBK); const bf16* U2 = (const bf16*)(c.ws + WS_U2);
    const unsigned char* PU8 = c.ws + WS_PU; const unsigned char* PV8 = c.ws + WS_PV; const bf16* PUS = (const bf16*)(c.ws + WS_PUS); const bf16* PVS = (const bf16*)(c.ws + WS_PVS); const float* X1 = (const float*)(c.ws + WS_X1);
    const float* MODF = (const float*)(c.ws + WS_MODF); const float* g2 = (const float*)a.in[I_LN2G]; const float* b2 = (const float*)a.in[I_LN2B];
    int* EIDX = (int*)(c.ws + WS_U1); float* PGW = (float*)(c.ws + WS_U1 + 4 * MiB);
    for (int it = c.bid; it < NTOK / 32; it += c.G) {
        const int t0 = it * 32;
#ifndef P9_NOROUTE
        for (int rrep = 0; rrep < NREP(91); ++rrep)
        { LAS float* sb = (LAS float*)c.lds + wave * (32 * 129); const int h = wave;
#pragma unroll 1
          for (int m = 0; m < 2; ++m) {
              int fq8 = 8 * fq, frl = fr; asm volatile("" : "+v"(fq8), "+v"(frl));
              { f32x4 acc[2][8];
#pragma unroll
                for (int p = 0; p < 2; ++p)
#pragma unroll
                    for (int nt = 0; nt < 8; ++nt) acc[p][nt] = (f32x4){0.f, 0.f, 0.f, 0.f};
#pragma unroll
                for (int p = 0; p < 2; ++p)
#pragma unroll
                    for (int ks = 0; ks < 4; ++ks) { const bf16x8 av = *(const bf16x8*)(QP + (size_t)(t0 + 16 * m + frl) * DM + h * 256 + p * 128 + ks * 32 + fq8);
#pragma unroll
                        for (int nt = 0; nt < 8; ++nt) { const bf16x8 bv = *(const bf16x8*)(SUBK + ((size_t)(h * 2 + p) * 128 + 16 * nt + frl) * 128 + ks * 32 + fq8);
                            acc[p][nt] = mfma16(av, bv, acc[p][nt]); } }
#pragma unroll
                for (int p = 0; p < 2; ++p)
#pragma unroll
                    for (int nt = 0; nt < 8; ++nt)
#pragma unroll
                        for (int r = 0; r < 4; ++r) sb[(p * 16 + 4 * fq + r) * 129 + 16 * nt + fr] = acc[p][nt][r]; }
              LDS_WAIT(); asm volatile("" ::: "memory");
              unsigned T[16];
#pragma unroll
              for (int q = 0; q < 16; ++q) T[q] = 0u;
              { const int half = lane >> 5; const LAS float* row = sb + (lane & 31) * 129 + half * 64;
#pragma unroll 4
                for (int k = 0; k < 64; ++k) { unsigned key = (f2key(row[k]) & 0xFFFFFF80u) | (unsigned)(127 - (half * 64 + k)); INSK(key, T); } }
              { unsigned P[16];
#pragma unroll
                for (int q = 0; q < 16; ++q) P[q] = (unsigned)__shfl_xor((int)T[q], 32);
#pragma unroll
                for (int q = 0; q < 16; ++q) { unsigned key = P[q]; INSK(key, T); } }
              unsigned T2[16];
#pragma unroll
              for (int q = 0; q < 16; ++q) T2[q] = (unsigned)__shfl((int)T[q], (lane & 15) + 16);
              LDS_WAIT(); asm volatile("" ::: "memory");
              LAS int* ib = (LAS int*)sb;
              if (lane < 16) {
#pragma unroll
                  for (int q = 0; q < 16; ++q) { ib[lane * 33 + q] = 127 - (int)(T[q] & 0x7Fu); ib[lane * 33 + 16 + q] = 127 - (int)(T2[q] & 0x7Fu); } }
              float f1[16], f2[16];
#pragma unroll
              for (int q = 0; q < 16; ++q) { f1[q] = key2f(T[q] & 0xFFFFFF80u); f2[q] = key2f(T2[q] & 0xFFFFFF80u); }
              unsigned C[16];
#pragma unroll
              for (int q = 0; q < 16; ++q) C[q] = 0u;
#pragma unroll
              for (int a_ = 0; a_ < 16; ++a_)
#pragma unroll
                  for (int b_ = 0; b_ < 16; ++b_) if ((a_ + 1) * (b_ + 1) <= 16) { unsigned key = (f2key(f1[a_] + f2[b_]) & 0xFFFFFF00u) | (unsigned)(255 - (a_ * 16 + b_)); INSK(key, C); }
              LDS_WAIT(); asm volatile("" ::: "memory");
              if (lane < 16) {
                  const float mx = key2f(C[0] & 0xFFFFFF00u); float ev[16], sum = 0.f;
#pragma unroll
                  for (int q = 0; q < 16; ++q) { ev[q] = __expf(key2f(C[q] & 0xFFFFFF00u) - mx); sum += ev[q]; }
                  const float rs = 1.0f / sum;
#pragma unroll
                  for (int q = 0; q < 16; ++q) { const int code = 255 - (int)(C[q] & 0xFFu);
                      const int eid = ib[lane * 33 + (code >> 4)] * 128 + ib[lane * 33 + 16 + (code & 15)];
                      EIDX[(size_t)(t0 + 16 * m + lane) * 128 + h * 16 + q] = eid; PGW[(size_t)(t0 + 16 * m + lane) * 128 + h * 16 + q] = ev[q] * rs; } }
              LDS_WAIT(); asm volatile("" ::: "memory");
          } }
#endif
        VM_WAIT(); __syncthreads();
#ifndef P9_NOGATHER
        for (int grep_ = 0; grep_ < NREP(92); ++grep_)
#pragma unroll 1
        for (int i4 = 0; i4 < 4; ++i4) { const int tok = t0 + wave * 4 + i4, b = tok / SEQ;
            int l16 = 16 * lane; asm volatile("" : "+v"(l16));
            v32f uu;
#pragma unroll
            for (int cc = 0; cc < 2; ++cc)
#pragma unroll
                for (int hq = 0; hq < 2; ++hq) { const v4u r = *(const v4u*)(U2 + (size_t)tok * DM + 1024 * cc + l16 + 8 * hq); const int o = 16 * cc + 8 * hq;
                    uu[o + 0] = bflo(r.x); uu[o + 1] = bfhi(r.x); uu[o + 2] = bflo(r.y); uu[o + 3] = bfhi(r.y); uu[o + 4] = bflo(r.z); uu[o + 5] = bfhi(r.z); uu[o + 6] = bflo(r.w); uu[o + 7] = bfhi(r.w); }
            v32f acc;
#pragma unroll
            for (int i = 0; i < 32; ++i) acc[i] = 0.f;
            const int lane_ = l16 >> 4;
#pragma unroll 1
            for (int hf = 0; hf < 2; ++hf) {
                const int myi = EIDX[(size_t)tok * 128 + hf * 64 + lane]; const float myg = PGW[(size_t)tok * 128 + hf * 64 + lane];
#pragma unroll 1
                for (int e4 = 0; e4 < 64; e4 += 4) {
                    int ex[4]; float gv[4];
#pragma unroll
                    for (int q = 0; q < 4; ++q) { ex[q] = __builtin_amdgcn_readlane(myi, e4 + q);
                        gv[q] = __builtin_bit_cast(float, __builtin_amdgcn_readlane(__builtin_bit_cast(int, myg), e4 + q)); }
                    v4u rua[4], rva[4]; bf16 su[4], sv[4];
#pragma unroll
                    for (int q = 0; q < 4; ++q) { rua[q] = *(const v4u*)(PU8 + (size_t)ex[q] * FPQ_ROWB + l16); su[q] = PUS[(size_t)ex[q] * 64 + lane_]; }
                    __builtin_amdgcn_sched_barrier(0);
#pragma unroll
                    for (int q = 0; q < 4; ++q) { rva[q] = *(const v4u*)(PV8 + (size_t)ex[q] * FPQ_ROWB + l16); sv[q] = PVS[(size_t)ex[q] * 64 + lane_]; }
                    __builtin_amdgcn_sched_barrier(0);
                    float hk[4];
#pragma unroll
                    for (int q = 0; q < 4; ++q) { float s0 = 0.f, s1 = 0.f;
#pragma unroll
                        for (int k = 0; k < 4; ++k) { const unsigned wd = rua[q][k];
                            { const f32x2 d = dq4<0>(wd); s0 = fmaf(d.x, uu[8 * k + 0], s0); s1 = fmaf(d.y, uu[8 * k + 1], s1); }
                            { const f32x2 d = dq4<1>(wd); s0 = fmaf(d.x, uu[8 * k + 2], s0); s1 = fmaf(d.y, uu[8 * k + 3], s1); }
                            { const f32x2 d = dq4<2>(wd); s0 = fmaf(d.x, uu[8 * k + 4], s0); s1 = fmaf(d.y, uu[8 * k + 5], s1); }
                            { const f32x2 d = dq4<3>(wd); s0 = fmaf(d.x, uu[8 * k + 6], s0); s1 = fmaf(d.y, uu[8 * k + 7], s1); } }
                        hk[q] = gv[q] * gelu_tanh(wave_sum_u((s0 + s1) * bf2f(su[q]))); __builtin_amdgcn_sched_barrier(0); }
                    __builtin_amdgcn_sched_barrier(0);
#pragma unroll
                    for (int q = 0; q < 4; ++q) {
                        const float hq = hk[q] * bf2f(sv[q]);
#pragma unroll
                        for (int k = 0; k < 4; ++k) { const unsigned wd = rva[q][k];
                            { const f32x2 d = dq4<0>(wd); acc[8 * k + 0] = fmaf(d.x, hq, acc[8 * k + 0]); acc[8 * k + 1] = fmaf(d.y, hq, acc[8 * k + 1]); }
                            { const f32x2 d = dq4<1>(wd); acc[8 * k + 2] = fmaf(d.x, hq, acc[8 * k + 2]); acc[8 * k + 3] = fmaf(d.y, hq, acc[8 * k + 3]); }
                            { const f32x2 d = dq4<2>(wd); acc[8 * k + 4] = fmaf(d.x, hq, acc[8 * k + 4]); acc[8 * k + 5] = fmaf(d.y, hq, acc[8 * k + 5]); }
                            { const f32x2 d = dq4<3>(wd); acc[8 * k + 6] = fmaf(d.x, hq, acc[8 * k + 6]); acc[8 * k + 7] = fmaf(d.y, hq, acc[8 * k + 7]); } }
                        __builtin_amdgcn_sched_barrier(0); }
                    __builtin_amdgcn_sched_barrier(0);
                } }
            float s = 0.f; f32x4 z[2][4];
#pragma unroll
            for (int cc = 0; cc < 2; ++cc)
#pragma unroll
                for (int w = 0; w < 4; ++w) { const int col = 1024 * cc + l16 + 4 * w;
                    const f32x4 xv = *(const f32x4*)(X1 + (size_t)tok * DM + col), gt = *(const f32x4*)(MODF + (size_t)b * (6 * DM) + 5 * DM + col);
                    const f32x4 yv = {acc[16 * cc + 4 * w], acc[16 * cc + 4 * w + 1], acc[16 * cc + 4 * w + 2], acc[16 * cc + 4 * w + 3]};
                    z[cc][w] = xv * DN_ALPHA + (gt + 1.0f) * yv;
                    s += (z[cc][w].x + z[cc][w].y) + (z[cc][w].z + z[cc][w].w); }
            const float mean = wave_sum_u(s) * (1.f / DM); float s2 = 0.f;
#pragma unroll
            for (int cc = 0; cc < 2; ++cc)
#pragma unroll
                for (int w = 0; w < 4; ++w) { z[cc][w] = z[cc][w] - mean; s2 += (z[cc][w].x * z[cc][w].x + z[cc][w].y * z[cc][w].y) + (z[cc][w].z * z[cc][w].z + z[cc][w].w * z[cc][w].w); }
            const float rstd = 1.f / sqrtf(wave_sum_u(s2) * (1.f / DM) + LN_EPS);
#pragma unroll
            for (int cc = 0; cc < 2; ++cc)
#pragma unroll
                for (int w = 0; w < 4; ++w) { const int col = 1024 * cc + l16 + 4 * w;
                    *(f32x4*)(a.out + (size_t)tok * DM + col) = z[cc][w] * rstd * *(const f32x4*)(g2 + col) + *(const f32x4*)(b2 + col); }
        }
#endif
        __syncthreads();
    }
}

#ifndef MK_SINGLE
#define MK_SINGLE 1
#endif
constexpr int NPHASE = 10;
constexpr int CW_BAR = 4096;

__global__ void __launch_bounds__(NWAVES * 64, 2) fwd_kernel(Args args) {
    extern __shared__ __attribute__((aligned(16))) unsigned char lds_raw[];
    Ctx c;
    c.lds = (LAS unsigned char*)lds_raw; c.ws = args.ws;
    c.tid = threadIdx.x; c.lane = c.tid & 63; c.wave = __builtin_amdgcn_readfirstlane(c.tid >> 6);
    c.bid = blockIdx.x; c.G = gridDim.x; c.gw = c.bid * NWAVES + c.wave; c.ngw = c.G * NWAVES;
    volatile LAS unsigned* MISC = (volatile LAS unsigned*)(c.lds + MISC_OFF);
    if (c.tid < 64) MISC[c.tid] = 0u;
    __syncthreads();
    const int lo = args.ph_lo, hi = args.ph_hi;
    XcdBarrier bar; bar.bar = (unsigned*)(c.ws + WS_CTL) + CW_BAR; bar.x = 0; bar.st = nullptr;
    if (hi - lo > 1) bar = xcd_barrier_post((unsigned*)(c.ws + WS_CTL) + CW_BAR, MISC + 8);
#ifdef ONLY
#define IN(k) ((k) == ONLY)
#else
#define IN(k) (lo <= (k) && (k) < hi)
#endif
#define SEAM(k) do { if (IN(k) && IN((k) + 1)) xcd_barrier(bar); } while (0)

    if (IN(0)) { for (int rep = 0; rep < NREP(0); ++rep) { p0_prologue(c, args); } } SEAM(0);
    if (IN(1)) { for (int rep = 0; rep < NREP(1); ++rep) { p1_u1(c, args); } } SEAM(1);
    if (IN(2)) {
        pg8::Gemm g{(const pg8::bf16_t*)(c.ws + WS_U1), (const pg8::bf16_t*)(c.ws + WS_WIN), NTOK, NMAIN, DM}; pg8::StaticOrder S; S.init(NTOK, NMAIN, c.G, c.bid);
        pg8::EpiProj E{(pg8::bf16_t*)(c.ws + WS_PROJ), NMAIN, (const float*)(c.ws + WS_ROPE)};
        for (int rep = 0; rep < NREP(2); ++rep) pg8::gemm_phase<pg8::EpiProj, pg8::StaticOrder, true, true>(c.lds, g, S, E);
    } SEAM(2);
    if (IN(3)) { for (int rep = 0; rep < NREP(3); ++rep) { p3_post(c, args); } } SEAM(3);
    if (IN(4)) { p4_lru_scan(c); for (int rep = 0; rep < NREP(4); ++rep) { p4_indexer(c); } } SEAM(4);
    if (IN(5)) { for (int rep = 0; rep < NREP(50); ++rep) { p5_lru_apply(c); } for (int rep = 0; rep < NREP(5); ++rep) { p5_attention(c); } } SEAM(5);
    if (IN(6)) {
        pg8::Gemm g{(const pg8::bf16_t*)(c.ws + WS_YMIX), (const pg8::bf16_t*)(c.ws + WS_WOUT), NTOK, DM, DM}; pg8::StaticOrder S; S.init(NTOK, DM, c.G, c.bid);
        pg8::EpiResF32 E{(const float*)args.in[I_X], (float*)(c.ws + WS_X1), (const float*)(c.ws + WS_MODF) + 2 * DM, DM, SEQ, 6 * DM, DN_ALPHA};
        for (int rep = 0; rep < NREP(6); ++rep) pg8::gemm_phase<pg8::EpiResF32, pg8::StaticOrder, true, true>(c.lds, g, S, E);
    } SEAM(6);
    if (IN(7)) { p7_rows(c, args); } SEAM(7);
    if (IN(8)) {
        pg8::Gemm g{(const pg8::bf16_t*)(c.ws + WS_U2), (const pg8::bf16_t*)(c.ws + WS_WPQ), NTOK, DM, DM}; pg8::StaticOrder S; S.init(NTOK, DM, c.G, c.bid);
        pg8::EpiBf16<0> E{(pg8::bf16_t*)(c.ws + WS_QP), DM, nullptr, 0, 0, 1.f};
        for (int rep = 0; rep < NREP(8); ++rep) pg8::gemm_phase<pg8::EpiBf16<0>, pg8::StaticOrder, true, true>(c.lds, g, S, E);
    } SEAM(8);
    if (IN(9)) { for (int rep = 0; rep < NREP(9); ++rep) { p9_peer(c, args); } }
#undef IN
#undef SEAM
}

extern "C" void kernel_launch(void* const* d_in, const int* in_sizes, int n_in, void* d_out, int out_size, void* d_ws, size_t ws_size, hipStream_t stream) {
    static int grid = 0;
    if (grid == 0) {
        if (n_in != 23 || in_sizes[0] != NTOK * DM || out_size != NTOK * DM || ws_size < WS_END) {
            fprintf(stderr, "kernel_launch: unexpected shapes (n_in %d, in0 %d, out %d, ws %zu); nothing launched\n", n_in, n_in > 0 ? in_sizes[0] : -1, out_size, ws_size); grid = -1; return; }
        int dev = 0, cus = 0, per_cu = 0;
        if (hipGetDevice(&dev) != hipSuccess || hipDeviceGetAttribute(&cus, hipDeviceAttributeMultiprocessorCount, dev) != hipSuccess) { grid = -1; return; }
        if (hipFuncSetAttribute((const void*)fwd_kernel, hipFuncAttributeMaxDynamicSharedMemorySize, LDS_BYTES) != hipSuccess) { fprintf(stderr, "kernel_launch: hipFuncSetAttribute failed\n"); grid = -1; return; }
        if (hipOccupancyMaxActiveBlocksPerMultiprocessor(&per_cu, (const void*)fwd_kernel, NWAVES * 64, LDS_BYTES) != hipSuccess || per_cu < 1) { fprintf(stderr, "kernel_launch: occupancy query says %d\n", per_cu); }
        (void)hipGetLastError();
        grid = cus;
    }
    if (grid < 0) return;
    (void)hipMemsetAsync((char*)d_ws + WS_CTL, 0, CTL_ZERO_BYTES, stream);
    Args a{};
    for (int i = 0; i < 23; ++i) a.in[i] = d_in[i];
    a.out = (float*)d_out; a.ws = (unsigned char*)d_ws;
#if MK_SINGLE
    a.ph_lo = 0; a.ph_hi = NPHASE;
    hipLaunchKernelGGL(fwd_kernel, dim3(grid), dim3(NWAVES * 64), LDS_BYTES, stream, a);
#else
    for (int p = 0; p < NPHASE; ++p) { a.ph_lo = p; a.ph_hi = p + 1; hipLaunchKernelGGL(fwd_kernel, dim3(grid), dim3(NWAVES * 64), LDS_BYTES, stream, a); }
#endif
}
```

```cpp
#include <hip/hip_runtime.h>
#include <hip/hip_bf16.h>
#include <cstdio>
#include <cstdint>
#include <cmath>
#ifndef REP_PHASE
#define REP_PHASE -1
#endif
#define NREP(k) ((k) == REP_PHASE ? 2 : 1)

constexpr int NB = 2, SEQ = 4096, NTOK = NB * SEQ, DM = 2048;
constexpr int D_LRU = 1024, D_ATT = 1024, NHEAD = 8, HDIM = 128, NIH = 16, IDIM = 64;
constexpr int DIN = 6224, NMAIN = 6144;
constexpr int C_XL = 0, C_GL = 1024, C_Q = 2048, C_K = 3072, C_V = 4096, C_QI = 5120, C_KI = 6144, C_WI = 6208;
constexpr int NEXP = 16384, PKD = 256, PTOPK = 16, PHEADS = 8, NKEYS = 128;
constexpr float LN_EPS = 1e-5f;
constexpr float DN_ALPHA = 1.189207115002721f;

constexpr size_t MiB = 1u << 20;
constexpr size_t WS_CTL = 0, CTL_ZERO_BYTES = 1 * MiB;
constexpr size_t WS_MODP = 1 * MiB;
constexpr size_t WS_MODF = 4 * MiB;
constexpr size_t WS_PUS = 88 * MiB, WS_PVS = 152 * MiB;
constexpr size_t WS_WRG  = 5 * MiB;
constexpr size_t WS_SUBK = 6 * MiB;
constexpr size_t WS_KIDX = 7 * MiB;
constexpr size_t WS_WIDX = 8 * MiB;
constexpr size_t WS_AGG  = 9 * MiB;
constexpr size_t WS_MASK = 10 * MiB;
constexpr size_t WS_WIN  = 14 * MiB;
constexpr size_t WS_WOUT = 40 * MiB;
constexpr size_t WS_WPQ  = 48 * MiB;
constexpr size_t WS_PU   = 56 * MiB;
constexpr size_t WS_PV   = 120 * MiB;
constexpr size_t WS_U1   = 184 * MiB;
constexpr size_t WS_PROJ = 216 * MiB;
constexpr size_t WS_AG   = 312 * MiB;
constexpr size_t WS_BG   = 344 * MiB;
constexpr size_t WS_ROPE = 376 * MiB;
constexpr size_t WS_END  = 378 * MiB;
constexpr size_t WS_MODA = 512 * 1024;
constexpr size_t WS_YMIX = WS_U1, WS_X1 = WS_PROJ, WS_U2 = WS_PROJ + 64 * MiB, WS_QP = WS_AG;

#define GAS __attribute__((address_space(1)))
#define LAS __attribute__((address_space(3)))
typedef unsigned short bf16;
typedef unsigned v4u __attribute__((ext_vector_type(4)));
typedef unsigned v2u __attribute__((ext_vector_type(2)));
typedef float f32x4 __attribute__((ext_vector_type(4)));
typedef float f32x2 __attribute__((ext_vector_type(2)));
typedef float f32x16 __attribute__((ext_vector_type(16)));
typedef short bf16x8 __attribute__((ext_vector_type(8)));
typedef short s16x4 __attribute__((ext_vector_type(4)));
typedef float v32f __attribute__((ext_vector_type(32)));
typedef unsigned v6u __attribute__((ext_vector_type(6)));
#define RLX_AGENT __ATOMIC_RELAXED, __HIP_MEMORY_SCOPE_AGENT
#define LDS_WAIT() asm volatile("s_waitcnt lgkmcnt(0)" ::: "memory")
#define VM_WAIT() asm volatile("s_waitcnt vmcnt(0)" ::: "memory")
__device__ __forceinline__ unsigned f2bf(float f) { unsigned u = __builtin_bit_cast(unsigned, f); return (u + 0x7fffu + ((u >> 16) & 1u)) >> 16; }
__device__ __forceinline__ unsigned pk2(float lo, float hi) { return f2bf(lo) | (f2bf(hi) << 16); }
__device__ __forceinline__ float bflo(unsigned w) { return __builtin_bit_cast(float, w << 16); }
__device__ __forceinline__ float bfhi(unsigned w) { return __builtin_bit_cast(float, w & 0xffff0000u); }
__device__ __forceinline__ float bf2f(bf16 h) { return __builtin_bit_cast(float, (unsigned)h << 16); }
__device__ __forceinline__ float wave_sum(float v) {
#pragma unroll
    for (int o = 1; o < 64; o <<= 1) v += __shfl_xor(v, o);
    return v;
}
__device__ __forceinline__ float sigmoidf_(float x) { return 1.0f / (1.0f + __expf(-x)); }
__device__ __forceinline__ float gelu_tanh(float x) {
    const float u = 1.5957691216057308f * (x + 0.044715f * x * x * x);
    return x / (1.0f + __expf(-u));
}
namespace pg8 {
#define PG8_LAS __attribute__((address_space(3)))
typedef unsigned short bf16_t;
typedef short bf16x8 __attribute__((ext_vector_type(8)));
typedef float f32x4 __attribute__((ext_vector_type(4)));
typedef unsigned u32x4 __attribute__((ext_vector_type(4)));
constexpr int BM = 256, BK = 64, HALF = 128, HTB = HALF * BK * 2  , STAGE_BYTES = 8 * HTB, NXCD = 8, WGM = 8;

__host__ __device__ __forceinline__ int lds_byte(int r, int c) { const int st = (r >> 4) * 2 + (c >> 5), rr = r & 15, cc = c & 31, ob = rr * 64 + cc * 2; return st * 1024 + (ob ^ (((ob >> 9) & 1) << 5)); }
__host__ __device__ __forceinline__ void stage_rc(int b, int& R, int& C) { const int st = b / 1024, sb = b % 1024, swz = sb ^ (((sb >> 9) & 1) << 5); R = (st >> 1) * 16 + swz / 64; C = (st & 1) * 32 + (swz % 64) / 2; }
__host__ __device__ __forceinline__ int perm32(int rho) { const int n = rho >> 4, i = rho & 15; return 8 * (i >> 2) + 4 * n + (i & 3); }

struct Unit { int pm, pn; };
struct Gemm { const bf16_t* A; const bf16_t* Bt; int M, N, K; };

struct StaticOrder {
    int nM, nN, nwg, G, c;
    __host__ __device__ void init(int M, int N, int G_, int c_) { nM = M / BM; nN = N / BM; nwg = nM * nN; G = G_; c = c_; }
    __host__ __device__ bool next(int i, Unit& u) const {
        const long L = (long)i * G + c; if (L >= nwg) return false;
        int wgid = (int)L; { const int q = nwg / NXCD, r = nwg % NXCD, xcd = wgid % NXCD, off = wgid / NXCD; wgid = (xcd < r ? xcd * (q + 1) : r * (q + 1) + (xcd - r) * q) + off; }
        const int nig = WGM * nN, gid = wgid / nig, fm = gid * WGM, gsz = (nM - fm) < WGM ? (nM - fm) : WGM;
        u.pm = fm + ((wgid % nig) % gsz); u.pn = (wgid % nig) / gsz; return true;
    }
    __device__ __forceinline__ void a_ready(const Unit&) const {}
    __device__ __forceinline__ void done(const Unit&) const {}
};

__device__ __forceinline__ unsigned cvt_pk_bf16(float lo, float hi) { unsigned r; asm volatile("v_cvt_pk_bf16_f32 %0, %1, %2" : "=v"(r) : "v"(lo), "v"(hi)); return r; }
typedef float f32x2 __attribute__((ext_vector_type(2)));
__device__ __forceinline__ f32x2 gelu_pk(f32x2 v) {
    const f32x2 av = __builtin_elementwise_abs(v), d = av * 0.2316418882f + 1.0f;
    f32x2 t; t.x = __builtin_amdgcn_rcpf(d.x); t.y = __builtin_amdgcn_rcpf(d.y);
    f32x2 q = t * 0.5307027145f + (-0.7265760135f); q = q * t + 0.7107068705f; q = q * t + (-0.142248368f); q = q * t + 0.127414796f; q = q * t;
    const f32x2 s = (v * v) * (-0.72134752044f);
    f32x2 e; e.x = __builtin_amdgcn_exp2f(s.x); e.y = __builtin_amdgcn_exp2f(s.y);
    const f32x2 m = v * (q * e), r = v - m;
    f32x2 o; o.x = v.x < 0.f ? m.x : r.x; o.y = v.y < 0.f ? m.y : r.y; return o;
}

template <int ACT  > struct EpiBf16 {
    static constexpr bool PERM = true, AFTER_DRAIN = false; static_assert(ACT == 0 || ACT == 1, "EpiBf16: ACT is 0 (none) or 1 (gelu_pk)");
    bf16_t* O; int ldc; const float* bias; int split_cols; size_t split_stride; float scale0;
    __device__ __forceinline__ void operator()(const f32x4 (&acc)[2][2][4][2], const Unit& u, int wr, int wc, int fr, int fq) const {
        const int row0 = u.pm * BM + wr * 64 + fr; int colt = u.pn * BM; bf16_t* base = O;
        float sc = 1.f; if (split_cols) { const int t = colt / split_cols; base += (size_t)t * split_stride; colt -= t * split_cols; if (t == 0) sc = scale0; }
        const int col0 = colt + wc * 32 + 8 * fq, bcol0 = u.pn * BM + wc * 32 + 8 * fq;
        f32x4 bv[2][2];
#pragma unroll
        for (int bj = 0; bj < 2; ++bj)
#pragma unroll
            for (int n = 0; n < 2; ++n) bv[bj][n] = bias ? *(const f32x4*)(bias + bcol0 + bj * HALF + 4 * n) : (f32x4){0.f, 0.f, 0.f, 0.f};
#pragma unroll
        for (int ai = 0; ai < 2; ++ai)
#pragma unroll
            for (int m = 0; m < 4; ++m) { bf16_t* rowp = base + (size_t)(row0 + ai * HALF + m * 16) * ldc + col0;
#pragma unroll
                for (int bj = 0; bj < 2; ++bj) { f32x4 v0 = acc[ai][bj][m][0] + bv[bj][0], v1 = acc[ai][bj][m][1] + bv[bj][1];
                    if (ACT == 1) { f32x2 a = gelu_pk((f32x2){v0[0], v0[1]}), b = gelu_pk((f32x2){v0[2], v0[3]}), c = gelu_pk((f32x2){v1[0], v1[1]}), d = gelu_pk((f32x2){v1[2], v1[3]});
                        v0 = (f32x4){a.x, a.y, b.x, b.y}; v1 = (f32x4){c.x, c.y, d.x, d.y}; }
                    v0 = v0 * sc; v1 = v1 * sc; u32x4 w; w.x = cvt_pk_bf16(v0[0], v0[1]); w.y = cvt_pk_bf16(v0[2], v0[3]); w.z = cvt_pk_bf16(v1[0], v1[1]); w.w = cvt_pk_bf16(v1[2], v1[3]);
                    *(u32x4*)(rowp + bj * HALF) = w; } }
    }
};

struct EpiProj {
    static constexpr bool PERM = true, AFTER_DRAIN = false;
    bf16_t* O; int ldc; const float* CS;
    __device__ __forceinline__ void operator()(const f32x4 (&acc)[2][2][4][2], const Unit& u, int wr, int wc, int fr, int fq) const {
        const int row0 = u.pm * BM + wr * 64 + fr, col0 = u.pn * BM + wc * 32 + 8 * fq, region = (u.pn * BM) >> 10;
        const int mode = (region == 2 || region == 3) ? (wc == 0 ? 1 : 0) : (region == 5 ? ((wc & 1) == 0 ? 2 : 0) : 0);
#pragma unroll
        for (int ai = 0; ai < 2; ++ai)
#pragma unroll
            for (int m = 0; m < 4; ++m) { const int row = row0 + ai * HALF + m * 16; bf16_t* rowp = O + (size_t)row * ldc + col0;
                f32x4 c0 = {1.f, 1.f, 1.f, 1.f}, c1 = c0, s0 = {0.f, 0.f, 0.f, 0.f}, s1 = s0;
                if (mode == 1) { const float* cs = CS + (size_t)row * 48 + 8 * (fq & 1); c0 = *(const f32x4*)cs; c1 = *(const f32x4*)(cs + 4); s0 = *(const f32x4*)(cs + 16); s1 = *(const f32x4*)(cs + 20); if (fq < 2) { s0 = -s0; s1 = -s1; } }
                if (mode == 2) { const float* cs = CS + (size_t)row * 48 + 32; if (fq < 2) { c0 = *(const f32x4*)cs; c1 = *(const f32x4*)(cs + 4); s0 = *(const f32x4*)(cs + 8); s1 = *(const f32x4*)(cs + 12); if (fq == 0) { s0 = -s0; s1 = -s1; } } }
#pragma unroll
                for (int bj = 0; bj < 2; ++bj) { f32x4 v0 = acc[ai][bj][m][0], v1 = acc[ai][bj][m][1];
                    if (mode != 0) { const int xm = mode == 1 ? 32 : 16; f32x4 o0, o1;
#pragma unroll
                        for (int e = 0; e < 4; ++e) { o0[e] = __shfl_xor(v0[e], xm); o1[e] = __shfl_xor(v1[e], xm); }
                        v0 = v0 * c0 + o0 * s0; v1 = v1 * c1 + o1 * s1; }
                    u32x4 w; w.x = cvt_pk_bf16(v0[0], v0[1]); w.y = cvt_pk_bf16(v0[2], v0[3]); w.z = cvt_pk_bf16(v1[0], v1[1]); w.w = cvt_pk_bf16(v1[2], v1[3]);
                    *(u32x4*)(rowp + bj * HALF) = w; } }
    }
};

struct EpiResF32 {
    static constexpr bool PERM = false, AFTER_DRAIN = false;
    const float* X; float* Z; const float* gate; int ldc, rows_per_batch, gstride; float alpha;
    __device__ __forceinline__ void operator()(const f32x4 (&acc)[2][2][4][2], const Unit& u, int wr, int wc, int fr, int fq) const {
        const int row0 = u.pm * BM + wr * 64 + fr, col0 = u.pn * BM + wc * 32 + 4 * fq;
        const float* gb = gate + (size_t)((u.pm * BM) / rows_per_batch) * gstride;
        f32x4 gv[2][2];
#pragma unroll
        for (int bj = 0; bj < 2; ++bj)
#pragma unroll
            for (int n = 0; n < 2; ++n) gv[bj][n] = *(const f32x4*)(gb + col0 + bj * HALF + n * 16) + 1.0f;
#pragma unroll
        for (int ai = 0; ai < 2; ++ai)
#pragma unroll
            for (int m = 0; m < 4; ++m) { const size_t off = (size_t)(row0 + ai * HALF + m * 16) * ldc + col0;
#pragma unroll
                for (int bj = 0; bj < 2; ++bj)
#pragma unroll
                    for (int n = 0; n < 2; ++n) { const f32x4 xv = *(const f32x4*)(X + off + bj * HALF + n * 16);
                        *(f32x4*)(Z + off + bj * HALF + n * 16) = xv * alpha + gv[bj][n] * acc[ai][bj][m][n]; } }
    }
};

template <class Epi, class Sched, bool ALIGN_EPI = false, bool SP2 = false>
__device__ __forceinline__ void gemm_phase(PG8_LAS unsigned char* lds, const Gemm g, const Sched& S, const Epi& E) {
    const int tid = threadIdx.x, wid = __builtin_amdgcn_readfirstlane(tid >> 6), lane = tid & 63, wr = wid >> 2, wc = wid & 3, fr = lane & 15, fq = lane >> 4;
    const int K = g.K, nt = K / BK;
    unsigned voffA[2], voffB[2];
#pragma unroll
    for (int i = 0; i < 2; ++i) { int R, C; stage_rc(tid * 16 + i * 8192, R, C); const int Rb = Epi::PERM ? ((R & ~31) + perm32(R & 31)) : R;
        voffA[i] = (unsigned)(R * K + C) * 2u; voffB[i] = (unsigned)(Rb * K + C) * 2u; }
    const size_t kstep = (size_t)(BK * 2);
    const size_t hstep = (size_t)HALF * K * 2;
    const size_t tstep = 2 * hstep;
    const unsigned ldsw = (unsigned)wid * 1024u;
    const int aoff = lds_byte(wr * 64 + fr, fq * 8), boff = lds_byte(wc * 32 + fr, fq * 8);
#define PG8_SA(b, h) (((b) * 2 + (h)) * HTB)
#define PG8_SB(b, h) ((4 + (b) * 2 + (h)) * HTB)
#define PG8_STAGE(bufoff, gbase, voff) do { _Pragma("unroll") for (int _i = 0; _i < 2; ++_i) \
        __builtin_amdgcn_global_load_lds((const unsigned*)((const char*)(gbase) + (voff)[_i]), (PG8_LAS unsigned*)(lds + (bufoff) + ldsw + _i * 8192), 16, 0, 0); } while (0)
#define PG8_LDA(dst, b, h) do { _Pragma("unroll") for (int m = 0; m < 4; ++m) _Pragma("unroll") for (int k = 0; k < 2; ++k) dst[m][k] = *(const PG8_LAS bf16x8*)(lds + PG8_SA(b, h) + aoff + m * 2048 + k * 1024); } while (0)
#define PG8_LDB(dst, b, h) do { _Pragma("unroll") for (int n = 0; n < 2; ++n) _Pragma("unroll") for (int k = 0; k < 2; ++k) dst[n][k] = *(const PG8_LAS bf16x8*)(lds + PG8_SB(b, h) + boff + n * 2048 + k * 1024); } while (0)
#define PG8_MMA(ai, bj, At, Bt) do { __builtin_amdgcn_s_setprio(1); _Pragma("unroll") for (int m = 0; m < 4; ++m) _Pragma("unroll") for (int n = 0; n < 2; ++n) _Pragma("unroll") for (int k = 0; k < 2; ++k) \
        acc[ai][bj][m][n] = __builtin_amdgcn_mfma_f32_16x16x32_bf16(Bt[n][k], At[m][k], acc[ai][bj][m][n], 0, 0, 0); __builtin_amdgcn_s_setprio(0); } while (0)
#define PG8_WAIT_V(n) asm volatile("s_waitcnt vmcnt(" #n ")" ::: "memory")
#define PG8_WAIT_L(n) asm volatile("s_waitcnt lgkmcnt(" #n ")" ::: "memory")
#define PG8_BAR __builtin_amdgcn_s_barrier()
#define PG8_SCHED __builtin_amdgcn_sched_barrier(0)
    Unit cur, nxt; int ui = 0;
    if (!S.next(0, cur)) return;
    f32x4 acc[2][2][4][2];
#pragma unroll
    for (int a = 0; a < 2; ++a)
#pragma unroll
        for (int b = 0; b < 2; ++b)
#pragma unroll
            for (int m = 0; m < 4; ++m)
#pragma unroll
                for (int n = 0; n < 2; ++n) acc[a][b][m][n] = (f32x4){0.f, 0.f, 0.f, 0.f};
    bf16x8 At[4][2], B0[2][2], B1[2][2];
    const char* cA = (const char*)g.A + (size_t)cur.pm * tstep; const char* cB = (const char*)g.Bt + (size_t)cur.pn * tstep;
    S.a_ready(cur);
    if constexpr (SP2) {
        PG8_STAGE(PG8_SB(0, 0), cB, voffB); PG8_STAGE(PG8_SB(0, 1), cB + hstep, voffB); PG8_STAGE(PG8_SA(0, 0), cA, voffA); PG8_STAGE(PG8_SA(0, 1), cA + hstep, voffA);
        if (wr == 1) PG8_BAR;
        PG8_WAIT_V(2); PG8_BAR;
        PG8_STAGE(PG8_SB(1, 0), cB + kstep, voffB); PG8_STAGE(PG8_SA(1, 0), cA + kstep, voffA); PG8_STAGE(PG8_SB(1, 1), cB + hstep + kstep, voffB);
        PG8_WAIT_V(6); PG8_BAR;
    } else {
        PG8_STAGE(PG8_SB(0, 0), cB, voffB); PG8_STAGE(PG8_SA(0, 0), cA, voffA); PG8_STAGE(PG8_SB(0, 1), cB + hstep, voffB); PG8_STAGE(PG8_SA(0, 1), cA + hstep, voffA);
        if (wr == 1) PG8_BAR;
        PG8_WAIT_V(4); PG8_BAR;
        PG8_STAGE(PG8_SB(1, 0), cB + kstep, voffB); PG8_STAGE(PG8_SA(1, 0), cA + kstep, voffA); PG8_STAGE(PG8_SB(1, 1), cB + hstep + kstep, voffB);
        PG8_WAIT_V(6); PG8_BAR;
    }
    for (;;) {
        const bool has_next = S.next(ui + 1, nxt);
        const char* nA = has_next ? (const char*)g.A + (size_t)nxt.pm * tstep : cA; const char* nB = has_next ? (const char*)g.Bt + (size_t)nxt.pn * tstep : cB;
        for (int t = 0; t < nt; t += 2) {
            const bool last = (t == nt - 2);
            const char* a1 = cA + (size_t)(t + 1) * kstep;
            const char* a2 = last ? nA : cA + (size_t)(t + 2) * kstep; const char* b2 = last ? nB : cB + (size_t)(t + 2) * kstep;
            const char* a3 = a2 + kstep; const char* b3 = b2 + kstep;
            if (last && has_next) S.a_ready(nxt);
            if constexpr (SP2) {
            PG8_LDB(B0, 0, 0); PG8_LDB(B1, 0, 1); PG8_SCHED; PG8_LDA(At, 0, 0); PG8_STAGE(PG8_SA(1, 1), a1 + hstep, voffA);
            PG8_WAIT_V(8); PG8_WAIT_L(0); PG8_BAR; PG8_MMA(0, 0, At, B0); PG8_MMA(0, 1, At, B1); PG8_BAR; PG8_SCHED;
            PG8_LDA(At, 0, 1); PG8_STAGE(PG8_SB(0, 0), b2, voffB); PG8_STAGE(PG8_SB(0, 1), b2 + hstep, voffB); PG8_STAGE(PG8_SA(0, 0), a2, voffA);
            PG8_WAIT_V(8); PG8_WAIT_L(0); PG8_BAR; PG8_MMA(1, 0, At, B0); PG8_MMA(1, 1, At, B1); PG8_BAR; PG8_SCHED;
            PG8_LDB(B0, 1, 0); PG8_LDB(B1, 1, 1); PG8_SCHED; PG8_LDA(At, 1, 0); PG8_STAGE(PG8_SA(0, 1), a2 + hstep, voffA);
            PG8_WAIT_V(8); PG8_WAIT_L(0); PG8_BAR; PG8_MMA(0, 0, At, B0); PG8_MMA(0, 1, At, B1); PG8_BAR; PG8_SCHED;
            PG8_LDA(At, 1, 1); PG8_STAGE(PG8_SB(1, 0), b3, voffB); PG8_STAGE(PG8_SB(1, 1), b3 + hstep, voffB); PG8_STAGE(PG8_SA(1, 0), a3, voffA);
            PG8_WAIT_V(8); PG8_WAIT_L(0); PG8_BAR; PG8_MMA(1, 0, At, B0); PG8_MMA(1, 1, At, B1); PG8_BAR; PG8_SCHED;
            } else {
            PG8_LDB(B0, 0, 0); PG8_SCHED; PG8_LDA(At, 0, 0); PG8_STAGE(PG8_SA(1, 1), a1 + hstep, voffA);
            PG8_WAIT_L(8); PG8_BAR; PG8_WAIT_L(0); PG8_MMA(0, 0, At, B0); PG8_BAR; PG8_SCHED;
            PG8_LDB(B1, 0, 1); PG8_STAGE(PG8_SB(0, 0), b2, voffB);
            PG8_BAR; PG8_WAIT_L(0); PG8_MMA(0, 1, At, B1); PG8_BAR;
            PG8_LDA(At, 0, 1); PG8_STAGE(PG8_SA(0, 0), a2, voffA);
            PG8_BAR; PG8_WAIT_L(0); PG8_MMA(1, 0, At, B0); PG8_BAR; PG8_SCHED;
            PG8_STAGE(PG8_SB(0, 1), b2 + hstep, voffB);
            PG8_WAIT_V(6); PG8_BAR; PG8_MMA(1, 1, At, B1); PG8_BAR;
            PG8_LDB(B0, 1, 0); PG8_SCHED; PG8_LDA(At, 1, 0); PG8_STAGE(PG8_SA(0, 1), a2 + hstep, voffA);
            PG8_WAIT_L(8); PG8_BAR; PG8_WAIT_L(0); PG8_MMA(0, 0, At, B0); PG8_BAR; PG8_SCHED;
            PG8_LDB(B1, 1, 1); PG8_STAGE(PG8_SB(1, 0), b3, voffB);
            PG8_BAR; PG8_WAIT_L(0); PG8_MMA(0, 1, At, B1); PG8_BAR;
            PG8_LDA(At, 1, 1); PG8_STAGE(PG8_SA(1, 0), a3, voffA);
            PG8_BAR; PG8_WAIT_L(0); PG8_MMA(1, 0, At, B0); PG8_BAR; PG8_SCHED;
            PG8_STAGE(PG8_SB(1, 1), b3 + hstep, voffB);
            PG8_WAIT_V(6); PG8_BAR; PG8_MMA(1, 1, At, B1); PG8_BAR;
            }
        }
        if constexpr (ALIGN_EPI) { if (wr == 0) PG8_BAR; }
        if constexpr (!Epi::AFTER_DRAIN) { E(acc, cur, wr, wc, fr, fq); S.done(cur); }
        if (!has_next) break;
#pragma unroll
        for (int a = 0; a < 2; ++a)
#pragma unroll
            for (int b = 0; b < 2; ++b)
#pragma unroll
                for (int m = 0; m < 4; ++m)
#pragma unroll
                    for (int n = 0; n < 2; ++n) acc[a][b][m][n] = (f32x4){0.f, 0.f, 0.f, 0.f};
        cur = nxt; cA = nA; cB = nB; ++ui;
        if constexpr (ALIGN_EPI) { if (wr == 1) PG8_BAR; }
    }
    PG8_WAIT_V(0);
    if constexpr (!ALIGN_EPI) { if (wr == 0) PG8_BAR; }
    PG8_BAR;
    if constexpr (Epi::AFTER_DRAIN) { E.fused(acc, cur, wr, wc, fr, fq, lds, wid, lane); S.done(cur); }
#undef PG8_SA
#undef PG8_SB
#undef PG8_STAGE
#undef PG8_LDA
#undef PG8_LDB
#undef PG8_MMA
#undef PG8_WAIT_V
#undef PG8_WAIT_L
#undef PG8_BAR
#undef PG8_SCHED
}
}
namespace att {
using bf16 = __hip_bfloat16;
typedef short bf16x8 __attribute__((ext_vector_type(8)));
typedef short s16x4 __attribute__((ext_vector_type(4)));
typedef float f32x16 __attribute__((ext_vector_type(16)));
typedef float f32x4 __attribute__((ext_vector_type(4)));
typedef unsigned u32x4 __attribute__((ext_vector_type(4)));
template <class A, class Bt> struct same_t { static constexpr bool v = false; };
template <class A> struct same_t<A, A> { static constexpr bool v = true; };
constexpr int D = 128, PIN = 6144, POUT = 2048;
constexpr float THR = 8.f;
constexpr bool WSKIP = false;
constexpr float SCALE = 0.08838834764831845f;
constexpr int NW = 8, QBLK = 32, KVBLK = 64, QB = NW * QBLK;
constexpr int SHM_V = KVBLK * D * 2, SHM_K = KVBLK * D * 2;
constexpr int LDS_BYTES = 2 * SHM_V + 2 * SHM_K + NW * 64 * 4;
#define KSWZ(row, colB) ((row) * 256 + ((colB) ^ (((row) & 7) << 4)))
#define SBAR() __builtin_amdgcn_sched_barrier(0)
__device__ __forceinline__ int v_st(int k, int c) { const int kk = (k & ~0xC) | ((k & 4) << 1) | ((k & 8) >> 1); return ((kk >> 3) * 4 + (c >> 5)) * 512 + ((kk & 7) * 32 + (c & 31)) * 2; }
__device__ __forceinline__ int v_rd_base(int lane) { return ((lane & 3) << 3) | (((lane >> 2) & 3) << 6) | (((lane >> 4) & 1) << 5) | (((lane >> 5) & 1) << 8); }
constexpr int v_rd_off(int d0, int ks, int half) { return d0 * 512 + ks * 4096 + half * 2048; }
__device__ __forceinline__ int crow(int r, int hi) { return (r & 3) + 8 * (r >> 2) + 4 * hi; }
__device__ __forceinline__ unsigned cvtpk(float lo, float hi) {
    unsigned r; asm volatile("v_cvt_pk_bf16_f32 %0, %1, %2" : "=v"(r) : "v"(lo), "v"(hi)); return r;
}
__device__ __forceinline__ bf16x8 pack8(f32x4 a, f32x4 b) {
    u32x4 w = {cvtpk(a[0], a[1]), cvtpk(a[2], a[3]), cvtpk(b[0], b[1]), cvtpk(b[2], b[3])};
    return *reinterpret_cast<bf16x8*>(&w);
}
template <class T> __device__ __forceinline__ bf16x8 load8(const T* p) {
    if constexpr (same_t<T, float>::v) { return pack8(*(const f32x4*)p, *(const f32x4*)(p + 4)); }
    else { return *reinterpret_cast<const bf16x8*>(p); }
}
__device__ __forceinline__ void mask_tile(f32x16& p0, f32x16& p1, int dq, unsigned W) {
    const float NEG = -__builtin_inff();
#pragma unroll
    for (int r = 0; r < 16; ++r) {
        const int c = (r & 3) + 8 * (r >> 2);
        if ((unsigned)(dq - c) >= W) p0[r] = NEG;
        if ((unsigned)(dq - c - 32) >= W) p1[r] = NEG;
    }
}
__device__ __forceinline__ void bitmask_tile(f32x16& p0, f32x16& p1, unsigned mw) {
    const float NEG = -__builtin_inff();
#pragma unroll
    for (int r = 0; r < 16; ++r) {
        if (!((mw >> r) & 1u)) p0[r] = NEG;
        if (!((mw >> (16 + r)) & 1u)) p1[r] = NEG;
    }
}
__device__ __forceinline__ void partialSM(f32x16& p0, f32x16& p1, float& m_reg, float& mn, float& alpha) {
    float pmax = p0[0]; for (int r = 1; r < 16; ++r) pmax = fmaxf(pmax, p0[r]); for (int r = 0; r < 16; ++r) pmax = fmaxf(pmax, p1[r]);
    { auto rr = __builtin_amdgcn_permlane32_swap(__float_as_uint(pmax), __float_as_uint(pmax), false, false);
      pmax = fmaxf(__uint_as_float(rr[0]), __uint_as_float(rr[1])); }
    constexpr float C2 = 1.4426950408889634f * SCALE;
    if (__builtin_expect(__all((pmax - m_reg) * SCALE <= THR), 1)) { mn = m_reg; alpha = 1.f; }
    else { mn = fmaxf(m_reg, pmax); alpha = __builtin_amdgcn_exp2f((m_reg - mn) * C2); m_reg = mn; }
    const float mnL = -mn * C2;
    for (int r = 0; r < 16; ++r) p0[r] = fmaf(p0[r], C2, mnL); for (int r = 0; r < 16; ++r) p1[r] = fmaf(p1[r], C2, mnL);
    for (int r = 0; r < 16; ++r) p0[r] = __builtin_amdgcn_exp2f(p0[r]);
}
__device__ __forceinline__ void finishSM(f32x16& p0, f32x16& p1, float alpha, float& l_reg, bf16x8& pa0, bf16x8& pa1, bf16x8& pa2, bf16x8& pa3) {
    for (int r = 0; r < 16; ++r) p1[r] = __builtin_amdgcn_exp2f(p1[r]);
    float ps = 0; for (int r = 0; r < 16; ++r) ps += p0[r]; for (int r = 0; r < 16; ++r) ps += p1[r];
    { auto rr = __builtin_amdgcn_permlane32_swap(__float_as_uint(ps), __float_as_uint(ps), false, false);
      ps = __uint_as_float(rr[0]) + __uint_as_float(rr[1]); }
    l_reg = l_reg * alpha + ps;
#define PK4(P, B_, OUT) do { unsigned a0 = cvtpk(P[B_+0], P[B_+1]), a1 = cvtpk(P[B_+2], P[B_+3]);                          \
        unsigned b0 = cvtpk(P[B_+4], P[B_+5]), b1 = cvtpk(P[B_+6], P[B_+7]);                                             \
        auto r0 = __builtin_amdgcn_permlane32_swap(a0, b0, false, false); auto r1 = __builtin_amdgcn_permlane32_swap(a1, b1, false, false); \
        u32x4 w = {r0[0], r1[0], r0[1], r1[1]}; OUT = *reinterpret_cast<bf16x8*>(&w); } while (0)
    PK4(p0, 0, pa0); PK4(p0, 8, pa1); PK4(p1, 0, pa2); PK4(p1, 8, pa3);
#undef PK4
}
template <int KB, bool SK>
__device__ __forceinline__ void qkt(f32x16& p0, f32x16& p1, const char* K_lds, int r32, int hi, const bf16x8* qr, bool act) {
    if (SK && !act) { const float NEG = -__builtin_inff();
#pragma unroll
        for (int r = 0; r < 16; ++r) { p0[r] = NEG; p1[r] = NEG; } return; }
    p0 = f32x16{}; p1 = f32x16{};
    const char* kb[4];
#pragma unroll
    for (int dd = 0; dd < 4; ++dd) kb[dd] = K_lds + KB * SHM_K + KSWZ(r32, (dd * 16 + hi * 8) * 2);
#pragma unroll
    for (int d0 = 0; d0 < 8; ++d0) { const char* a = kb[d0 & 3] + (d0 >> 2) * 128;
        bf16x8 b0 = *reinterpret_cast<const bf16x8*>(a);
        bf16x8 b1 = *reinterpret_cast<const bf16x8*>(a + 32 * 256);
        p0 = __builtin_amdgcn_mfma_f32_32x32x16_bf16(b0, qr[d0], p0, 0, 0, 0);
        p1 = __builtin_amdgcn_mfma_f32_32x32x16_bf16(b1, qr[d0], p1, 0, 0, 0); }
}
template <int VB, bool SK>
__device__ __forceinline__ void pv_tile(f32x16* o, int vb0, bf16x8 pa0, bf16x8 pa1, bf16x8 pa2, bf16x8 pa3, bool act) {
    if (SK && !act) return;
#define TRRD(dst, off) asm volatile("ds_read_b64_tr_b16 %0, %1 offset:%2" : "=&v"(dst) : "v"(vb0), "i"(off) : "memory")
#define PV_D0(d0) do { s16x4 l0, l1, l2, l3, h0, h1, h2, h3; constexpr int b_ = VB * SHM_V + v_rd_off(d0, 0, 0);     \
        TRRD(l0, b_); TRRD(h0, b_ + 2048); TRRD(l1, b_ + 4096); TRRD(h1, b_ + 6144); TRRD(l2, b_ + 8192); TRRD(h2, b_ + 10240); TRRD(l3, b_ + 12288); TRRD(h3, b_ + 14336); \
        asm volatile("s_waitcnt lgkmcnt(0)" ::: "memory"); SBAR();                 \
        o[d0] = __builtin_amdgcn_mfma_f32_32x32x16_bf16(pa0, (bf16x8){l0[0], l0[1], l0[2], l0[3], h0[0], h0[1], h0[2], h0[3]}, o[d0], 0, 0, 0);   \
        o[d0] = __builtin_amdgcn_mfma_f32_32x32x16_bf16(pa1, (bf16x8){l1[0], l1[1], l1[2], l1[3], h1[0], h1[1], h1[2], h1[3]}, o[d0], 0, 0, 0);   \
        o[d0] = __builtin_amdgcn_mfma_f32_32x32x16_bf16(pa2, (bf16x8){l2[0], l2[1], l2[2], l2[3], h2[0], h2[1], h2[2], h2[3]}, o[d0], 0, 0, 0);   \
        o[d0] = __builtin_amdgcn_mfma_f32_32x32x16_bf16(pa3, (bf16x8){l3[0], l3[1], l3[2], l3[3], h3[0], h3[1], h3[2], h3[3]}, o[d0], 0, 0, 0); } while (0)
    PV_D0(0); PV_D0(1); PV_D0(2); PV_D0(3);
#undef PV_D0
#undef TRRD
}

template <class TIn, class TOut> struct BlockRef { const TIn* Q; const TIn* K; const TIn* V; TOut* O; const unsigned long long* M; int P0; };
template <class TIn> struct Seam {
    bf16x8 qr[8];
    bf16x8 st_v0, st_v1, st_k0, st_k1; f32x4 sf0, sf1, sf2, sf3;
    f32x4 tq[16];
};
__device__ __forceinline__ int swa_jlo(int P0, int W) { const int lowk = P0 - W + 1; return lowk > 0 ? lowk / KVBLK : 0; }
#define ROW(p, k0, rr) ((p) + (size_t)((k0) + (rr)) * PIN + sc)
#define VMW() asm volatile("s_waitcnt vmcnt(0)" ::: "memory")
#define VMWN(n) asm volatile("s_waitcnt vmcnt(%0)" :: "i"(n) : "memory")
#define SLOAD_H(Kp, Vp, k0) do { S.st_v0 = load8<TIn>(ROW(Vp, k0, sr)); S.st_v1 = load8<TIn>(ROW(Vp, k0, 32 + sr));              \
                         S.st_k0 = load8<TIn>(ROW(Kp, k0, sr)); S.st_k1 = load8<TIn>(ROW(Kp, k0, 32 + sr)); } while (0)
#define SWRITE_HK(bf) do { *(bf16x8*)(K_lds + (bf) * SHM_K + kws) = S.st_k0; *(bf16x8*)(K_lds + (bf) * SHM_K + kws + 32 * 256) = S.st_k1; } while (0)
#define SWRITE_HV(bf) do { *(bf16x8*)(V_lds + (bf) * SHM_V + vst0) = S.st_v0; *(bf16x8*)(V_lds + (bf) * SHM_V + vst1) = S.st_v1; } while (0)
#define SWRITE_H(bf) do { SWRITE_HV(bf); SWRITE_HK(bf); } while (0)
#define SLOAD_F(p, k0) do { S.sf0 = *(const f32x4*)ROW(p, k0, sr); S.sf1 = *(const f32x4*)(ROW(p, k0, sr) + 4);                \
                            S.sf2 = *(const f32x4*)ROW(p, k0, 32 + sr); S.sf3 = *(const f32x4*)(ROW(p, k0, 32 + sr) + 4); } while (0)
#define SWRITE_KF(bf) do { *(bf16x8*)(K_lds + (bf) * SHM_K + kws) = pack8(S.sf0, S.sf1); *(bf16x8*)(K_lds + (bf) * SHM_K + kws + 32 * 256) = pack8(S.sf2, S.sf3); } while (0)
#define SWRITE_VF(bf) do { *(bf16x8*)(V_lds + (bf) * SHM_V + vst0) = pack8(S.sf0, S.sf1); *(bf16x8*)(V_lds + (bf) * SHM_V + vst1) = pack8(S.sf2, S.sf3); } while (0)
template <class TIn, class TOut>
__device__ __forceinline__ void causal_swa_prime(const BlockRef<TIn, TOut>& cur, int W, char* lds, Seam<TIn>& S) {
    constexpr bool F32 = same_t<TIn, float>::v;
    const int tid = threadIdx.x, wid = __builtin_amdgcn_readfirstlane(tid >> 6), lane = tid & 63, r32 = lane & 31, hi = lane >> 5;
    const int sr = tid >> 4, sc = (tid & 15) * 8, kws = KSWZ(sr, sc * 2); char* K_lds = lds + 2 * SHM_V;
    const int kb0 = swa_jlo(cur.P0, W) * KVBLK;
    for (int d0 = 0; d0 < 8; ++d0) S.qr[d0] = load8<TIn>(cur.Q + (size_t)(wid * QBLK + r32) * PIN + d0 * 16 + hi * 8);
    if constexpr (F32) { SLOAD_F((const float*)cur.K, kb0); VMW(); SWRITE_KF(0); SBAR(); SLOAD_F((const float*)cur.V, kb0); }
    else { SLOAD_H(cur.K, cur.V, kb0); VMW(); SWRITE_HK(0); }
    __syncthreads();
}
template <class TIn, class TOut>
__device__ __forceinline__ void causal_swa_block(const BlockRef<TIn, TOut>& cur, const BlockRef<TIn, TOut>& nxt, int skv, int W, char* lds, Seam<TIn>& S) {
    constexpr bool F32 = same_t<TIn, float>::v;
    const int tid = threadIdx.x, wid = __builtin_amdgcn_readfirstlane(tid >> 6), lane = tid & 63, r32 = lane & 31, hi = lane >> 5;
    const int j_lo = swa_jlo(cur.P0, W);
    int j_hi = (cur.P0 + QB - 1) / KVBLK + 1; if (j_hi > skv / KVBLK) j_hi = skv / KVBLK;
    const int NT = j_hi - j_lo;
    const int kbn = swa_jlo(nxt.P0, W) * KVBLK;
    const unsigned* M32 = (const unsigned*)cur.M; const unsigned moff = (unsigned)((wid * QBLK + r32) * 128 + hi);
    const int qlo = cur.P0 + wid * QBLK;
    char* V_lds = lds; char* K_lds = lds + 2 * SHM_V;
    float* ws = (float*)(lds + 2 * SHM_V + 2 * SHM_K) + wid * 64; float* li_l = ws, * al_l = ws + 32;
    float m_reg = -1e30f, l_reg = 0; f32x16 o[4] = {};
    const int sr = tid >> 4, sc = (tid & 15) * 8, vst0 = v_st(sr, sc), vst1 = v_st(32 + sr, sc), kws = KSWZ(sr, sc * 2);
    const int vb0 = (int)(uintptr_t)V_lds + v_rd_base(lane);
    const TIn* Kh = cur.K; const TIn* Vh = cur.V;
#define RESC(a) do { if (__any((a) < 1.f)) { if (hi == 0) al_l[r32] = (a); asm volatile("s_waitcnt lgkmcnt(0)" ::: "memory");              \
                     for (int d_ = 0; d_ < 4; ++d_) for (int r = 0; r < 16; ++r) o[d_][r] *= al_l[crow(r, hi)]; } } while (0)
#define KBASE(t) ((j_lo + (t)) * KVBLK)
#define ACT(t) (KBASE(t) <= qlo + QBLK - 1 && KBASE(t) + KVBLK - 1 >= qlo - W + 1)
#define MASKT(P0_, P1_, t) do { bitmask_tile(P0_, P1_, mwn); } while (0)
    constexpr int NQL = F32 ? 16 : 8;
    constexpr bool SK = WSKIP && !F32;
#define SEAM_K0() do { VMWN(NQL); if constexpr (F32) { SWRITE_KF(0); SBAR(); SLOAD_F((const float*)nxt.V, kbn); } else { SWRITE_HK(0); } SBAR(); } while (0)
    f32x16 pA0, pA1, pB0, pB1; float mnA, mnB, alA, alB; bf16x8 pa0, pa1, pa2, pa3;
    if constexpr (F32) { VMW(); SWRITE_VF(0); SBAR(); } else { SWRITE_HV(0); SBAR(); }
    if (NT > 1) { if constexpr (F32) SLOAD_F((const float*)Kh, KBASE(1)); else SLOAD_H(Kh, Vh, KBASE(1)); }
    unsigned mwn = M32[moff + 2 * j_lo]; SBAR(); qkt<0, SK>(pA0, pA1, K_lds, r32, hi, S.qr, ACT(0));
    if constexpr (F32) { if (NT > 1) { VMW(); SWRITE_KF(1); SBAR(); SLOAD_F((const float*)Vh, KBASE(1)); } }
    MASKT(pA0, pA1, 0); partialSM(pA0, pA1, m_reg, mnA, alA);
    if (NT > 1) { VMW(); if constexpr (F32) { SWRITE_VF(1); SBAR(); if (NT > 2) SLOAD_F((const float*)Kh, KBASE(2)); } else SWRITE_H(1); }
    __syncthreads();
#define HALF_STEP(PX0, PX1, mnX, alX, PY0, PY1, alY, t, KB, VB, SB) do {                                                      \
        mwn = M32[moff + 2 * (j_lo + (t))]; SBAR(); qkt<KB, SK>(PX0, PX1, K_lds, r32, hi, S.qr, ACT(t));             \
        finishSM(PY0, PY1, alY, l_reg, pa0, pa1, pa2, pa3); SBAR();                                                           \
        if ((t) + 1 < NT) { if constexpr (F32) { VMW(); SWRITE_KF(SB); SBAR(); SLOAD_F((const float*)Vh, KBASE((t) + 1)); }  \
                            else { SLOAD_H(Kh, Vh, KBASE((t) + 1)); } SBAR(); }                                               \
        pv_tile<VB, SK>(o, vb0, pa0, pa1, pa2, pa3, ACT((t) - 1)); MASKT(PX0, PX1, (t)); partialSM(PX0, PX1, m_reg, mnX, alX);                                        \
        __syncthreads();                                                                                                      \
        if ((t) + 1 < NT) { VMW(); if constexpr (F32) { SWRITE_VF(SB); SBAR(); if ((t) + 2 < NT) SLOAD_F((const float*)Kh, KBASE((t) + 2)); } \
                            else { SWRITE_H(SB); } }                                                                          \
        RESC(alX); __syncthreads(); } while (0)
    for (int t = 1; t + 1 < NT; t += 2) {
        HALF_STEP(pB0, pB1, mnB, alB, pA0, pA1, alA, t, 1, 0, 0);
        HALF_STEP(pA0, pA1, mnA, alA, pB0, pB1, alB, t + 1, 0, 1, 1);
    }
    const bool even = (NT & 1) == 0;
    if (even) { mwn = M32[moff + 2 * (j_lo + NT - 1)]; SBAR(); qkt<1, SK>(pB0, pB1, K_lds, r32, hi, S.qr, ACT(NT - 1)); SBAR(); }
#define QROW(e) (nxt.Q + (size_t)(wid * QBLK + r32) * PIN + ((e) >> 1) * 16 + hi * 8 + ((e) & 1) * 4)
    if constexpr (F32) { SLOAD_F((const float*)nxt.K, kbn); SBAR();
#pragma unroll
        for (int e = 0; e < 8; ++e) S.tq[e] = *(const f32x4*)QROW(e); }
    else { SLOAD_H(nxt.K, nxt.V, kbn); SBAR();
#pragma unroll
        for (int d0 = 0; d0 < 8; ++d0) S.qr[d0] = load8<TIn>(nxt.Q + (size_t)(wid * QBLK + r32) * PIN + d0 * 16 + hi * 8); }
    SBAR();
    finishSM(pA0, pA1, alA, l_reg, pa0, pa1, pa2, pa3); SBAR();
    if constexpr (F32) {
#pragma unroll
        for (int e = 8; e < 16; ++e) S.tq[e] = *(const f32x4*)QROW(e); SBAR(); }
#undef QROW
    pv_tile<0, SK>(o, vb0, pa0, pa1, pa2, pa3, ACT(even ? NT - 2 : NT - 1));
    if (even) { MASKT(pB0, pB1, NT - 1); partialSM(pB0, pB1, m_reg, mnB, alB); __syncthreads(); RESC(alB);
        finishSM(pB0, pB1, alB, l_reg, pa0, pa1, pa2, pa3); SBAR(); pv_tile<1, SK>(o, vb0, pa0, pa1, pa2, pa3, ACT(NT - 1)); }
    SBAR(); SEAM_K0();
    if (hi == 0) li_l[r32] = l_reg; asm volatile("s_waitcnt lgkmcnt(0)" ::: "memory");
    float rli[16];
#pragma unroll
    for (int r = 0; r < 16; ++r) rli[r] = __builtin_amdgcn_rcpf(li_l[crow(r, hi)]);
    TOut* Ow = cur.O + (size_t)(wid * QBLK) * POUT;
#pragma unroll
    for (int r = 0; r < 16; ++r) { const int orow = crow(r, hi);
#pragma unroll
        for (int d0 = 0; d0 < 4; ++d0) { const float v = o[d0][r] * rli[r];
            if constexpr (same_t<TOut, float>::v) { Ow[(size_t)orow * POUT + d0 * 32 + r32] = v; }
            else { const float vn = __shfl_xor(v, 1);
                   if ((r32 & 1) == 0) *(unsigned*)(Ow + (size_t)orow * POUT + d0 * 32 + r32) = cvtpk(v, vn); } } }
    if constexpr (F32) {
#pragma unroll
        for (int d0 = 0; d0 < 8; ++d0) S.qr[d0] = pack8(S.tq[2 * d0], S.tq[2 * d0 + 1]); }
    __syncthreads();
#undef RESC
#undef KBASE
#undef ACT
#undef MASKT
#undef SEAM_K0
#undef HALF_STEP
}
#undef ROW
#undef VMW
#undef VMWN
#undef SLOAD_H
#undef SWRITE_HK
#undef SWRITE_HV
#undef SWRITE_H
#undef SLOAD_F
#undef SWRITE_KF
#undef SWRITE_VF

}
typedef GAS unsigned gu32;
#define XB_TMO      128
#define XB_XCNT(j)  (256  + 64 * (j))
#define XB_XSUB(j)  (1280 + 64 * (j))
#define XB_XGEN(j)  (2304 + 64 * (j))
#define XB_TOP      3328
#define XB_TOPGEN   3392
#define XCD_BAR_WORDS 3456
#define XB_SPIN_CAP (1u << 18)

__device__ __forceinline__ unsigned xb_ld(unsigned* p)              { return __hip_atomic_load(p, __ATOMIC_RELAXED, __HIP_MEMORY_SCOPE_AGENT); }
__device__ __forceinline__ unsigned xb_add(unsigned* p, unsigned v) { return __hip_atomic_fetch_add(p, v, __ATOMIC_RELAXED, __HIP_MEMORY_SCOPE_AGENT); }
__device__ __forceinline__ unsigned xb_xcc_id() { return (unsigned)__builtin_amdgcn_s_getreg((3 << 11) | 20) & 0xFu; }
#define XB_SPIN(cond, bar) do { unsigned _sp = 0; while (cond) { __builtin_amdgcn_s_sleep(1); \
    if ((++_sp & 255u) == 0u) { if (xb_ld(&(bar)[XB_TMO])) break; if (_sp > XB_SPIN_CAP) { atomicAdd(&(bar)[XB_TMO], 1u); break; } } } } while (0)

struct XcdBarrier {
    unsigned* bar; unsigned x;
    volatile LAS unsigned* st;
};

__device__ __forceinline__ XcdBarrier xcd_barrier_post(unsigned* bar, volatile LAS unsigned* st) {
    XcdBarrier b; b.bar = bar; b.x = xb_xcc_id(); b.st = st;
    if (threadIdx.x == 0) (void)xb_add(&bar[XB_XCNT(b.x)], 1u);
    return b;
}
__device__ __forceinline__ void xcd_barrier_complete(unsigned* bar, unsigned x, unsigned& nloc, unsigned& nx) {
    const unsigned G = gridDim.x * gridDim.y * gridDim.z;
    unsigned sum, cnt, mine, sp = 0u;
    for (;;) {
        sum = 0u; cnt = 0u; mine = 0u;
#pragma unroll
        for (unsigned j = 0; j < 16; ++j) { const unsigned c = xb_ld(&bar[XB_XCNT(j)]); sum += c; cnt += (c > 0u) ? 1u : 0u; mine = (j == x) ? c : mine; }
        if (sum == G) break;
        __builtin_amdgcn_s_sleep(1);
        if ((++sp & 255u) == 0u) { if (xb_ld(&bar[XB_TMO])) break; if (sp > XB_SPIN_CAP) { atomicAdd(&bar[XB_TMO], 1u); break; } }
    }
    nloc = mine > 0u ? mine : 1u; nx = cnt > 0u ? cnt : 1u;
}

__device__ __forceinline__ void xcd_barrier(const XcdBarrier& b) {
    asm volatile("s_waitcnt vmcnt(0)" ::: "memory");
    __syncthreads();
    if (threadIdx.x == 0) {
        unsigned* bar = b.bar;
        __builtin_amdgcn_s_waitcnt(0);
        unsigned nloc = b.st[0], nx = b.st[1];
        if (nloc == 0u) { xcd_barrier_complete(bar, b.x, nloc, nx); b.st[0] = nloc; b.st[1] = nx; }
        const unsigned old = xb_add(&bar[XB_XSUB(b.x)], 1u);
        const unsigned gen = old / nloc;
        if (old + 1u == (gen + 1u) * nloc) {
            __builtin_amdgcn_fence(__ATOMIC_RELEASE, "agent");
            asm volatile("s_waitcnt vmcnt(0)" ::: "memory");
            const unsigned og = xb_add(&bar[XB_TOP], 1u);
            const unsigned tg = og / nx;
            if (og + 1u == (tg + 1u) * nx) xb_add(&bar[XB_TOPGEN], 1u);
            else XB_SPIN(xb_ld(&bar[XB_TOPGEN]) == tg, bar);
            __builtin_amdgcn_fence(__ATOMIC_ACQUIRE, "agent");
            xb_add(&bar[XB_XGEN(b.x)], 1u);
            asm volatile("s_waitcnt vmcnt(0)" ::: "memory");
        } else {
            XB_SPIN(xb_ld(&bar[XB_XGEN(b.x)]) == gen, bar);
            __builtin_amdgcn_fence(__ATOMIC_ACQUIRE, "agent");
            asm volatile("s_waitcnt vmcnt(0)" ::: "memory");
        }
    }
    __syncthreads();
}

constexpr int LDS_BYTES = 147456;
constexpr int MISC_OFF = LDS_BYTES - 256;
constexpr int NWAVES = 8;

struct Args { const void* in[23]; float* out; unsigned char* ws; int ph_lo, ph_hi; };
enum { I_X = 0, I_C, I_POS, I_WADA, I_BADA, I_WIN, I_CONVW, I_CONVB, I_WRGA, I_BRGA, I_WRGX, I_BRGX, I_LAM, I_KIDXG, I_WOUT, I_LN1G, I_LN1B, I_WPQ, I_SUBK, I_PU, I_PV, I_LN2G, I_LN2B };

struct Ctx { LAS unsigned char* lds; unsigned char* ws; int tid, lane, wave, bid, G, gw, ngw; };

__device__ __forceinline__ f32x4 mfma16(bf16x8 a, bf16x8 b, f32x4 c) { return __builtin_amdgcn_mfma_f32_16x16x32_bf16(a, b, c, 0, 0, 0); }
__device__ __forceinline__ f32x16 mfma32(bf16x8 a, bf16x8 b, f32x16 c) { return __builtin_amdgcn_mfma_f32_32x32x16_bf16(a, b, c, 0, 0, 0); }

__device__ __forceinline__ void transpose_item(const float* W, int K, int N, bf16* WT, LAS float* scr, int item, int lane) {
    const int nblk = (N + 31) / 32, kb = item / nblk, nb = item % nblk, k0 = 64 * kb, n0 = 32 * nb;
    const int nc = n0 + (lane & 31); const bool okc = nc < N;
#pragma unroll 8
    for (int i = 0; i < 32; ++i) { const int kk = 2 * i + (lane >> 5); scr[kk * 33 + (lane & 31)] = okc ? W[(size_t)(k0 + kk) * N + nc] : 0.f; }
    LDS_WAIT(); asm volatile("" ::: "memory");
    const int c = lane & 7;
#pragma unroll
    for (int j = 0; j < 4; ++j) { const int n = (lane >> 3) + 8 * j; const LAS float* s = scr + (8 * c) * 33 + n;
        v4u o; o.x = pk2(s[0 * 33], s[1 * 33]); o.y = pk2(s[2 * 33], s[3 * 33]); o.z = pk2(s[4 * 33], s[5 * 33]); o.w = pk2(s[6 * 33], s[7 * 33]);
        if (n0 + n < N) *(v4u*)(WT + (size_t)(n0 + n) * K + k0 + 8 * c) = o; }
    LDS_WAIT(); asm volatile("" ::: "memory");
}
__device__ __forceinline__ void convert_stream(const float* src, bf16* dst, size_t n, int gw, int ngw, int lane) {
    const size_t niter = n / 512;
#pragma unroll 4
    for (size_t i = gw; i < niter; i += ngw) { const size_t e = i * 512 + (size_t)lane * 8;
        const f32x4 a = *(const f32x4*)(src + e), b = *(const f32x4*)(src + e + 4);
        v4u o; o.x = pk2(a.x, a.y); o.y = pk2(a.z, a.w); o.z = pk2(b.x, b.y); o.w = pk2(b.z, b.w);
        *(v4u*)(dst + e) = o; }
}
__device__ __forceinline__ unsigned fp4_code(float v) {
    const float a = fabsf(v);
    const float q = a < 2.0f ? 2.0f * a : (a < 4.0f ? a + 2.0f : 0.5f * a + 4.0f);
    unsigned cde = (unsigned)(int)rintf(q); cde = cde > 7u ? 7u : cde;
    return cde | ((__builtin_bit_cast(unsigned, v) >> 31) << 3);
}
constexpr int FPQ_ROWB = 1024;
template <int NR>
__device__ __forceinline__ void convert_rows_fpq(const float* src, unsigned char* dst, bf16* inv_scale, int row0, int lane) {
    f32x4 v[NR][2][4];
#pragma unroll
    for (int r = 0; r < NR; ++r)
#pragma unroll
        for (int cc = 0; cc < 2; ++cc)
#pragma unroll
            for (int w = 0; w < 4; ++w) v[r][cc][w] = *(const f32x4*)(src + (size_t)(row0 + r) * DM + 1024 * cc + 16 * lane + 4 * w);
#pragma unroll
    for (int r = 0; r < NR; ++r) { const int row = row0 + r; float mx = 0.f;
#pragma unroll
        for (int cc = 0; cc < 2; ++cc)
#pragma unroll
            for (int w = 0; w < 4; ++w) mx = fmaxf(mx, fmaxf(fmaxf(fabsf(v[r][cc][w].x), fabsf(v[r][cc][w].y)), fmaxf(fabsf(v[r][cc][w].z), fabsf(v[r][cc][w].w))));
        const unsigned sb = f2bf(mx > 0.f ? mx * (1.0f / 6.0f) : 1.0f);
        const float sc = 1.0f / bf2f((bf16)sb);
        inv_scale[(size_t)row * 64 + lane] = (bf16)sb;
        v4u pa;
#pragma unroll
        for (int k = 0; k < 4; ++k) { const f32x4 e0 = v[r][k >> 1][2 * (k & 1)] * sc, e1 = v[r][k >> 1][2 * (k & 1) + 1] * sc; unsigned w = 0u;
            w = __builtin_amdgcn_cvt_scalef32_pk_fp4_f32(w, e0.x, e0.y, 1.0f, 0); w = __builtin_amdgcn_cvt_scalef32_pk_fp4_f32(w, e0.z, e0.w, 1.0f, 1);
            w = __builtin_amdgcn_cvt_scalef32_pk_fp4_f32(w, e1.x, e1.y, 1.0f, 2); w = __builtin_amdgcn_cvt_scalef32_pk_fp4_f32(w, e1.z, e1.w, 1.0f, 3); pa[k] = w; }
        *(v4u*)(dst + (size_t)row * FPQ_ROWB + 16 * lane) = pa; }
}
__device__ __forceinline__ void p0_prologue(const Ctx& c, const Args& a) {
    const int tid = c.tid, lane = c.lane, gw = c.gw, ngw = c.ngw;
    LAS float* sl = (LAS float*)(c.lds + 8 * 8448);
    { const float* cc = (const float*)a.in[I_C];
      for (int i = tid; i < 2 * DM; i += 512) { const float v = cc[i]; sl[i] = v / (1.0f + __expf(-v)); } }
    __syncthreads();
    { const float* W = (const float*)a.in[I_WADA]; float* MODP = (float*)(c.ws + WS_MODP); LAS float* red = (LAS float*)(c.lds + 8 * 8448 + 16384);
      for (int it = c.bid; it < 48 * 4; it += c.G) { const int cg = it % 48, kq = it / 48, col = cg * 256 + lane * 4, k0 = kq * 512 + c.wave * 64;
          f32x4 a0 = {0.f, 0.f, 0.f, 0.f}, a1 = {0.f, 0.f, 0.f, 0.f};
#pragma unroll 16
          for (int kk = 0; kk < 64; ++kk) { const f32x4 w = *(const f32x4*)(W + (size_t)(k0 + kk) * (6 * DM) + col); const float s0 = sl[k0 + kk], s1 = sl[DM + k0 + kk]; a0 += w * s0; a1 += w * s1; }
          *(LAS f32x4*)(red + (c.wave * 2 + 0) * 256 + lane * 4) = a0; *(LAS f32x4*)(red + (c.wave * 2 + 1) * 256 + lane * 4) = a1;
          __syncthreads();
          { const int b = tid >> 8, cc = tid & 255; float s = 0.f;
#pragma unroll
            for (int w = 0; w < 8; ++w) s += red[(w * 2 + b) * 256 + cc];
            MODP[((size_t)kq * 2 + b) * (6 * DM) + cg * 256 + cc] = s; }
          __syncthreads(); } }
    LAS float* scr = (LAS float*)(c.lds + c.wave * 8448);
    { constexpr int I_IN = (DM / 64) * ((DIN + 31) / 32), I_SQ = (DM / 64) * (DM / 32), I_G = 8 * 2 * 4;
      for (int it = gw; it < I_IN + 2 * I_SQ + 2 * I_G; it += ngw) { int r = it;
          if (r < I_IN) { transpose_item((const float*)a.in[I_WIN], DM, DIN, (bf16*)(c.ws + WS_WIN), scr, r, lane); continue; } r -= I_IN;
          if (r < I_SQ) { transpose_item((const float*)a.in[I_WOUT], DM, DM, (bf16*)(c.ws + WS_WOUT), scr, r, lane); continue; } r -= I_SQ;
          if (r < I_SQ) { transpose_item((const float*)a.in[I_WPQ], DM, DM, (bf16*)(c.ws + WS_WPQ), scr, r, lane); continue; } r -= I_SQ;
          if (r < I_G) { const int n = r / 8; transpose_item((const float*)a.in[I_WRGA] + n * 16384, 128, 128, (bf16*)(c.ws + WS_WRG) + n * 16384, scr, r % 8, lane); continue; } r -= I_G;
          { const int n = r / 8; transpose_item((const float*)a.in[I_WRGX] + n * 16384, 128, 128, (bf16*)(c.ws + WS_WRG) + (8 + n) * 16384, scr, r % 8, lane); } } }
    convert_stream((const float*)a.in[I_SUBK], (bf16*)(c.ws + WS_SUBK), (size_t)8 * 2 * 128 * 128, gw, ngw, lane);
    __syncthreads();
}

__device__ __forceinline__ void p1_u1(const Ctx& c, const Args& a) {
    const int tid = c.tid, lane = c.lane;
    const float* MODP = (const float*)(c.ws + WS_MODP); const float* bada = (const float*)a.in[I_BADA]; float* MODF = (float*)(c.ws + WS_MODF);
    { const int g = c.bid * 512 + tid;
      for (int e = g; e < 2 * 6 * DM; e += c.G * 512) { const int b = e / (6 * DM), j = e % (6 * DM); MODF[e] = bada[j] + ((MODP[((size_t)0 * 2 + b) * (6 * DM) + j] + MODP[((size_t)1 * 2 + b) * (6 * DM) + j]) + (MODP[((size_t)2 * 2 + b) * (6 * DM) + j] + MODP[((size_t)3 * 2 + b) * (6 * DM) + j])); }
      const int* pos = (const int*)a.in[I_POS]; float* CS = (float*)(c.ws + WS_ROPE);
      for (int i = g; i < NTOK * 24; i += c.G * 512) { const int tk = i / 24, j = i % 24;
          const float ex = j < 16 ? -(float)j / 16.0f : -(float)(j - 16) / 8.0f;
          const float inv = exp2f(ex * 18.931568569324174f);
          const float ang = (float)pos[tk] * inv;
          double rev = (double)ang * 0.15915494309189535; rev -= floor(rev);
          if (rev > 0.5) rev -= 1.0;
          const float rr = (float)(rev * 6.283185307179586);
          float sn, cs; sincosf(rr, &sn, &cs);
          if (j < 16) { CS[tk * 48 + j] = cs; CS[tk * 48 + 16 + j] = sn; } else { CS[tk * 48 + 32 + (j - 16)] = cs; CS[tk * 48 + 40 + (j - 16)] = sn; } } }
    LAS float* ms = (LAS float*)c.lds;
    for (int i = tid; i < 2 * 2 * DM; i += 512) { const int b = i / (2 * DM), j = i % (2 * DM); ms[i] = bada[j] + ((MODP[((size_t)0 * 2 + b) * (6 * DM) + j] + MODP[((size_t)1 * 2 + b) * (6 * DM) + j]) + (MODP[((size_t)2 * 2 + b) * (6 * DM) + j] + MODP[((size_t)3 * 2 + b) * (6 * DM) + j])); }
    __syncthreads();
    const float* x = (const float*)a.in[I_X]; bf16* U1 = (bf16*)(c.ws + WS_U1);
    for (int row = c.gw; row < NTOK; row += c.ngw) { const int b = row / SEQ;
        const f32x4* xr = (const f32x4*)(x + (size_t)row * DM) + lane;
        f32x4 v[8]; float s = 0.f;
#pragma unroll
        for (int j = 0; j < 8; ++j) { v[j] = xr[64 * j]; s += (v[j].x + v[j].y) + (v[j].z + v[j].w); }
        const float mean = wave_sum(s) * (1.f / DM); float s2 = 0.f;
#pragma unroll
        for (int j = 0; j < 8; ++j) { v[j] = v[j] - mean; s2 += (v[j].x * v[j].x + v[j].y * v[j].y) + (v[j].z * v[j].z + v[j].w * v[j].w); }
        const float rstd = 1.f / sqrtf(wave_sum(s2) * (1.f / DM) + LN_EPS);
#pragma unroll
        for (int j = 0; j < 8; ++j) { const int col = 4 * lane + 256 * j;
            const f32x4 sh = *(const LAS f32x4*)(ms + b * 4096 + col), sc = *(const LAS f32x4*)(ms + b * 4096 + DM + col);
            const f32x4 y = v[j] * rstd * (sc + 1.0f) + sh;
            v2u o; o.x = pk2(y.x, y.y); o.y = pk2(y.z, y.w);
            *(v2u*)(U1 + (size_t)row * DM + col) = o; }
    }
    __syncthreads();
}

__device__ __forceinline__ void p3_post(const Ctx& c, const Args& a) {
    const int tid = c.tid, lane = c.lane, wave = c.wave, fr = lane & 15, fq = lane >> 4;
    bf16* PROJ = (bf16*)(c.ws + WS_PROJ); const bf16* U1 = (const bf16*)(c.ws + WS_U1); const bf16* WinT = (const bf16*)(c.ws + WS_WIN);
    for (int it = c.bid; it < NTOK / 32; it += c.G) {
        const int t0 = it * 32, b = t0 / SEQ;
        LAS float* red = (LAS float*)c.lds;
        LAS float* kw = red + 8 * 32 * 80;
        { f32x4 acc[2][5];
#pragma unroll
          for (int m = 0; m < 2; ++m)
#pragma unroll
              for (int n = 0; n < 5; ++n) acc[m][n] = (f32x4){0.f, 0.f, 0.f, 0.f};
          for (int ks = 0; ks < 8; ++ks) { const int kb = wave * 256 + ks * 32 + 8 * fq;
              const bf16x8 a0 = *(const bf16x8*)(U1 + (size_t)(t0 + fr) * DM + kb), a1 = *(const bf16x8*)(U1 + (size_t)(t0 + 16 + fr) * DM + kb);
#pragma unroll
              for (int n = 0; n < 5; ++n) { const bf16x8 bb = *(const bf16x8*)(WinT + (size_t)(NMAIN + 16 * n + fr) * DM + kb);
                  acc[0][n] = mfma16(a0, bb, acc[0][n]); acc[1][n] = mfma16(a1, bb, acc[1][n]); } }
#pragma unroll
          for (int m = 0; m < 2; ++m)
#pragma unroll
              for (int n = 0; n < 5; ++n)
#pragma unroll
                  for (int r = 0; r < 4; ++r) red[(wave * 32 + 16 * m + 4 * fq + r) * 80 + 16 * n + fr] = acc[m][n][r]; }
        __syncthreads();
        for (int i = tid; i < 32 * 80; i += 512) { float s = 0.f;
#pragma unroll
            for (int w = 0; w < 8; ++w) s += red[w * 2560 + i];
            kw[i] = s; }
        __syncthreads();
        { const float* kg = (const float*)a.in[I_KIDXG]; const float* CS = (const float*)(c.ws + WS_ROPE);
#pragma unroll
          for (int i4 = 0; i4 < 4; ++i4) { const int tk = wave * 4 + i4, tok = t0 + tk;
              const float v = kw[tk * 80 + lane]; const float mean = wave_sum(v) * (1.f / 64.f); const float dv = v - mean;
              const float rstd = 1.f / sqrtf(wave_sum(dv * dv) * (1.f / 64.f) + LN_EPS);
              float y = dv * rstd * kg[lane]; const float py = __shfl_xor(y, 8);
              if (lane < 16) { const float cs = CS[(size_t)tok * 48 + 32 + (lane & 7)], sn = CS[(size_t)tok * 48 + 40 + (lane & 7)]; y = lane < 8 ? y * cs - py * sn : y * cs + py * sn; }
              ((bf16*)(c.ws + WS_KIDX))[(size_t)tok * 64 + lane] = (bf16)f2bf(y);
              if (lane < 16) ((float*)(c.ws + WS_WIDX))[(size_t)tok * 16 + lane] = kw[tk * 80 + 64 + lane] * (0.25f * 0.125f); } }
        __syncthreads();
        { const int n = wave; LAS float* xcs = (LAS float*)c.lds + wave * (32 * 132);
          const float* convw = (const float*)a.in[I_CONVW]; const float* convb = (const float*)a.in[I_CONVB]; const bf16* WRG = (const bf16*)(c.ws + WS_WRG);
          const float* brga = (const float*)a.in[I_BRGA]; const float* brgx = (const float*)a.in[I_BRGX]; const float* lam = (const float*)a.in[I_LAM];
          float* AG = (float*)(c.ws + WS_AG); float* BG = (float*)(c.ws + WS_BG);
#pragma unroll 1
          for (int m = 0; m < 2; ++m) { const int tk = 16 * m + fr, tok = t0 + tk;
              f32x4 accA[8], accX[8];
#pragma unroll
              for (int nt = 0; nt < 8; ++nt) { accA[nt] = (f32x4){0.f, 0.f, 0.f, 0.f}; accX[nt] = (f32x4){0.f, 0.f, 0.f, 0.f}; }
#pragma unroll 1
              for (int ks = 0; ks < 4; ++ks) { int fq8 = 8 * fq; asm volatile("" : "+v"(fq8));
                  const int chl = ks * 32 + fq8, ch = n * 128 + chl;
                  f32x4 x0 = *(const f32x4*)(convb + ch), x1 = *(const f32x4*)(convb + ch + 4);
#pragma unroll
                  for (int j = 0; j < 4; ++j) { const int tt = tok - 3 + j;
                      if (tt >= b * SEQ) { const v4u raw = *(const v4u*)(PROJ + (size_t)tt * NMAIN + C_XL + ch);
                          const f32x4 w0 = *(const f32x4*)(convw + j * D_LRU + ch), w1 = *(const f32x4*)(convw + j * D_LRU + ch + 4);
                          x0.x += w0.x * bflo(raw.x); x0.y += w0.y * bfhi(raw.x); x0.z += w0.z * bflo(raw.y); x0.w += w0.w * bfhi(raw.y);
                          x1.x += w1.x * bflo(raw.z); x1.y += w1.y * bfhi(raw.z); x1.z += w1.z * bflo(raw.w); x1.w += w1.w * bfhi(raw.w); } }
                  *(LAS f32x4*)(xcs + tk * 132 + chl) = x0; *(LAS f32x4*)(xcs + tk * 132 + chl + 4) = x1;
                  v4u o; o.x = pk2(x0.x, x0.y); o.y = pk2(x0.z, x0.w); o.z = pk2(x1.x, x1.y); o.w = pk2(x1.z, x1.w);
                  const bf16x8 af = __builtin_bit_cast(bf16x8, o);
#pragma unroll
                  for (int nt = 0; nt < 8; ++nt) { const size_t wo = ((size_t)n * 128 + 16 * nt + fr) * 128 + ks * 32 + fq8;
                      const bf16x8 ba = *(const bf16x8*)(WRG + wo), bx = *(const bf16x8*)(WRG + (size_t)8 * 16384 + wo);
                      accA[nt] = mfma16(af, ba, accA[nt]); accX[nt] = mfma16(af, bx, accX[nt]); } }
              LDS_WAIT(); asm volatile("" ::: "memory");
#pragma unroll
              for (int nt = 0; nt < 8; ++nt) { const int chl = 16 * nt + fr, ch = n * 128 + chl;
                  const float ba_ = brga[ch], bx_ = brgx[ch], sp = log1pf(__expf(-lam[ch]));
#pragma unroll
                  for (int r = 0; r < 4; ++r) { const int tk2 = 16 * m + 4 * fq + r;
                      const float ra = sigmoidf_(accA[nt][r] + ba_), ix = sigmoidf_(accX[nt][r] + bx_);
                      const float la = -8.0f * ra * sp, av = __expf(la), bc = sqrtf(-expm1f(2.0f * la)), xv = xcs[tk2 * 132 + chl];
                      AG[(size_t)(t0 + tk2) * D_LRU + ch] = av; BG[(size_t)(t0 + tk2) * D_LRU + ch] = bc * ix * xv; } } } }
        __syncthreads();
    }
}

__device__ __forceinline__ void p4_lru_scan(const Ctx& c) {
    float* AG = (float*)(c.ws + WS_AG); float* BG = (float*)(c.ws + WS_BG); float* AGG = (float*)(c.ws + WS_AGG);
    for (int li = c.gw; li < 2048; li += c.ngw) { const int b = li >> 10, ck = (li >> 4) & 63, ch = (li & 15) * 64 + c.lane; const size_t base = ((size_t)b * SEQ + ck * 64) * D_LRU + ch;
        float h = 0.f, P = 1.f;
        for (int t8 = 0; t8 < 64; t8 += 8) { float av[8], bv[8];
#pragma unroll
            for (int t = 0; t < 8; ++t) { av[t] = AG[base + (size_t)(t8 + t) * D_LRU]; bv[t] = BG[base + (size_t)(t8 + t) * D_LRU]; }
#pragma unroll
            for (int t = 0; t < 8; ++t) { h = av[t] * h + bv[t]; P *= av[t]; av[t] = P; bv[t] = h; }
#pragma unroll
            for (int t = 0; t < 8; ++t) { AG[base + (size_t)(t8 + t) * D_LRU] = av[t]; BG[base + (size_t)(t8 + t) * D_LRU] = bv[t]; } }
        AGG[((size_t)(0 * 2 + b) * 64 + ck) * D_LRU + ch] = P; AGG[((size_t)(1 * 2 + b) * 64 + ck) * D_LRU + ch] = h; }
}

constexpr int IDX_ROWB = 144;
constexpr int IDX_TILE = 256, IDX_BUFB = IDX_TILE * IDX_ROWB;
__device__ __forceinline__ void p4_indexer_item(const Ctx& c, int b, int q0) {
    const int tid = c.tid, lane = c.lane, wave = c.wave, r32 = lane & 31, hh = lane >> 5;
    const bf16* PROJ = (const bf16*)(c.ws + WS_PROJ); const bf16* KIDX = (const bf16*)(c.ws + WS_KIDX); const float* WIDX = (const float*)(c.ws + WS_WIDX);
    const int n = 64 * (q0 / 64 + 1), ntile = (n + IDX_TILE - 1) / IDX_TILE, nj = n / 32;
    const int tokA = b * SEQ + q0 + 2 * wave, myq = tokA + ((r32 >> 2) & 1), myh = (r32 & 3) + 4 * (r32 >> 3);
    bf16x8 af[4];
#pragma unroll
    for (int s = 0; s < 4; ++s) af[s] = *(const bf16x8*)(PROJ + (size_t)myq * NMAIN + C_QI + myh * 64 + 16 * s + 8 * hh);
    float wv[16];
#pragma unroll
    for (int r = 0; r < 16; ++r) wv[r] = WIDX[(size_t)(tokA + hh) * 16 + r];
    const int skey = tid >> 1, shalf = tid & 1;
    const bf16* kbase = KIDX + (size_t)b * SEQ * 64;
    v4u st[4];
    auto stage_load = [&](int tile) { int key = tile * IDX_TILE + skey; key = key < SEQ ? key : SEQ - 1;
#pragma unroll
        for (int q = 0; q < 4; ++q) st[q] = *(const v4u*)(kbase + (size_t)key * 64 + shalf * 32 + 8 * q); };
    auto stage_write = [&](int buf) {
#pragma unroll
        for (int q = 0; q < 4; ++q) *(LAS v4u*)(c.lds + buf * IDX_BUFB + skey * IDX_ROWB + shalf * 64 + 16 * q) = st[q]; };
    unsigned key_[128];
    for (int srep = 0; srep < NREP(42); ++srep) {
    stage_load(0); stage_write(0); __syncthreads();
#pragma unroll
    for (int tile = 0; tile < 16; ++tile) {
        if (tile < ntile) {
            if (tile + 1 < ntile) stage_load(tile + 1);
            const LAS unsigned char* kb = c.lds + (tile & 1) * IDX_BUFB + r32 * IDX_ROWB + hh * 16;
#pragma unroll
            for (int jj = 0; jj < 8; ++jj) { const int j = tile * 8 + jj;
                if (j < nj) {
                    f32x16 acc = {};
#pragma unroll
                    for (int s = 0; s < 4; ++s) { const bf16x8 bb = *(const LAS bf16x8*)(kb + jj * 32 * IDX_ROWB + s * 32); acc = mfma32(af[s], bb, acc); }
                    float sc = 0.f;
#pragma unroll
                    for (int r = 0; r < 16; ++r) sc += wv[r] * fmaxf(acc[r], 0.f);
                    const unsigned u = __builtin_bit_cast(unsigned, sc);
                    key_[j] = (u & 0x80000000u) ? ~u : (u | 0x80000000u);
                } else key_[j] = 0u; }
            if (tile + 1 < ntile) stage_write((tile + 1) & 1);
            __syncthreads();
        } else {
#pragma unroll
            for (int jj = 0; jj < 8; ++jj) key_[tile * 8 + jj] = 0u;
        }
    } }
    unsigned prefix = 0u;
    for (int brep = 0; brep < NREP(41); ++brep) { prefix = 0u;
    for (int bit = 31; bit >= 0; --bit) { const unsigned cand = prefix | (1u << bit); int cnt = 0;
#pragma unroll
        for (int g = 0; g < 8; ++g) if (g * 16 < nj) {
#pragma unroll
            for (int jj = 0; jj < 16; ++jj) cnt += (key_[g * 16 + jj] >= cand) ? 1 : 0; }
#pragma unroll
        for (int o = 1; o < 32; o <<= 1) cnt += __shfl_xor(cnt, o);
        if (cnt >= 256) prefix = cand; } }
    unsigned wA0 = 0u, wA1 = 0u, wB0 = 0u, wB1 = 0u;
#define CMP16(x_) (((x_) & 0xFu) | (((x_) >> 4) & 0xF0u) | (((x_) >> 8) & 0xF00u) | (((x_) >> 12) & 0xF000u))
    const unsigned thr = prefix > 1u ? prefix : 1u;
#pragma unroll
    for (int g = 0; g < 8; ++g) if (g * 16 < nj) {
#pragma unroll
    for (int jj = 0; jj < 16; ++jj) { const int j = g * 16 + jj; const unsigned long long m = __ballot(key_[j] >= thr);
        const unsigned ma = (unsigned)m, mb = (unsigned)(m >> 32);
        const unsigned a0 = CMP16(ma) << (16 * (j & 1)), a1 = CMP16(ma >> 4) << (16 * (j & 1)), b0 = CMP16(mb) << (16 * (j & 1)), b1 = CMP16(mb >> 4) << (16 * (j & 1));
        const int idx = 2 * (j >> 1);
        if (idx < 64) { if (lane == idx) { wA0 |= a0; wB0 |= b0; } if (lane == idx + 1) { wA0 |= a1; wB0 |= b1; } }
        else { if (lane == idx - 64) { wA1 |= a0; wB1 |= b0; } if (lane == idx - 63) { wA1 |= a1; wB1 |= b1; } } } }
#undef CMP16
    unsigned* MASK = (unsigned*)(c.ws + WS_MASK);
    MASK[(size_t)tokA * 128 + lane] = wA0; MASK[(size_t)tokA * 128 + 64 + lane] = wA1;
    MASK[(size_t)(tokA + 1) * 128 + lane] = wB0; MASK[(size_t)(tokA + 1) * 128 + 64 + lane] = wB1;
    __syncthreads();
}
__device__ __forceinline__ void p4_indexer(const Ctx& c) {
    for (int w = c.bid; w < 256; w += c.G) { const int b = w & 1, p = w >> 1;
        p4_indexer_item(c, b, 16 * p); p4_indexer_item(c, b, 16 * (255 - p)); }
}

__device__ __forceinline__ void p5_lru_apply_item(const Ctx& c, int li) {
    const float* AG = (const float*)(c.ws + WS_AG); const float* BG = (const float*)(c.ws + WS_BG); const float* AGG = (const float*)(c.ws + WS_AGG);
    const bf16* PROJ = (const bf16*)(c.ws + WS_PROJ); bf16* YMIX = (bf16*)(c.ws + WS_YMIX);
    { const int b = li >> 10, ck = (li >> 4) & 63, ch = (li & 15) * 64 + c.lane; const size_t tok0 = (size_t)b * SEQ + ck * 64;
        float hc = 0.f;
        for (int cc = 0; cc < ck; ++cc) hc = AGG[((size_t)(0 * 2 + b) * 64 + cc) * D_LRU + ch] * hc + AGG[((size_t)(1 * 2 + b) * 64 + cc) * D_LRU + ch];
#pragma unroll 8
        for (int t = 0; t < 64; ++t) { const size_t tok = tok0 + t; const float h = BG[tok * D_LRU + ch] + AG[tok * D_LRU + ch] * hc;
            const float gl = bf2f(PROJ[tok * NMAIN + C_GL + ch]);
            YMIX[tok * DM + ch] = (bf16)f2bf(h * gelu_tanh(gl)); } }
}
constexpr int CW_Q5 = 8192;
__device__ __forceinline__ void p5_filler(const Ctx& c, const Args& a) {
    const int sh = c.bid & 7;
    unsigned* cnt = (unsigned*)(c.ws + WS_CTL) + CW_Q5 + 64 * sh;
    constexpr int N_APPLY = 2048 / 8, N_CONV = (2 * NEXP / 8) / 8;
    for (;;) {
        unsigned r = 0u; if (c.lane == 0) r = __hip_atomic_fetch_add(cnt, 1u, __ATOMIC_RELAXED, __HIP_MEMORY_SCOPE_AGENT);
        r = (unsigned)__builtin_amdgcn_readfirstlane((int)r);
        if (r >= (unsigned)(N_APPLY + N_CONV)) break;
        if (r < (unsigned)N_APPLY) { p5_lru_apply_item(c, (int)(N_APPLY - 1 - r) * 8 + sh); }
        else { const int ch = ((int)r - N_APPLY) * 8 + sh, tbl = ch >= NEXP / 8, row0 = (ch - tbl * (NEXP / 8)) * 8;
            convert_rows_fpq<4>((const float*)a.in[tbl ? I_PV : I_PU], c.ws + (tbl ? WS_PV : WS_PU), (bf16*)(c.ws + (tbl ? WS_PVS : WS_PUS)), row0, c.lane);
            convert_rows_fpq<4>((const float*)a.in[tbl ? I_PV : I_PU], c.ws + (tbl ? WS_PV : WS_PU), (bf16*)(c.ws + (tbl ? WS_PVS : WS_PUS)), row0 + 4, c.lane); }
    }
}
__device__ __forceinline__ void p5_attention(const Ctx& c) {
    typedef att::bf16 abf;
    const abf* PROJ = (const abf*)(c.ws + WS_PROJ); abf* YMIX = (abf*)(c.ws + WS_YMIX); const unsigned long long* MASK = (const unsigned long long*)(c.ws + WS_MASK);
    for (int w = c.bid; w < 256; w += c.G) {
        const int xcd = w & 7, slot = w >> 3, bh = xcd * 2 + (slot >> 4), x = 15 - (slot & 15), b = bh >> 3, h = bh & 7;
        att::BlockRef<abf, abf> cur;
        const size_t tokb = (size_t)b * SEQ, tok0 = tokb + (size_t)x * 256;
        cur.Q = PROJ + tok0 * NMAIN + C_Q + h * 128; cur.K = PROJ + tokb * NMAIN + C_K + h * 128; cur.V = PROJ + tokb * NMAIN + C_V + h * 128;
        cur.O = YMIX + tok0 * DM + D_LRU + h * 128; cur.M = MASK + tok0 * 64; cur.P0 = x * 256;
        att::Seam<abf> S;
        att::causal_swa_prime<abf, abf>(cur, 1 << 30, (char*)c.lds, S);
        att::causal_swa_block<abf, abf>(cur, cur, SEQ, 1 << 30, (char*)c.lds, S);
        VM_WAIT(); __syncthreads();
    }
}

__device__ __forceinline__ void p7_rows(const Ctx& c, const Args& a) {
    const int lane = c.lane;
    float* X1 = (float*)(c.ws + WS_X1); bf16* U2 = (bf16*)(c.ws + WS_U2); const float* MODF = (const float*)(c.ws + WS_MODF);
    const float* g1 = (const float*)a.in[I_LN1G]; const float* b1 = (const float*)a.in[I_LN1B];
    for (int row = c.gw; row < NTOK; row += c.ngw) { const int b = row / SEQ;
        f32x4* xr = (f32x4*)(X1 + (size_t)row * DM) + lane;
        f32x4 v[8]; float s = 0.f;
#pragma unroll
        for (int j = 0; j < 8; ++j) { v[j] = xr[64 * j]; s += (v[j].x + v[j].y) + (v[j].z + v[j].w); }
        float mean = wave_sum(s) * (1.f / DM), s2 = 0.f;
#pragma unroll
        for (int j = 0; j < 8; ++j) { v[j] = v[j] - mean; s2 += (v[j].x * v[j].x + v[j].y * v[j].y) + (v[j].z * v[j].z + v[j].w * v[j].w); }
        float rstd = 1.f / sqrtf(wave_sum(s2) * (1.f / DM) + LN_EPS);
        s = 0.f;
#pragma unroll
        for (int j = 0; j < 8; ++j) { const int col = 4 * lane + 256 * j;
            v[j] = v[j] * rstd * *(const f32x4*)(g1 + col) + *(const f32x4*)(b1 + col);
            xr[64 * j] = v[j]; s += (v[j].x + v[j].y) + (v[j].z + v[j].w); }
        mean = wave_sum(s) * (1.f / DM); s2 = 0.f;
#pragma unroll
        for (int j = 0; j < 8; ++j) { v[j] = v[j] - mean; s2 += (v[j].x * v[j].x + v[j].y * v[j].y) + (v[j].z * v[j].z + v[j].w * v[j].w); }
        rstd = 1.f / sqrtf(wave_sum(s2) * (1.f / DM) + LN_EPS);
#pragma unroll
        for (int j = 0; j < 8; ++j) { const int col = 4 * lane + 256 * j;
            const f32x4 sh = *(const f32x4*)(MODF + (size_t)b * (6 * DM) + 3 * DM + col), sc = *(const f32x4*)(MODF + (size_t)b * (6 * DM) + 4 * DM + col);
            const f32x4 y = v[j] * rstd * (sc + 1.0f) + sh;
            v2u o; o.x = pk2(y.x, y.y); o.y = pk2(y.z, y.w);
            *(v2u*)(U2 + (size_t)row * DM + col) = o; }
    }
}

__device__ __forceinline__ unsigned f2key(float f) { const unsigned u = __builtin_bit_cast(unsigned, f); return u ^ ((unsigned)((int)u >> 31) | 0x80000000u); }
__device__ __forceinline__ float key2f(unsigned k) { const unsigned u = (k & 0x80000000u) ? (k ^ 0x80000000u) : ~k; return __builtin_bit_cast(float, u); }
#define INSK(k_, T) do { _Pragma("unroll") for (int q_ = 0; q_ < 16; ++q_) { const unsigned t_ = T[q_]; const unsigned mx_ = t_ > k_ ? t_ : k_; const unsigned mn_ = t_ > k_ ? k_ : t_; T[q_] = mx_; k_ = mn_; } } while (0)
__device__ __forceinline__ float wave_sum_u(float v) {
    v += __builtin_bit_cast(float, __builtin_amdgcn_mov_dpp(__builtin_bit_cast(int, v), 0xB1, 0xf, 0xf, true));
    v += __builtin_bit_cast(float, __builtin_amdgcn_mov_dpp(__builtin_bit_cast(int, v), 0x4E, 0xf, 0xf, true));
    v += __builtin_bit_cast(float, __builtin_amdgcn_mov_dpp(__builtin_bit_cast(int, v), 0x141, 0xf, 0xf, true));
    v += __builtin_bit_cast(float, __builtin_amdgcn_mov_dpp(__builtin_bit_cast(int, v), 0x140, 0xf, 0xf, true));
    const int iv = __builtin_bit_cast(int, v);
    return (__builtin_bit_cast(float, __builtin_amdgcn_readlane(iv, 0)) + __builtin_bit_cast(float, __builtin_amdgcn_readlane(iv, 16)))
         + (__builtin_bit_cast(float, __builtin_amdgcn_readlane(iv, 32)) + __builtin_bit_cast(float, __builtin_amdgcn_readlane(iv, 48)));
}
template <int B> __device__ __forceinline__ f32x2 dq4(unsigned w) { return __builtin_amdgcn_cvt_scalef32_pk_f32_fp4(w, 1.0f, B); }
__device__ __forceinline__ float dot2bf(unsigned a, unsigned b, float c) {
    c = fmaf(bflo(a), bflo(b), c); return fmaf(bfhi(a), bfhi(b), c);
}
__device__ __forceinline__ void p9_peer(const Ctx& c, const Args& a) {
    const int lane = c.lane, wave = c.wave, fr = lane & 15, fq = lane >> 4;
    const bf16* QP = (const bf16*)(c.ws + WS_QP); const bf16* SUBK = (const bf16*)(c.ws + WS_SUBK); const bf16* U2 = (const bf16*)(c.ws + WS_U2);
    const unsigned char* PU8 = c.ws + WS_PU; const unsigned char* PV8 = c.ws + WS_PV; const bf16* PUS = (const bf16*)(c.ws + WS_PUS); const bf16* PVS = (const bf16*)(c.ws + WS_PVS); const float* X1 = (const float*)(c.ws + WS_X1);
    const float* MODF = (const float*)(c.ws + WS_MODF); const float* g2 = (const float*)a.in[I_LN2G]; const float* b2 = (const float*)a.in[I_LN2B];
    int* EIDX = (int*)(c.ws + WS_U1); float* PGW = (float*)(c.ws + WS_U1 + 4 * MiB);
    for (int it = c.bid; it < NTOK / 32; it += c.G) {
        const int t0 = it * 32;
#ifndef P9_NOROUTE
        for (int rrep = 0; rrep < NREP(91); ++rrep)
        { LAS float* sb = (LAS float*)c.lds + wave * (32 * 129); const int h = wave;
#pragma unroll 1
          for (int m = 0; m < 2; ++m) {
              int fq8 = 8 * fq, frl = fr; asm volatile("" : "+v"(fq8), "+v"(frl));
              { f32x4 acc[2][8];
#pragma unroll
                for (int p = 0; p < 2; ++p)
#pragma unroll
                    for (int nt = 0; nt < 8; ++nt) acc[p][nt] = (f32x4){0.f, 0.f, 0.f, 0.f};
#pragma unroll
                for (int p = 0; p < 2; ++p)
#pragma unroll
                    for (int ks = 0; ks < 4; ++ks) { const bf16x8 av = *(const bf16x8*)(QP + (size_t)(t0 + 16 * m + frl) * DM + h * 256 + p * 128 + ks * 32 + fq8);
#pragma unroll
                        for (int nt = 0; nt < 8; ++nt) { const bf16x8 bv = *(const bf16x8*)(SUBK + ((size_t)(h * 2 + p) * 128 + 16 * nt + frl) * 128 + ks * 32 + fq8);
                            acc[p][nt] = mfma16(av, bv, acc[p][nt]); } }
#pragma unroll
                for (int p = 0; p < 2; ++p)
#pragma unroll
                    for (int nt = 0; nt < 8; ++nt)
#pragma unroll
                        for (int r = 0; r < 4; ++r) sb[(p * 16 + 4 * fq + r) * 129 + 16 * nt + fr] = acc[p][nt][r]; }
              LDS_WAIT(); asm volatile("" ::: "memory");
              unsigned T[16];
#pragma unroll
              for (int q = 0; q < 16; ++q) T[q] = 0u;
              { const int half = lane >> 5; const LAS float* row = sb + (lane & 31) * 129 + half * 64;
#pragma unroll 4
                for (int k = 0; k < 64; ++k) { unsigned key = (f2key(row[k]) & 0xFFFFFF80u) | (unsigned)(127 - (half * 64 + k)); INSK(key, T); } }
              { unsigned P[16];
#pragma unroll
                for (int q = 0; q < 16; ++q) P[q] = (unsigned)__shfl_xor((int)T[q], 32);
#pragma unroll
                for (int q = 0; q < 16; ++q) { unsigned key = P[q]; INSK(key, T); } }
              unsigned T2[16];
#pragma unroll
              for (int q = 0; q < 16; ++q) T2[q] = (unsigned)__shfl((int)T[q], (lane & 15) + 16);
              LDS_WAIT(); asm volatile("" ::: "memory");
              LAS int* ib = (LAS int*)sb;
              if (lane < 16) {
#pragma unroll
                  for (int q = 0; q < 16; ++q) { ib[lane * 33 + q] = 127 - (int)(T[q] & 0x7Fu); ib[lane * 33 + 16 + q] = 127 - (int)(T2[q] & 0x7Fu); } }
              float f1[16], f2[16];
#pragma unroll
              for (int q = 0; q < 16; ++q) { f1[q] = key2f(T[q] & 0xFFFFFF80u); f2[q] = key2f(T2[q] & 0xFFFFFF80u); }
              unsigned C[16];
#pragma unroll
              for (int q = 0; q < 16; ++q) C[q] = 0u;
#pragma unroll
              for (int a_ = 0; a_ < 16; ++a_)
#pragma unroll
                  for (int b_ = 0; b_ < 16; ++b_) if ((a_ + 1) * (b_ + 1) <= 16) { unsigned key = (f2key(f1[a_] + f2[b_]) & 0xFFFFFF00u) | (unsigned)(255 - (a_ * 16 + b_)); INSK(key, C); }
              LDS_WAIT(); asm volatile("" ::: "memory");
              if (lane < 16) {
                  const float mx = key2f(C[0] & 0xFFFFFF00u); float ev[16], sum = 0.f;
#pragma unroll
                  for (int q = 0; q < 16; ++q) { ev[q] = __expf(key2f(C[q] & 0xFFFFFF00u) - mx); sum += ev[q]; }
                  const float rs = 1.0f / sum;
#pragma unroll
                  for (int q = 0; q < 16; ++q) { const int code = 255 - (int)(C[q] & 0xFFu);
                      const int eid = ib[lane * 33 + (code >> 4)] * 128 + ib[lane * 33 + 16 + (code & 15)];
                      EIDX[(size_t)(t0 + 16 * m + lane) * 128 + h * 16 + q] = eid; PGW[(size_t)(t0 + 16 * m + lane) * 128 + h * 16 + q] = ev[q] * rs; } }
              LDS_WAIT(); asm volatile("" ::: "memory");
          } }
#endif
        VM_WAIT(); __syncthreads();
#ifndef P9_NOGATHER
        for (int grep_ = 0; grep_ < NREP(92); ++grep_)
#pragma unroll 1
        for (int i4 = 0; i4 < 4; ++i4) { const int tok = t0 + wave * 4 + i4, b = tok / SEQ;
            int l16 = 16 * lane; asm volatile("" : "+v"(l16));
            v32f uu;
#pragma unroll
            for (int cc = 0; cc < 2; ++cc)
#pragma unroll
                for (int hq = 0; hq < 2; ++hq) { const v4u r = *(const v4u*)(U2 + (size_t)tok * DM + 1024 * cc + l16 + 8 * hq); const int o = 16 * cc + 8 * hq;
                    uu[o + 0] = bflo(r.x); uu[o + 1] = bfhi(r.x); uu[o + 2] = bflo(r.y); uu[o + 3] = bfhi(r.y); uu[o + 4] = bflo(r.z); uu[o + 5] = bfhi(r.z); uu[o + 6] = bflo(r.w); uu[o + 7] = bfhi(r.w); }
            v32f acc;
#pragma unroll
            for (int i = 0; i < 32; ++i) acc[i] = 0.f;
            const int lane_ = l16 >> 4;
#pragma unroll 1
            for (int hf = 0; hf < 2; ++hf) {
                const int myi = EIDX[(size_t)tok * 128 + hf * 64 + lane]; const float myg = PGW[(size_t)tok * 128 + hf * 64 + lane];
#pragma unroll 1
                for (int e4 = 0; e4 < 64; e4 += 4) {
                    int ex[4]; float gv[4];
#pragma unroll
                    for (int q = 0; q < 4; ++q) { ex[q] = __builtin_amdgcn_readlane(myi, e4 + q);
                        gv[q] = __builtin_bit_cast(float, __builtin_amdgcn_readlane(__builtin_bit_cast(int, myg), e4 + q)); }
                    v4u rua[4], rva[4]; bf16 su[4], sv[4];
#pragma unroll
                    for (int q = 0; q < 4; ++q) { rua[q] = *(const v4u*)(PU8 + (size_t)ex[q] * FPQ_ROWB + l16); su[q] = PUS[(size_t)ex[q] * 64 + lane_]; }
                    __builtin_amdgcn_sched_barrier(0);
#pragma unroll
                    for (int q = 0; q < 4; ++q) { rva[q] = *(const v4u*)(PV8 + (size_t)ex[q] * FPQ_ROWB + l16); sv[q] = PVS[(size_t)ex[q] * 64 + lane_]; }
                    __builtin_amdgcn_sched_barrier(0);
                    float hk[4];
#pragma unroll
                    for (int q = 0; q < 4; ++q) { float s0 = 0.f, s1 = 0.f;
#pragma unroll
                        for (int k = 0; k < 4; ++k) { const unsigned wd = rua[q][k];
                            { const f32x2 d = dq4<0>(wd); s0 = fmaf(d.x, uu[8 * k + 0], s0); s1 = fmaf(d.y, uu[8 * k + 1], s1); }
                            { const f32x2 d = dq4<1>(wd); s0 = fmaf(d.x, uu[8 * k + 2], s0); s1 = fmaf(d.y, uu[8 * k + 3], s1); }
                            { const f32x2 d = dq4<2>(wd); s0 = fmaf(d.x, uu[8 * k + 4], s0); s1 = fmaf(d.y, uu[8 * k + 5], s1); }
                            { const f32x2 d = dq4<3>(wd); s0 = fmaf(d.x, uu[8 * k + 6], s0); s1 = fmaf(d.y, uu[8 * k + 7], s1); } }
                        hk[q] = gv[q] * gelu_tanh(wave_sum_u((s0 + s1) * bf2f(su[q]))); __builtin_amdgcn_sched_barrier(0); }
                    __builtin_amdgcn_sched_barrier(0);
#pragma unroll
                    for (int q = 0; q < 4; ++q) {
                        const float hq = hk[q] * bf2f(sv[q]);
#pragma unroll
                        for (int k = 0; k < 4; ++k) { const unsigned wd = rva[q][k];
                            { const f32x2 d = dq4<0>(wd); acc[8 * k + 0] = fmaf(d.x, hq, acc[8 * k + 0]); acc[8 * k + 1] = fmaf(d.y, hq, acc[8 * k + 1]); }
                            { const f32x2 d = dq4<1>(wd); acc[8 * k + 2] = fmaf(d.x, hq, acc[8 * k + 2]); acc[8 * k + 3] = fmaf(d.y, hq, acc[8 * k + 3]); }
                            { const f32x2 d = dq4<2>(wd); acc[8 * k + 4] = fmaf(d.x, hq, acc[8 * k + 4]); acc[8 * k + 5] = fmaf(d.y, hq, acc[8 * k + 5]); }
                            { const f32x2 d = dq4<3>(wd); acc[8 * k + 6] = fmaf(d.x, hq, acc[8 * k + 6]); acc[8 * k + 7] = fmaf(d.y, hq, acc[8 * k + 7]); } }
                        __builtin_amdgcn_sched_barrier(0); }
                    __builtin_amdgcn_sched_barrier(0);
                } }
            float s = 0.f; f32x4 z[2][4];
#pragma unroll
            for (int cc = 0; cc < 2; ++cc)
#pragma unroll
                for (int w = 0; w < 4; ++w) { const int col = 1024 * cc + l16 + 4 * w;
                    const f32x4 xv = *(const f32x4*)(X1 + (size_t)tok * DM + col), gt = *(const f32x4*)(MODF + (size_t)b * (6 * DM) + 5 * DM + col);
                    const f32x4 yv = {acc[16 * cc + 4 * w], acc[16 * cc + 4 * w + 1], acc[16 * cc + 4 * w + 2], acc[16 * cc + 4 * w + 3]};
                    z[cc][w] = xv * DN_ALPHA + (gt + 1.0f) * yv;
                    s += (z[cc][w].x + z[cc][w].y) + (z[cc][w].z + z[cc][w].w); }
            const float mean = wave_sum_u(s) * (1.f / DM); float s2 = 0.f;
#pragma unroll
            for (int cc = 0; cc < 2; ++cc)
#pragma unroll
                for (int w = 0; w < 4; ++w) { z[cc][w] = z[cc][w] - mean; s2 += (z[cc][w].x * z[cc][w].x + z[cc][w].y * z[cc][w].y) + (z[cc][w].z * z[cc][w].z + z[cc][w].w * z[cc][w].w); }
            const float rstd = 1.f / sqrtf(wave_sum_u(s2) * (1.f / DM) + LN_EPS);
#pragma unroll
            for (int cc = 0; cc < 2; ++cc)
#pragma unroll
                for (int w = 0; w < 4; ++w) { const int col = 1024 * cc + l16 + 4 * w;
                    *(f32x4*)(a.out + (size_t)tok * DM + col) = z[cc][w] * rstd * *(const f32x4*)(g2 + col) + *(const f32x4*)(b2 + col); }
        }
#endif
        __syncthreads();
    }
}

#ifndef MK_SINGLE
#define MK_SINGLE 1
#endif
constexpr int NPHASE = 10;
constexpr int CW_BAR = 4096;

__global__ void __launch_bounds__(NWAVES * 64, 2) fwd_kernel(Args args) {
    extern __shared__ __attribute__((aligned(16))) unsigned char lds_raw[];
    Ctx c;
    c.lds = (LAS unsigned char*)lds_raw; c.ws = args.ws;
    c.tid = threadIdx.x; c.lane = c.tid & 63; c.wave = __builtin_amdgcn_readfirstlane(c.tid >> 6);
    c.bid = blockIdx.x; c.G = gridDim.x; c.gw = c.bid * NWAVES + c.wave; c.ngw = c.G * NWAVES;
    volatile LAS unsigned* MISC = (volatile LAS unsigned*)(c.lds + MISC_OFF);
    if (c.tid < 64) MISC[c.tid] = 0u;
    __syncthreads();
    const int lo = args.ph_lo, hi = args.ph_hi;
    XcdBarrier bar; bar.bar = (unsigned*)(c.ws + WS_CTL) + CW_BAR; bar.x = 0; bar.st = nullptr;
    if (hi - lo > 1) bar = xcd_barrier_post((unsigned*)(c.ws + WS_CTL) + CW_BAR, MISC + 8);
#ifdef ONLY
#define IN(k) ((k) == ONLY)
#else
#define IN(k) (lo <= (k) && (k) < hi)
#endif
#define SEAM(k) do { if (IN(k) && IN((k) + 1)) xcd_barrier(bar); } while (0)

    if (IN(0)) { for (int rep = 0; rep < NREP(0); ++rep) { p0_prologue(c, args); } } SEAM(0);
    if (IN(1)) { for (int rep = 0; rep < NREP(1); ++rep) { p1_u1(c, args); } } SEAM(1);
    if (IN(2)) {
        pg8::Gemm g{(const pg8::bf16_t*)(c.ws + WS_U1), (const pg8::bf16_t*)(c.ws + WS_WIN), NTOK, NMAIN, DM}; pg8::StaticOrder S; S.init(NTOK, NMAIN, c.G, c.bid);
        pg8::EpiProj E{(pg8::bf16_t*)(c.ws + WS_PROJ), NMAIN, (const float*)(c.ws + WS_ROPE)};
        for (int rep = 0; rep < NREP(2); ++rep) pg8::gemm_phase<pg8::EpiProj, pg8::StaticOrder, true, true>(c.lds, g, S, E);
    } SEAM(2);
    if (IN(3)) { for (int rep = 0; rep < NREP(3); ++rep) { p3_post(c, args); } } SEAM(3);
    if (IN(4)) { p4_lru_scan(c); for (int rep = 0; rep < NREP(4); ++rep) { p4_indexer(c); } } SEAM(4);
    if (IN(5)) { for (int rep = 0; rep < NREP(5); ++rep) { p5_attention(c); } p5_filler(c, args); } SEAM(5);
    if (IN(6)) {
        pg8::Gemm g{(const pg8::bf16_t*)(c.ws + WS_YMIX), (const pg8::bf16_t*)(c.ws + WS_WOUT), NTOK, DM, DM}; pg8::StaticOrder S; S.init(NTOK, DM, c.G, c.bid);
        pg8::EpiResF32 E{(const float*)args.in[I_X], (float*)(c.ws + WS_X1), (const float*)(c.ws + WS_MODF) + 2 * DM, DM, SEQ, 6 * DM, DN_ALPHA};
        for (int rep = 0; rep < NREP(6); ++rep) pg8::gemm_phase<pg8::EpiResF32, pg8::StaticOrder, true, true>(c.lds, g, S, E);
    } SEAM(6);
    if (IN(7)) { p7_rows(c, args); } SEAM(7);
    if (IN(8)) {
        pg8::Gemm g{(const pg8::bf16_t*)(c.ws + WS_U2), (const pg8::bf16_t*)(c.ws + WS_WPQ), NTOK, DM, DM}; pg8::StaticOrder S; S.init(NTOK, DM, c.G, c.bid);
        pg8::EpiBf16<0> E{(pg8::bf16_t*)(c.ws + WS_QP), DM, nullptr, 0, 0, 1.f};
        for (int rep = 0; rep < NREP(8); ++rep) pg8::gemm_phase<pg8::EpiBf16<0>, pg8::StaticOrder, true, true>(c.lds, g, S, E);
    } SEAM(8);
    if (IN(9)) { for (int rep = 0; rep < NREP(9); ++rep) { p9_peer(c, args); } }
    if (NREP(99) > 1) { for (int xb = 0; xb < 10; ++xb) xcd_barrier(bar); }
#undef IN
#undef SEAM
}

extern "C" void kernel_launch(void* const* d_in, const int* in_sizes, int n_in, void* d_out, int out_size, void* d_ws, size_t ws_size, hipStream_t stream) {
    static int grid = 0;
    if (grid == 0) {
        if (n_in != 23 || in_sizes[0] != NTOK * DM || out_size != NTOK * DM || ws_size < WS_END) {
            fprintf(stderr, "kernel_launch: unexpected shapes (n_in %d, in0 %d, out %d, ws %zu); nothing launched\n", n_in, n_in > 0 ? in_sizes[0] : -1, out_size, ws_size); grid = -1; return; }
        int dev = 0, cus = 0, per_cu = 0;
        if (hipGetDevice(&dev) != hipSuccess || hipDeviceGetAttribute(&cus, hipDeviceAttributeMultiprocessorCount, dev) != hipSuccess) { grid = -1; return; }
        if (hipFuncSetAttribute((const void*)fwd_kernel, hipFuncAttributeMaxDynamicSharedMemorySize, LDS_BYTES) != hipSuccess) { fprintf(stderr, "kernel_launch: hipFuncSetAttribute failed\n"); grid = -1; return; }
        if (hipOccupancyMaxActiveBlocksPerMultiprocessor(&per_cu, (const void*)fwd_kernel, NWAVES * 64, LDS_BYTES) != hipSuccess || per_cu < 1) { fprintf(stderr, "kernel_launch: occupancy query says %d\n", per_cu); }
        (void)hipGetLastError();
        grid = cus;
    }
    if (grid < 0) return;
    (void)hipMemsetAsync((char*)d_ws + WS_CTL, 0, CTL_ZERO_BYTES, stream);
    Args a{};
    for (int i = 0; i < 23; ++i) a.in[i] = d_in[i];
    a.out = (float*)d_out; a.ws = (unsigned char*)d_ws;
#if MK_SINGLE
    a.ph_lo = 0; a.ph_hi = NPHASE;
    hipLaunchKernelGGL(fwd_kernel, dim3(grid), dim3(NWAVES * 64), LDS_BYTES, stream, a);
#else
    for (int p = 0; p < NPHASE; ++p) { a.ph_lo = p; a.ph_hi = p + 1; hipLaunchKernelGGL(fwd_kernel, dim3(grid), dim3(NWAVES * 64), LDS_BYTES, stream, a); }
#endif
}
```
